# Optimizing an MI355X kernel written in HIP

```python
import jax, jax.numpy as jnp
from jax import lax
import numpy as np

D_MODEL = 1024
BATCH = 8
SEQ = 4096
DEPTH = 1

N_META = 16
RMS_EPS = 1e-6
RWKV_HEADS = 8
RWKV_HEAD_DIM = 64
RWKV_WIDTH = RWKV_HEADS * RWKV_HEAD_DIM
DECAY_LORA = 64
AAA_LORA = 64
GATE_LORA = 160
GN_EPS = 64e-5
MLA_HEADS = 4
QK_NOPE_DIM = 128
QK_ROPE_DIM = 64
V_HEAD_DIM = 128
MLA_WIDTH = MLA_HEADS * V_HEAD_DIM
Q_LORA = 384
KV_LORA = 256
ROPE_THETA = 10000.0
Q_BLOCK = 128
D_FF = -(-8 * D_MODEL // (3 * 256)) * 256
RWKV_SIZES = (RWKV_WIDTH, RWKV_WIDTH, RWKV_WIDTH, DECAY_LORA, AAA_LORA, GATE_LORA)
MLA_SIZES = (Q_LORA, KV_LORA, QK_ROPE_DIM)
RWKV_COLS = 3 * RWKV_WIDTH + DECAY_LORA + AAA_LORA + GATE_LORA
MLA_COLS = Q_LORA + KV_LORA + QK_ROPE_DIM
IN_COLS = RWKV_COLS + MLA_COLS

kernel_name = "hymba_rwkv7_mla_hybrid_layer"


def _rmsnorm(x, g):
    xf = x.astype(jnp.float32)
    y = xf * lax.rsqrt(jnp.mean(xf * xf, axis=-1, keepdims=True) + RMS_EPS)
    return (y * g.astype(jnp.float32)).astype(x.dtype)


def _split(x, sizes):
    out = []
    o = 0
    for s in sizes:
        out.append(x[..., o:o + s])
        o += s
    return out


def _token_shift(p, mu):
    prev = jnp.pad(p, ((0, 0), (1, 0), (0, 0)))[:, :-1]
    return p + (prev - p) * mu


def _rope(x, cos, sin):
    half = x.shape[-1] // 2
    x1, x2 = x[..., :half], x[..., half:]
    return jnp.concatenate([x1 * cos - x2 * sin, x2 * cos + x1 * sin], axis=-1).astype(x.dtype)


def _rwkv7_scan(r, w, k, v, a, b):
    B, L, H, N = r.shape

    def step(S, inp):
        r_t, w_t, k_t, v_t, a_t, b_t = inp
        sa = jnp.einsum('bhij,bhj->bhi', S, a_t)
        S = S * w_t[:, :, None, :] + sa[..., None] * b_t[:, :, None, :] + v_t[..., None] * k_t[:, :, None, :]
        y_t = jnp.einsum('bhij,bhj->bhi', S, r_t)
        return S, y_t

    xs = tuple(jnp.moveaxis(t, 1, 0) for t in (r, w, k, v, a, b))
    S0 = jnp.zeros((B, H, N, N), jnp.float32)
    _, y = lax.scan(step, S0, xs)
    return jnp.moveaxis(y, 0, 1)


def _rwkv7_group(p, mu, w0, w2, a0, a2, g2, k_k, k_a, r_k, ln_w, ln_b):
    B, L, _ = p.shape
    H, N = RWKV_HEADS, RWKV_HEAD_DIM
    f32 = jnp.float32
    p = _token_shift(p, mu)
    r, k, v, wd, ad, gd = _split(p, RWKV_SIZES)
    w = -jax.nn.softplus(-(w0 + jnp.tanh(wd) @ w2)) - 0.5
    decay = jnp.exp(-jnp.exp(w.astype(f32)))
    a = jax.nn.sigmoid(a0 + ad @ a2)
    g = jax.nn.sigmoid(gd) @ g2
    hs = lambda t: t.astype(f32).reshape(B, L, H, N)
    r, k, v, a, decay = hs(r), hs(k), hs(v), hs(a), hs(decay)
    kk = k * k_k.astype(f32).reshape(H, N)
    kk = kk / jnp.maximum(jnp.sqrt(jnp.sum(kk * kk, axis=-1, keepdims=True)), 1e-12)
    k = k * (1.0 + (a - 1.0) * k_a.astype(f32).reshape(H, N))
    y = _rwkv7_scan(r, decay, k, v, -kk, kk * a)
    mean = jnp.mean(y, axis=-1, keepdims=True)
    var = jnp.var(y, axis=-1, keepdims=True)
    y = (y - mean) * lax.rsqrt(var + GN_EPS) * ln_w.astype(f32).reshape(H, N) + ln_b.astype(f32).reshape(H, N)
    y = y + jnp.sum(r * k * r_k.astype(f32), axis=-1, keepdims=True) * v
    return (y.reshape(B, L, RWKV_WIDTH) * g.astype(f32)).astype(p.dtype)


def _mla_group(p, q_norm_g, w_uq, kv_norm_g, w_ukv, out_norm_g):
    B, L, _ = p.shape
    H = MLA_HEADS
    f32 = jnp.float32
    c_q, c_kv, k_pe = _split(p, MLA_SIZES)
    q = (_rmsnorm(c_q, q_norm_g) @ w_uq).reshape(B, L, H, QK_NOPE_DIM + QK_ROPE_DIM)
    q_nope, q_pe = q[..., :QK_NOPE_DIM], q[..., QK_NOPE_DIM:]
    kv = (_rmsnorm(c_kv, kv_norm_g) @ w_ukv).reshape(B, L, H, QK_NOPE_DIM + V_HEAD_DIM)
    k_nope, v = kv[..., :QK_NOPE_DIM], kv[..., QK_NOPE_DIM:]
    pos = jnp.arange(L, dtype=f32)
    inv_freq = 1.0 / (ROPE_THETA ** (jnp.arange(0, QK_ROPE_DIM, 2, dtype=f32) / QK_ROPE_DIM))
    ang = pos[:, None] * inv_freq[None, :]
    cos, sin = jnp.cos(ang), jnp.sin(ang)
    q_pe = _rope(q_pe, cos[:, None, :], sin[:, None, :])
    k_pe = _rope(k_pe, cos, sin)
    pad = Q_BLOCK - N_META
    padt = lambda t: jnp.pad(t, [(0, 0), (pad, 0)] + [(0, 0)] * (t.ndim - 2))
    qn, qp, kn, kp, vv = padt(q_nope), padt(q_pe), padt(k_nope), padt(k_pe), padt(v)
    n_blocks = (L + pad) // Q_BLOCK
    scale = (QK_NOPE_DIM + QK_ROPE_DIM) ** -0.5
    outs = []
    for i in range(n_blocks):
        q0 = i * Q_BLOCK
        kend = q0 + Q_BLOCK
        s = (jnp.einsum('bqhd,bkhd->bhqk', qn[:, q0:kend], kn[:, :kend])
             + jnp.einsum('bqhd,bkd->bhqk', qp[:, q0:kend], kp[:, :kend])).astype(f32) * scale
        qi = jnp.arange(q0, kend)[:, None]
        ki = jnp.arange(kend)[None, :]
        mask = (ki <= qi) & (ki >= pad)
        s = jnp.where(mask, s, -1e30)
        prob = jax.nn.softmax(s, axis=-1).astype(vv.dtype)
        outs.append(jnp.einsum('bhqk,bkhd->bqhd', prob, vv[:, :kend]))
    o = jnp.concatenate(outs, axis=1)[:, pad:]
    o = _rmsnorm(o, out_norm_g.reshape(H, V_HEAD_DIM))
    return o.reshape(B, L, MLA_WIDTH)


def setup_inputs(seed: int = 0) -> dict:
    key = jax.random.key(seed)
    ks = jax.random.split(key, 32)
    nrm = lambda k, shape, s: jax.random.normal(k, shape, jnp.float32) * s
    gain = lambda k, shape: 1.0 + 0.02 * jax.random.normal(k, shape, jnp.float32)
    Dp = DEPTH
    return {
        "x": nrm(ks[0], (BATCH, SEQ, D_MODEL), 1.0),
        "meta_tokens": nrm(ks[1], (N_META, D_MODEL), 1.0),
        "norm1_g": gain(ks[2], (Dp, D_MODEL)),
        "w_in": nrm(ks[3], (Dp, D_MODEL, IN_COLS), D_MODEL ** -0.5),
        "rwkv_mu": jax.random.uniform(ks[4], (Dp, RWKV_COLS), jnp.float32),
        "rwkv_w0": jax.random.uniform(ks[5], (Dp, RWKV_WIDTH), jnp.float32, minval=-6.0, maxval=1.0),
        "rwkv_w2": nrm(ks[6], (Dp, DECAY_LORA, RWKV_WIDTH), 0.5 * DECAY_LORA ** -0.5),
        "rwkv_a0": nrm(ks[7], (Dp, RWKV_WIDTH), 0.3),
        "rwkv_a2": nrm(ks[8], (Dp, AAA_LORA, RWKV_WIDTH), 0.5 * AAA_LORA ** -0.5),
        "rwkv_g2": nrm(ks[9], (Dp, GATE_LORA, RWKV_WIDTH), GATE_LORA ** -0.5),
        "rwkv_k_k": 0.85 + nrm(ks[10], (Dp, RWKV_WIDTH), 0.02),
        "rwkv_k_a": gain(ks[11], (Dp, RWKV_WIDTH)),
        "rwkv_r_k": nrm(ks[12], (Dp, RWKV_HEADS, RWKV_HEAD_DIM), 0.1),
        "rwkv_ln_w": gain(ks[13], (Dp, RWKV_WIDTH)),
        "rwkv_ln_b": nrm(ks[14], (Dp, RWKV_WIDTH), 0.02),
        "mla_q_norm_g": gain(ks[15], (Dp, Q_LORA)),
        "mla_w_uq": nrm(ks[16], (Dp, Q_LORA, MLA_HEADS * (QK_NOPE_DIM + QK_ROPE_DIM)), Q_LORA ** -0.5),
        "mla_kv_norm_g": gain(ks[17], (Dp, KV_LORA)),
        "mla_w_ukv": nrm(ks[18], (Dp, KV_LORA, MLA_HEADS * (QK_NOPE_DIM + V_HEAD_DIM)), KV_LORA ** -0.5),
        "mla_out_norm_g": gain(ks[19], (Dp, MLA_WIDTH)),
        "w_out": nrm(ks[20], (Dp, RWKV_WIDTH + MLA_WIDTH, D_MODEL), (RWKV_WIDTH + MLA_WIDTH) ** -0.5),
        "norm2_g": gain(ks[21], (Dp, D_MODEL)),
        "ffn_w_gate": nrm(ks[22], (Dp, D_MODEL, D_FF), D_MODEL ** -0.5),
        "ffn_w_up": nrm(ks[23], (Dp, D_MODEL, D_FF), D_MODEL ** -0.5),
        "ffn_w_down": nrm(ks[24], (Dp, D_FF, D_MODEL), D_FF ** -0.5),
        "final_norm_g": gain(ks[25], (D_MODEL,)),
    }


def reference(x, meta_tokens, norm1_g, w_in, rwkv_mu, rwkv_w0, rwkv_w2, rwkv_a0, rwkv_a2, rwkv_g2,
              rwkv_k_k, rwkv_k_a, rwkv_r_k, rwkv_ln_w, rwkv_ln_b, mla_q_norm_g, mla_w_uq, mla_kv_norm_g,
              mla_w_ukv, mla_out_norm_g, w_out, norm2_g, ffn_w_gate, ffn_w_up, ffn_w_down, final_norm_g):
    B = x.shape[0]
    meta = jnp.broadcast_to(meta_tokens[None].astype(x.dtype), (B, N_META, D_MODEL))
    h = jnp.concatenate([meta, x], axis=1)
    for layer in range(DEPTH):
        u = _rmsnorm(h, norm1_g[layer])
        p = u @ w_in[layer]
        y_rwkv = _rwkv7_group(p[..., :RWKV_COLS], rwkv_mu[layer], rwkv_w0[layer], rwkv_w2[layer],
                              rwkv_a0[layer], rwkv_a2[layer], rwkv_g2[layer], rwkv_k_k[layer],
                              rwkv_k_a[layer], rwkv_r_k[layer], rwkv_ln_w[layer], rwkv_ln_b[layer])
        y_mla = _mla_group(p[..., RWKV_COLS:], mla_q_norm_g[layer], mla_w_uq[layer],
                           mla_kv_norm_g[layer], mla_w_ukv[layer], mla_out_norm_g[layer])
        h = h + jnp.concatenate([y_rwkv, y_mla], axis=-1) @ w_out[layer]
        u = _rmsnorm(h, norm2_g[layer])
        h = h + (jax.nn.silu(u @ ffn_w_gate[layer]) * (u @ ffn_w_up[layer])) @ ffn_w_down[layer]
    h = _rmsnorm(h, final_norm_g)
    return h[:, N_META:]
```

```cpp
#include <hip/hip_runtime.h>
#include <cstdio>
#include <cstdint>

typedef unsigned short bf16_t;
typedef _Float16 f16_t;
typedef float f32x4 __attribute__((ext_vector_type(4)));
typedef unsigned u32x4 __attribute__((ext_vector_type(4)));
typedef unsigned u32x2 __attribute__((ext_vector_type(2)));

constexpr int NB = 8, SEQ = 4096, DM = 1024, NMETA = 16, L = SEQ + NMETA;
constexpr int LPAD = 48, LP = L + LPAD;
constexpr int TP = NB * LP;
constexpr int TR = NB * SEQ;
constexpr int NIN = 2528, NINP = 2560, RW = 512, RCOLS = 1824;
constexpr int QL = 384, KVL = 256, DQK = 192, DV = 128, NH = 4, RH = 8, RN = 64;
constexpr int DFF = 2816;
constexpr float RMS_EPS = 1e-6f, GN_EPS = 64e-5f;
constexpr float QSCALE = 0.07216878364870323f * 1.4426950408889634f;

constexpr size_t MiB = 1u << 20;
constexpr size_t al256(size_t x) { return (x + 255) & ~(size_t)255; }
constexpr size_t O_WIN = 0;
constexpr size_t O_WUQ = O_WIN + al256((size_t)NINP * DM * 2);
constexpr size_t O_WUKV = O_WUQ + al256((size_t)768 * QL * 2);
constexpr size_t O_LWA = O_WUKV + al256((size_t)1024 * KVL * 2);
constexpr size_t O_LG = O_LWA + al256((size_t)1024 * 128 * 2);
constexpr size_t O_WOUT = O_LG + al256((size_t)512 * 256 * 2);
constexpr size_t O_WGU = O_WOUT + al256((size_t)DM * DM * 2);
constexpr size_t O_WDN = O_WGU + al256((size_t)2 * DFF * DM * 2);
constexpr size_t O_ROPE = O_WDN + al256((size_t)DM * DFF * 2);
constexpr size_t O_RSTDQ = O_ROPE + al256((size_t)L * 32 * 8);
constexpr size_t O_RSTDKV = O_RSTDQ + al256((size_t)TP * 4);
constexpr size_t O_SSQ2 = O_RSTDKV + al256((size_t)TP * 4);
constexpr size_t O_SSQ3 = O_SSQ2 + al256((size_t)TR * 4);
constexpr size_t O_CTL = O_SSQ3 + al256((size_t)TR * 4);
constexpr size_t O_WEND = O_CTL + 65536;
static_assert(O_WEND <= 32 * MiB, "weight region");
constexpr size_t ROWB = (size_t)TP * 512 * 2;
constexpr size_t O_P = 32 * MiB;
constexpr size_t O_Q = O_P;
constexpr size_t O_V = O_Q + al256((size_t)TP * 768 * 2);
constexpr size_t O_EW = O_V + ROWB;
constexpr size_t O_B = O_EW + ROWB;
static_assert(O_B + ROWB <= O_P + al256((size_t)TP * NIN * 2), "aliases inside P");
constexpr size_t O_U1 = 193 * MiB;
constexpr size_t O_R = O_U1;
constexpr size_t O_VV = O_R + ROWB;
static_assert(O_P + al256((size_t)TP * NIN * 2) <= O_U1 && O_VV + ROWB <= 258 * MiB, "U1 region");
constexpr size_t O_KK = 258 * MiB;
constexpr size_t O_KMOD = O_KK + ROWB;
constexpr size_t O_LIN = O_KMOD + ROWB;
constexpr size_t O_CQKV = O_LIN + al256((size_t)TP * 384 * 2);
constexpr size_t O_K = O_CQKV + al256((size_t)TP * 640 * 2);
constexpr size_t O_G = O_K + al256((size_t)TP * 768 * 2);
constexpr size_t O_END1 = O_G + ROWB;
static_assert(O_END1 <= 512 * MiB, "ws");
constexpr size_t O_Y = O_LIN;
static_assert(O_Y + (size_t)TR * DM * 2 <= O_K, "Y alias");
constexpr size_t O_H2B = O_P;
constexpr size_t O_ACT = O_P + 64 * MiB;
static_assert(O_ACT + (size_t)TR * DFF * 2 <= O_Y, "ACT alias");
static_assert((size_t)TP * 512 * 4 <= (size_t)TR * DM * 4, "YRAW in d_out");

struct Params {
    const float* in[26];
    float* out;
    unsigned char* ws;
};

__device__ __forceinline__ unsigned f2bf(float f) { unsigned u = __builtin_bit_cast(unsigned, f); return (u + 0x7fffu + ((u >> 16) & 1u)) >> 16; }
__device__ __forceinline__ float bf2f(unsigned h) { return __builtin_bit_cast(float, h << 16); }
__device__ __forceinline__ unsigned pk2(float lo, float hi) { return f2bf(lo) | (f2bf(hi) << 16); }
__device__ __forceinline__ float wave_sum(float v) {
#pragma unroll
    for (int o = 1; o < 64; o <<= 1) v += __shfl_xor(v, o);
    return v;
}
__device__ __forceinline__ float sigmoidf_(float x) { return 1.f / (1.f + __expf(-x)); }
__device__ __forceinline__ int row_pos(int row) { int p = row % LP - LPAD; return p < 0 ? 0 : p; }

__constant__ double c_inv_freq[32] = {
    1.0, 0.7498942093324559, 0.5623413251903491, 0.4216965034285822, 0.31622776601683794, 0.23713737056616552, 0.1778279410038923, 0.1333521432163324,
    0.1, 0.07498942093324558, 0.05623413251903491, 0.04216965034285822, 0.03162277660168379, 0.023713737056616554, 0.01778279410038923, 0.01333521432163324,
    0.01, 0.007498942093324559, 0.005623413251903491, 0.004216965034285823, 0.0031622776601683794, 0.0023713737056616554, 0.0017782794100389228, 0.001333521432163324,
    0.001, 0.0007498942093324559, 0.0005623413251903491, 0.0004216965034285822, 0.00031622776601683794, 0.00023713737056616554, 0.00017782794100389227, 0.0001333521432163324};

__device__ __forceinline__ void sincos_d(double a, float& s, float& c) {
    const double q = __builtin_rint(a * 0.6366197723675814);
    double r = __builtin_fma(-q, 1.5707963267948966, a);
    r = __builtin_fma(-q, 6.123233995736766e-17, r);
    const double r2 = r * r;
    double sp = -1.0 / 1307674368000.0;
    sp = sp * r2 + 1.0 / 6227020800.0; sp = sp * r2 - 1.0 / 39916800.0; sp = sp * r2 + 1.0 / 362880.0; sp = sp * r2 - 1.0 / 5040.0; sp = sp * r2 + 1.0 / 120.0; sp = sp * r2 - 1.0 / 6.0;
    const double sn = r + r * r2 * sp;
    double cp = 1.0 / 87178291200.0;
    cp = cp * r2 - 1.0 / 479001600.0; cp = cp * r2 + 1.0 / 3628800.0; cp = cp * r2 - 1.0 / 40320.0; cp = cp * r2 + 1.0 / 720.0; cp = cp * r2 - 1.0 / 24.0; cp = cp * r2 + 0.5;
    const double cs = 1.0 - r2 * cp;
    const int qi = ((int)q) & 3;
    const double ss = (qi == 0) ? sn : (qi == 1) ? cs : (qi == 2) ? -sn : -cs;
    const double cc = (qi == 0) ? cs : (qi == 1) ? -sn : (qi == 2) ? -cs : sn;
    s = (float)ss; c = (float)cc;
}

struct SrcWin { const float* w; __device__ float operator()(int k, int n) const {
        if (n >= NIN) return 0.f; int ns = n;
        if (n >= 2464) { const int j = n - 2464; ns = 2464 + (j >> 1) + 32 * (j & 1); }
        return w[(size_t)k * NIN + ns]; } };
struct SrcWuq { const float* w; const float* g; __device__ float operator()(int k, int n) const {
        const int h = n / DQK, c = n % DQK; int cs = c; if (c >= 128) { const int j = c - 128; cs = 128 + (j >> 1) + 32 * (j & 1); }
        return w[(size_t)k * 768 + h * DQK + cs] * g[k]; } };
struct SrcWukv { const float* w; const float* g; __device__ float operator()(int k, int n) const { return w[(size_t)k * 1024 + n] * g[k]; } };
struct SrcLwa { const float* w2; const float* a2; __device__ float operator()(int k, int n) const {
        if (n < 512) return k < 64 ? w2[(size_t)k * 512 + n] : 0.f;
        return k >= 64 ? a2[(size_t)(k - 64) * 512 + (n - 512)] : 0.f; } };
struct SrcLg { const float* g2; __device__ float operator()(int k, int n) const { return k < 160 ? g2[(size_t)k * 512 + n] : 0.f; } };
struct SrcWout { const float* w; __device__ float operator()(int k, int n) const { return w[(size_t)k * DM + n]; } };
struct SrcWgu { const float* wg; const float* wu; const float* g; __device__ float operator()(int k, int n) const {
        const int j = n >> 8, c = n & 255; const float v = c < 128 ? wg[(size_t)k * DFF + 128 * j + c] : wu[(size_t)k * DFF + 128 * j + (c - 128)];
        return v * g[k]; } };
struct SrcWdn { const float* w; __device__ float operator()(int k, int n) const { return w[(size_t)k * DM + n]; } };

template <class F>
__device__ __forceinline__ void wconv_item(const F& f, bf16_t* WT, int K, int nblk, int item, float* scr, int lane) {
    const int kb = item / nblk, nb = item % nblk, k0 = 64 * kb, n0 = 32 * nb;
#pragma unroll 8
    for (int i = 0; i < 32; ++i) { const int kk = 2 * i + (lane >> 5); scr[kk * 33 + (lane & 31)] = f(k0 + kk, n0 + (lane & 31)); }
    asm volatile("s_waitcnt lgkmcnt(0)" ::: "memory");
    const int c = lane & 7;
#pragma unroll
    for (int j = 0; j < 4; ++j) { const int n = (lane >> 3) + 8 * j; const float* s = scr + (8 * c) * 33 + n;
        u32x4 o; o.x = pk2(s[0 * 33], s[1 * 33]); o.y = pk2(s[2 * 33], s[3 * 33]); o.z = pk2(s[4 * 33], s[5 * 33]); o.w = pk2(s[6 * 33], s[7 * 33]);
        *(u32x4*)(WT + (size_t)(n0 + n) * K + k0 + 8 * c) = o; }
    asm volatile("s_waitcnt lgkmcnt(0)" ::: "memory");
}

__device__ __forceinline__ void p0_phase(const Params& p, float* scr_all, int gw, int ngw, int lane, int wave_in_block) {
    float* scr = scr_all + wave_in_block * (64 * 33);
    unsigned char* ws = p.ws;
    constexpr int I0 = (DM / 64) * (NINP / 32), I1 = (QL / 64) * (768 / 32), I2 = (KVL / 64) * (1024 / 32), I3 = (128 / 64) * (1024 / 32), I4 = (256 / 64) * (512 / 32),
                  I5 = (DM / 64) * (DM / 32), I6 = (DM / 64) * (2 * DFF / 32), I7 = (DFF / 64) * (DM / 32);
    constexpr int NIT = I0 + I1 + I2 + I3 + I4 + I5 + I6 + I7;
    for (int it = gw; it < NIT; it += ngw) {
        int r = it;
        if (r < I0) { wconv_item(SrcWin{p.in[3]}, (bf16_t*)(ws + O_WIN), DM, NINP / 32, r, scr, lane); continue; } r -= I0;
        if (r < I1) { wconv_item(SrcWuq{p.in[16], p.in[15]}, (bf16_t*)(ws + O_WUQ), QL, 768 / 32, r, scr, lane); continue; } r -= I1;
        if (r < I2) { wconv_item(SrcWukv{p.in[18], p.in[17]}, (bf16_t*)(ws + O_WUKV), KVL, 1024 / 32, r, scr, lane); continue; } r -= I2;
        if (r < I3) { wconv_item(SrcLwa{p.in[6], p.in[8]}, (bf16_t*)(ws + O_LWA), 128, 1024 / 32, r, scr, lane); continue; } r -= I3;
        if (r < I4) { wconv_item(SrcLg{p.in[9]}, (bf16_t*)(ws + O_LG), 256, 512 / 32, r, scr, lane); continue; } r -= I4;
        if (r < I5) { wconv_item(SrcWout{p.in[20]}, (bf16_t*)(ws + O_WOUT), DM, DM / 32, r, scr, lane); continue; } r -= I5;
        if (r < I6) { wconv_item(SrcWgu{p.in[22], p.in[23], p.in[21]}, (bf16_t*)(ws + O_WGU), DM, 2 * DFF / 32, r, scr, lane); continue; } r -= I6;
        wconv_item(SrcWdn{p.in[24]}, (bf16_t*)(ws + O_WDN), DFF, DM / 32, r, scr, lane);
    }
    const float* x = p.in[0]; const float* meta = p.in[1]; const float* g1 = p.in[2];
    bf16_t* U1 = (bf16_t*)(ws + O_U1);
    for (int row = gw; row < TP; row += ngw) {
        const int b = row / LP, pr = row % LP - LPAD;
        u32x2* o = (u32x2*)(U1 + (size_t)row * DM) + lane;
        if (pr < 0) {
#pragma unroll
            for (int j = 0; j < 4; ++j) o[64 * j] = (u32x2){0u, 0u};
            continue;
        }
        const float* src = pr < NMETA ? meta + (size_t)pr * DM : x + ((size_t)b * SEQ + (pr - NMETA)) * DM;
        const f32x4* xr = (const f32x4*)src + lane;
        f32x4 v[4]; float s = 0.f;
#pragma unroll
        for (int j = 0; j < 4; ++j) { v[j] = xr[64 * j]; s += (v[j].x * v[j].x + v[j].y * v[j].y) + (v[j].z * v[j].z + v[j].w * v[j].w); }
        const float rstd = 1.0f / sqrtf(wave_sum(s) * (1.f / DM) + RMS_EPS);
#pragma unroll
        for (int j = 0; j < 4; ++j) { const f32x4 g = ((const f32x4*)g1)[lane + 64 * j];
            o[64 * j] = (u32x2){pk2(v[j].x * rstd * g.x, v[j].y * rstd * g.y), pk2(v[j].z * rstd * g.z, v[j].w * rstd * g.w)}; }
    }
    float* rope = (float*)(ws + O_ROPE);
    for (int i = gw * 64 + lane; i < L * 32; i += ngw * 64) {
        const int pos = i >> 5, f = i & 31; float s, c; sincos_d((double)pos * c_inv_freq[f], s, c);
        rope[2 * i] = c; rope[2 * i + 1] = s;
    }
    float* ssq = (float*)(ws + O_SSQ2);
    for (int i = gw * 64 + lane; i < (int)((O_CTL - O_SSQ2) / 4); i += ngw * 64) ssq[i] = 0.f;
}

__global__ void __launch_bounds__(512) k_p0(Params p) {
    __shared__ float scr[8 * 64 * 33];
    const int lane = threadIdx.x & 63, w = threadIdx.x >> 6;
    p0_phase(p, scr, blockIdx.x * 8 + w, gridDim.x * 8, lane, w);
}

struct EpiP {
    bf16_t* P;
    __device__ __forceinline__ void operator()(int row, int col, float v) const { if (col < NIN) P[(size_t)row * NIN + col] = (bf16_t)f2bf(v); }
};
struct EpiQ {
    bf16_t* Q; const float* rstd; const float* rope;
    __device__ __forceinline__ void pair(int row, int col, float v0, float v1) const {
        const float rs = rstd[row] * QSCALE; v0 *= rs; v1 *= rs;
        const int c = col % DQK;
        if (c >= 128) { const int i = (c - 128) >> 1; const float* t = rope + ((size_t)row_pos(row) * 32 + i) * 2; const float cs = t[0], sn = t[1];
            const float a = v0 * cs - v1 * sn, b = v1 * cs + v0 * sn; v0 = a; v1 = b; }
        *(unsigned*)(Q + (size_t)row * 768 + col) = pk2(v0, v1);
    }
};
struct EpiKV {
    bf16_t* K; bf16_t* V; const float* rstd;
    __device__ __forceinline__ void operator()(int row, int col, float v) const {
        v *= rstd[row]; const int h = col >> 8, c = col & 255;
        if (c < 128) K[(size_t)row * 768 + h * DQK + c] = (bf16_t)f2bf(v); else V[(size_t)row * 512 + h * DV + (c - 128)] = (bf16_t)f2bf(v);
    }
};
struct EpiLwa {
    f16_t* EW; f16_t* KMOD; const f16_t* KK; f16_t* Bv; const float* w0; const float* a0; const float* k_a;
    __device__ __forceinline__ void operator()(int row, int col, float v) const {
        if (col < 512) {
            const float xx = w0[col] + v;
            const float sp = (-xx > 20.f) ? -xx : log1pf(__expf(-xx));
            const float w = -sp - 0.5f;
            EW[(size_t)row * 512 + col] = (f16_t)__expf(w);
        } else {
            const int c = col - 512; const float a = sigmoidf_(a0[c] + v);
            const size_t idx = (size_t)row * 512 + c; const float k = (float)KMOD[idx], kk = (float)KK[idx];
            KMOD[idx] = (f16_t)(k * (1.f + (a - 1.f) * k_a[c])); Bv[idx] = (f16_t)(kk * a);
        }
    }
};
struct EpiG { bf16_t* G; __device__ __forceinline__ void operator()(int row, int col, float v) const { G[(size_t)row * 512 + col] = (bf16_t)f2bf(v); } };
struct EpiOut {
    const float* x; float* H2; bf16_t* H2B;
    __device__ __forceinline__ float operator()(int row, int col, float v) const {
        const size_t idx = (size_t)row * DM + col; const float h = x[idx] + v; H2[idx] = h; H2B[idx] = (bf16_t)f2bf(h); return h * h; }
};
struct EpiAct {
    bf16_t* ACT; const float* ssq;
    __device__ __forceinline__ void gu(int row, int acol, float g, float u) const {
        const float rs = 1.0f / sqrtf(ssq[row] * (1.f / DM) + RMS_EPS); g *= rs; u *= rs;
        ACT[(size_t)row * DFF + acol] = (bf16_t)f2bf(g * sigmoidf_(g) * u); }
};
struct EpiDown {
    float* H;
    __device__ __forceinline__ float operator()(int row, int col, float v) const { const size_t idx = (size_t)row * DM + col; const float h = H[idx] + v; H[idx] = h; return h * h; }
};

template <int MODE, class Epi>
__global__ void __launch_bounds__(256) k_gemm_naive(const bf16_t* A, int lda, const bf16_t* Bt, int ldb, int M, int N, int K, Epi E, float* ssq) {
    __shared__ float As[16][68], Bs[16][68];
    const int tid = threadIdx.x, ty = tid >> 4, tx = tid & 15;
    const int m0 = blockIdx.y * 64, n0 = blockIdx.x * 64;
    float acc[4][4];
#pragma unroll
    for (int i = 0; i < 4; ++i)
#pragma unroll
        for (int j = 0; j < 4; ++j) acc[i][j] = 0.f;
    const int lr = tid >> 2, lc = (tid & 3) * 4;
    for (int k0 = 0; k0 < K; k0 += 16) {
        const u32x2 av = *(const u32x2*)(A + (size_t)(m0 + lr) * lda + k0 + lc);
        const u32x2 bv = *(const u32x2*)(Bt + (size_t)(n0 + lr) * ldb + k0 + lc);
        As[lc + 0][lr] = bf2f(av.x & 0xffffu); As[lc + 1][lr] = bf2f(av.x >> 16); As[lc + 2][lr] = bf2f(av.y & 0xffffu); As[lc + 3][lr] = bf2f(av.y >> 16);
        Bs[lc + 0][lr] = bf2f(bv.x & 0xffffu); Bs[lc + 1][lr] = bf2f(bv.x >> 16); Bs[lc + 2][lr] = bf2f(bv.y & 0xffffu); Bs[lc + 3][lr] = bf2f(bv.y >> 16);
        __syncthreads();
#pragma unroll
        for (int kk = 0; kk < 16; ++kk) {
            const f32x4 a = *(const f32x4*)&As[kk][ty * 4]; const f32x4 b = *(const f32x4*)&Bs[kk][tx * 4];
#pragma unroll
            for (int i = 0; i < 4; ++i)
#pragma unroll
                for (int j = 0; j < 4; ++j) acc[i][j] += a[i] * b[j];
        }
        __syncthreads();
    }
#pragma unroll
    for (int i = 0; i < 4; ++i) {
        const int row = m0 + ty * 4 + i, col = n0 + tx * 4;
        if constexpr (MODE == 0) {
#pragma unroll
            for (int j = 0; j < 4; ++j) E(row, col + j, acc[i][j]);
        } else if constexpr (MODE == 1) {
            E.pair(row, col, acc[i][0], acc[i][1]); E.pair(row, col + 2, acc[i][2], acc[i][3]);
        } else if constexpr (MODE == 2) {
            float s = 0.f;
#pragma unroll
            for (int j = 0; j < 4; ++j) s += E(row, col + j, acc[i][j]);
#pragma unroll
            for (int o = 1; o < 16; o <<= 1) s += __shfl_xor(s, o);
            if (tx == 0) atomicAdd(ssq + row, s);
        }
    }
    (void)M; (void)N;
}
template <class Epi>
__global__ void __launch_bounds__(256) k_gemm_gu_naive(const bf16_t* A, int lda, const bf16_t* Bt, int ldb, int K, Epi E) {
    __shared__ float As[16][68], Bs[16][68], Cs[16][68];
    const int tid = threadIdx.x, ty = tid >> 4, tx = tid & 15;
    const int m0 = blockIdx.y * 64; const int j = blockIdx.x >> 1, half = blockIdx.x & 1;
    const int ng = 256 * j + 64 * half, nu = ng + 128;
    float ag[4][4], au[4][4];
#pragma unroll
    for (int i = 0; i < 4; ++i)
#pragma unroll
        for (int q = 0; q < 4; ++q) { ag[i][q] = 0.f; au[i][q] = 0.f; }
    const int lr = tid >> 2, lc = (tid & 3) * 4;
    for (int k0 = 0; k0 < K; k0 += 16) {
        const u32x2 av = *(const u32x2*)(A + (size_t)(m0 + lr) * lda + k0 + lc);
        const u32x2 bv = *(const u32x2*)(Bt + (size_t)(ng + lr) * ldb + k0 + lc);
        const u32x2 cv = *(const u32x2*)(Bt + (size_t)(nu + lr) * ldb + k0 + lc);
        As[lc + 0][lr] = bf2f(av.x & 0xffffu); As[lc + 1][lr] = bf2f(av.x >> 16); As[lc + 2][lr] = bf2f(av.y & 0xffffu); As[lc + 3][lr] = bf2f(av.y >> 16);
        Bs[lc + 0][lr] = bf2f(bv.x & 0xffffu); Bs[lc + 1][lr] = bf2f(bv.x >> 16); Bs[lc + 2][lr] = bf2f(bv.y & 0xffffu); Bs[lc + 3][lr] = bf2f(bv.y >> 16);
        Cs[lc + 0][lr] = bf2f(cv.x & 0xffffu); Cs[lc + 1][lr] = bf2f(cv.x >> 16); Cs[lc + 2][lr] = bf2f(cv.y & 0xffffu); Cs[lc + 3][lr] = bf2f(cv.y >> 16);
        __syncthreads();
#pragma unroll
        for (int kk = 0; kk < 16; ++kk) {
            const f32x4 a = *(const f32x4*)&As[kk][ty * 4]; const f32x4 b = *(const f32x4*)&Bs[kk][tx * 4]; const f32x4 c = *(const f32x4*)&Cs[kk][tx * 4];
#pragma unroll
            for (int i = 0; i < 4; ++i)
#pragma unroll
                for (int q = 0; q < 4; ++q) { ag[i][q] += a[i] * b[q]; au[i][q] += a[i] * c[q]; }
        }
        __syncthreads();
    }
#pragma unroll
    for (int i = 0; i < 4; ++i)
#pragma unroll
        for (int q = 0; q < 4; ++q) E.gu(m0 + ty * 4 + i, 128 * j + 64 * half + tx * 4 + q, ag[i][q], au[i][q]);
}

__device__ __forceinline__ void p2_row(const Params& p, int row, int lane) {
    unsigned char* ws = p.ws;
    const bf16_t* P = (const bf16_t*)(ws + O_P);
    const bf16_t* cur = P + (size_t)row * NIN; const bf16_t* prv = cur - NIN;
    const bool has_prev = row > 0;
    const float* mu = p.in[4]; const float* k_k = p.in[10];
    f16_t* R = (f16_t*)(ws + O_R); f16_t* VV = (f16_t*)(ws + O_VV); f16_t* KK = (f16_t*)(ws + O_KK); f16_t* KM = (f16_t*)(ws + O_KMOD);
    bf16_t* LIN = (bf16_t*)(ws + O_LIN); bf16_t* CQKV = (bf16_t*)(ws + O_CQKV); bf16_t* Kb = (bf16_t*)(ws + O_K);
    float ssq_q = 0.f, ssq_kv = 0.f;
    for (int ch = lane; ch < 320; ch += 64) {
        const bool act = ch < 316; const int c0 = 8 * ch;
        float v[8];
        {
            u32x4 a = (u32x4){0u, 0u, 0u, 0u};
            if (act) a = *(const u32x4*)(cur + c0);
            v[0] = bf2f(a.x & 0xffffu); v[1] = bf2f(a.x >> 16); v[2] = bf2f(a.y & 0xffffu); v[3] = bf2f(a.y >> 16);
            v[4] = bf2f(a.z & 0xffffu); v[5] = bf2f(a.z >> 16); v[6] = bf2f(a.w & 0xffffu); v[7] = bf2f(a.w >> 16);
        }
        if (c0 < RCOLS) {
            u32x4 b = (u32x4){0u, 0u, 0u, 0u};
            if (act && has_prev) b = *(const u32x4*)(prv + c0);
            float q[8];
            q[0] = bf2f(b.x & 0xffffu); q[1] = bf2f(b.x >> 16); q[2] = bf2f(b.y & 0xffffu); q[3] = bf2f(b.y >> 16);
            q[4] = bf2f(b.z & 0xffffu); q[5] = bf2f(b.z >> 16); q[6] = bf2f(b.w & 0xffffu); q[7] = bf2f(b.w >> 16);
#pragma unroll
            for (int j = 0; j < 8; ++j) v[j] = v[j] + (q[j] - v[j]) * mu[c0 + j];
        }
        const bool isk = (c0 >= 512 && c0 < 1024);
        float ss = 0.f; float kkv[8];
        if (isk) {
#pragma unroll
            for (int j = 0; j < 8; ++j) { kkv[j] = v[j] * k_k[c0 - 512 + j]; ss += kkv[j] * kkv[j]; }
        }
        ss += __shfl_xor(ss, 1); ss += __shfl_xor(ss, 2); ss += __shfl_xor(ss, 4);
        if (!act) continue;
        if (c0 < 512) {
#pragma unroll
            for (int j = 0; j < 8; ++j) R[(size_t)row * 512 + c0 + j] = (f16_t)v[j];
        } else if (c0 < 1024) {
            const float inv = 1.f / fmaxf(sqrtf(ss), 1e-12f);
#pragma unroll
            for (int j = 0; j < 8; ++j) { KM[(size_t)row * 512 + c0 - 512 + j] = (f16_t)v[j]; KK[(size_t)row * 512 + c0 - 512 + j] = (f16_t)(kkv[j] * inv); }
        } else if (c0 < 1536) {
#pragma unroll
            for (int j = 0; j < 8; ++j) VV[(size_t)row * 512 + c0 - 1024 + j] = (f16_t)v[j];
        } else if (c0 < 1600) {
#pragma unroll
            for (int j = 0; j < 8; ++j) LIN[(size_t)row * 384 + c0 - 1536 + j] = (bf16_t)f2bf(tanhf(v[j]));
        } else if (c0 < 1664) {
#pragma unroll
            for (int j = 0; j < 8; ++j) LIN[(size_t)row * 384 + c0 - 1536 + j] = (bf16_t)f2bf(v[j]);
        } else if (c0 < 1824) {
#pragma unroll
            for (int j = 0; j < 8; ++j) LIN[(size_t)row * 384 + c0 - 1536 + j] = (bf16_t)f2bf(sigmoidf_(v[j]));
        } else if (c0 < 2208) {
#pragma unroll
            for (int j = 0; j < 8; ++j) { CQKV[(size_t)row * 640 + c0 - 1824 + j] = (bf16_t)f2bf(v[j]); ssq_q += v[j] * v[j]; }
        } else if (c0 < 2464) {
#pragma unroll
            for (int j = 0; j < 8; ++j) { CQKV[(size_t)row * 640 + c0 - 1824 + j] = (bf16_t)f2bf(v[j]); ssq_kv += v[j] * v[j]; }
        } else {
            const float* t = (const float*)(ws + O_ROPE) + ((size_t)row_pos(row) * 32 + ((c0 - 2464) >> 1)) * 2;
            float o[8];
#pragma unroll
            for (int j = 0; j < 4; ++j) { const float cs = t[2 * j], sn = t[2 * j + 1]; o[2 * j] = v[2 * j] * cs - v[2 * j + 1] * sn; o[2 * j + 1] = v[2 * j + 1] * cs + v[2 * j] * sn; }
            u32x4 w; w.x = pk2(o[0], o[1]); w.y = pk2(o[2], o[3]); w.z = pk2(o[4], o[5]); w.w = pk2(o[6], o[7]);
#pragma unroll
            for (int h = 0; h < NH; ++h) *(u32x4*)(Kb + (size_t)row * 768 + h * DQK + 128 + (c0 - 2464)) = w;
        }
    }
    if (lane < 12) *(u32x4*)(LIN + (size_t)row * 384 + 288 + 8 * lane) = (u32x4){0u, 0u, 0u, 0u};
    ssq_q = wave_sum(ssq_q); ssq_kv = wave_sum(ssq_kv);
    if (lane == 0) { ((float*)(ws + O_RSTDQ))[row] = 1.0f / sqrtf(ssq_q * (1.f / QL) + RMS_EPS); ((float*)(ws + O_RSTDKV))[row] = 1.0f / sqrtf(ssq_kv * (1.f / KVL) + RMS_EPS); }
}
__global__ void __launch_bounds__(512) k_p2(Params p) {
    const int lane = threadIdx.x & 63, gw = blockIdx.x * 8 + (threadIdx.x >> 6), ngw = gridDim.x * 8;
    for (int row = gw; row < TP; row += ngw) p2_row(p, row, lane);
}

__global__ void __launch_bounds__(256) k_scan_naive(Params p) {
    unsigned char* ws = p.ws;
    const f16_t* R = (const f16_t*)(ws + O_R); const f16_t* VV = (const f16_t*)(ws + O_VV); const f16_t* KK = (const f16_t*)(ws + O_KK); const f16_t* KM = (const f16_t*)(ws + O_KMOD);
    const f16_t* EW = (const f16_t*)(ws + O_EW); const f16_t* Bv = (const f16_t*)(ws + O_B);
    float* YRAW = p.out;
    const int bh = blockIdx.x >> 2, quarter = blockIdx.x & 3, b = bh >> 3, h = bh & 7;
    const int tid = threadIdx.x, il = tid >> 4, c = tid & 15, i = 16 * quarter + il;
    float S[4] = {0.f, 0.f, 0.f, 0.f};
    const size_t base = ((size_t)b * LP + LPAD) * 512 + h * 64;
    for (int t = 0; t < L; ++t) {
        const size_t o = base + (size_t)t * 512 + 4 * c;
        float w[4], kk[4], bb[4], k[4], r[4];
#pragma unroll
        for (int j = 0; j < 4; ++j) { w[j] = __expf(-(float)EW[o + j]); kk[j] = (float)KK[o + j]; bb[j] = (float)Bv[o + j]; k[j] = (float)KM[o + j]; r[j] = (float)R[o + j]; }
        const float v = (float)VV[base + (size_t)t * 512 + i];
        float sa = 0.f;
#pragma unroll
        for (int j = 0; j < 4; ++j) sa += S[j] * kk[j];
        sa += __shfl_xor(sa, 1); sa += __shfl_xor(sa, 2); sa += __shfl_xor(sa, 4); sa += __shfl_xor(sa, 8);
        sa = -sa;
        float y = 0.f;
#pragma unroll
        for (int j = 0; j < 4; ++j) { S[j] = S[j] * w[j] + sa * bb[j] + v * k[j]; y += S[j] * r[j]; }
        y += __shfl_xor(y, 1); y += __shfl_xor(y, 2); y += __shfl_xor(y, 4); y += __shfl_xor(y, 8);
        if (c == 0) YRAW[base + (size_t)t * 512 + i] = y;
    }
}

__global__ void __launch_bounds__(256) k_attn_naive(Params p) {
    extern __shared__ float sm[];
    float* Qs = sm;
    float* Ks = Qs + 64 * 192;
    float* Vs = Ks + 64 * 193;
    float* Ps = Vs + 64 * 128;
    unsigned char* ws = p.ws;
    const bf16_t* Q = (const bf16_t*)(ws + O_Q); const bf16_t* Kb = (const bf16_t*)(ws + O_K); const bf16_t* V = (const bf16_t*)(ws + O_V);
    bf16_t* Y = (bf16_t*)(ws + O_Y); const float* og = p.in[19];
    const int qt = blockIdx.x & 63, h = (blockIdx.x >> 6) & 3, b = blockIdx.x >> 8;
    const int tid = threadIdx.x;
    const size_t rb = (size_t)b * LP;
    const int qrow0 = 64 + 64 * qt;
    for (int i = tid; i < 64 * 192; i += 256) { const int r = i / 192, d = i % 192; Qs[i] = bf2f(Q[(rb + qrow0 + r) * 768 + h * DQK + d]); }
    const int qi = tid >> 2, sub = tid & 3;
    float m = -1e30f, l = 0.f; float o[32];
#pragma unroll
    for (int j = 0; j < 32; ++j) o[j] = 0.f;
    const int nkt = qt + 2;
    for (int kt = 0; kt < nkt; ++kt) {
        __syncthreads();
        for (int i = tid; i < 64 * 192; i += 256) { const int r = i / 192, d = i % 192; Ks[r * 193 + d] = bf2f(Kb[(rb + 64 * kt + r) * 768 + h * DQK + d]); }
        for (int i = tid; i < 64 * 128; i += 256) { const int r = i >> 7, d = i & 127; Vs[i] = bf2f(V[(rb + 64 * kt + r) * 512 + h * DV + d]); }
        __syncthreads();
        float sc[16]; float mx = -1e30f;
#pragma unroll
        for (int kk = 0; kk < 16; ++kk) {
            const int key = sub + 4 * kk; float s = 0.f;
            for (int d = 0; d < 192; ++d) s += Qs[qi * 192 + d] * Ks[key * 193 + d];
            const int krow = 64 * kt + key;
            if (krow < LPAD || krow > qrow0 + qi) s = -1e30f;
            sc[kk] = s; mx = fmaxf(mx, s);
        }
        mx = fmaxf(mx, __shfl_xor(mx, 1)); mx = fmaxf(mx, __shfl_xor(mx, 2));
        const float mn = fmaxf(m, mx), scale = exp2f(m - mn);
        float ps = 0.f;
#pragma unroll
        for (int kk = 0; kk < 16; ++kk) { const float pv = (sc[kk] <= -1e29f) ? 0.f : exp2f(sc[kk] - mn); Ps[qi * 65 + sub + 4 * kk] = pv; ps += pv; }
        ps += __shfl_xor(ps, 1); ps += __shfl_xor(ps, 2);
        l = l * scale + ps; m = mn;
        __syncthreads();
#pragma unroll
        for (int j = 0; j < 32; ++j) o[j] *= scale;
        for (int key = 0; key < 64; ++key) { const float pv = Ps[qi * 65 + key];
#pragma unroll
            for (int j = 0; j < 32; ++j) o[j] += pv * Vs[key * 128 + sub * 32 + j]; }
    }
    const float il = 1.f / l; float ss = 0.f;
#pragma unroll
    for (int j = 0; j < 32; ++j) { o[j] *= il; ss += o[j] * o[j]; }
    ss += __shfl_xor(ss, 1); ss += __shfl_xor(ss, 2);
    const float rs = 1.0f / sqrtf(ss * (1.f / DV) + RMS_EPS);
    const size_t yrow = (size_t)b * SEQ + 64 * qt + qi;
#pragma unroll
    for (int j = 0; j < 32; ++j) Y[yrow * DM + 512 + h * DV + sub * 32 + j] = (bf16_t)f2bf(o[j] * rs * og[h * DV + sub * 32 + j]);
}

__global__ void __launch_bounds__(512) k_p5(Params p) {
    unsigned char* ws = p.ws;
    const float* YRAW = p.out;
    const f16_t* R = (const f16_t*)(ws + O_R); const f16_t* VV = (const f16_t*)(ws + O_VV); const f16_t* KM = (const f16_t*)(ws + O_KMOD); const bf16_t* G = (const bf16_t*)(ws + O_G);
    bf16_t* Y = (bf16_t*)(ws + O_Y);
    const float* r_k = p.in[12]; const float* ln_w = p.in[13]; const float* ln_b = p.in[14];
    const int lane = threadIdx.x & 63, gw = blockIdx.x * 8 + (threadIdx.x >> 6), ngw = gridDim.x * 8;
    for (int it = gw; it < TR * RH; it += ngw) {
        const int rr = it >> 3, h = it & 7, b = rr / SEQ, s = rr % SEQ;
        const size_t idx = ((size_t)b * LP + 64 + s) * 512 + h * 64 + lane;
        const float y = YRAW[idx];
        const float mean = wave_sum(y) * (1.f / 64.f); const float d = y - mean; const float var = wave_sum(d * d) * (1.f / 64.f);
        const float r = (float)R[idx], k = (float)KM[idx], v = (float)VV[idx];
        const float bonus = wave_sum(r * k * r_k[h * 64 + lane]);
        float yo = d * (1.0f / sqrtf(var + GN_EPS)) * ln_w[h * 64 + lane] + ln_b[h * 64 + lane] + bonus * v;
        yo *= bf2f(G[idx]);
        Y[(size_t)rr * DM + h * 64 + lane] = (bf16_t)f2bf(yo);
    }
}

__global__ void __launch_bounds__(512) k_p9(Params p) {
    const float* ssq = (const float*)(p.ws + O_SSQ3); const float* g = p.in[25];
    const int lane = threadIdx.x & 63, gw = blockIdx.x * 8 + (threadIdx.x >> 6), ngw = gridDim.x * 8;
    for (int row = gw; row < TR; row += ngw) {
        const float rs = 1.0f / sqrtf(ssq[row] * (1.f / DM) + RMS_EPS);
        f32x4* o = (f32x4*)(p.out + (size_t)row * DM) + lane;
#pragma unroll
        for (int j = 0; j < 4; ++j) { const f32x4 gv = ((const f32x4*)g)[lane + 64 * j]; f32x4 v = o[64 * j]; v = v * rs * gv; o[64 * j] = v; }
    }
}

extern "C" void kernel_launch(void* const* d_in, const int* in_sizes, int n_in, void* d_out, int out_size, void* d_ws, size_t ws_size, hipStream_t stream) {
    if (n_in != 26 || out_size != TR * DM || ws_size < 512 * MiB) { fprintf(stderr, "kernel_launch: unexpected sizes n_in=%d out=%d ws=%zu\n", n_in, out_size, ws_size); return; }
    Params p{};
    for (int i = 0; i < 26; ++i) p.in[i] = (const float*)d_in[i];
    p.out = (float*)d_out; p.ws = (unsigned char*)d_ws;
    unsigned char* ws = p.ws;
    k_p0<<<256, 512, 0, stream>>>(p);
    k_gemm_naive<0, EpiP><<<dim3(NINP / 64, TP / 64), 256, 0, stream>>>((const bf16_t*)(ws + O_U1), DM, (const bf16_t*)(ws + O_WIN), DM, TP, NINP, DM, EpiP{(bf16_t*)(ws + O_P)}, nullptr);
    k_p2<<<512, 512, 0, stream>>>(p);
    k_gemm_naive<1, EpiQ><<<dim3(768 / 64, TP / 64), 256, 0, stream>>>((const bf16_t*)(ws + O_CQKV), 640, (const bf16_t*)(ws + O_WUQ), QL, TP, 768, QL,
        EpiQ{(bf16_t*)(ws + O_Q), (const float*)(ws + O_RSTDQ), (const float*)(ws + O_ROPE)}, nullptr);
    k_gemm_naive<0, EpiKV><<<dim3(1024 / 64, TP / 64), 256, 0, stream>>>((const bf16_t*)(ws + O_CQKV) + 384, 640, (const bf16_t*)(ws + O_WUKV), KVL, TP, 1024, KVL,
        EpiKV{(bf16_t*)(ws + O_K), (bf16_t*)(ws + O_V), (const float*)(ws + O_RSTDKV)}, nullptr);
    k_gemm_naive<0, EpiLwa><<<dim3(1024 / 64, TP / 64), 256, 0, stream>>>((const bf16_t*)(ws + O_LIN), 384, (const bf16_t*)(ws + O_LWA), 128, TP, 1024, 128,
        EpiLwa{(f16_t*)(ws + O_EW), (f16_t*)(ws + O_KMOD), (const f16_t*)(ws + O_KK), (f16_t*)(ws + O_B), p.in[5], p.in[7], p.in[11]}, nullptr);
    k_gemm_naive<0, EpiG><<<dim3(512 / 64, TP / 64), 256, 0, stream>>>((const bf16_t*)(ws + O_LIN) + 128, 384, (const bf16_t*)(ws + O_LG), 256, TP, 512, 256, EpiG{(bf16_t*)(ws + O_G)}, nullptr);
    k_scan_naive<<<NB * RH * 4, 256, 0, stream>>>(p);
    {
        const size_t smem = (size_t)(64 * 192 + 64 * 193 + 64 * 128 + 64 * 65) * 4;
        static bool attr_done = false;
        if (!attr_done) { (void)hipFuncSetAttribute((const void*)k_attn_naive, hipFuncAttributeMaxDynamicSharedMemorySize, (int)smem); attr_done = true; }
        k_attn_naive<<<NB * NH * 64, 256, smem, stream>>>(p);
    }
    k_p5<<<1024, 512, 0, stream>>>(p);
    k_gemm_naive<2, EpiOut><<<dim3(DM / 64, TR / 64), 256, 0, stream>>>((const bf16_t*)(ws + O_Y), DM, (const bf16_t*)(ws + O_WOUT), DM, TR, DM, DM,
        EpiOut{p.in[0], p.out, (bf16_t*)(ws + O_H2B)}, (float*)(ws + O_SSQ2));
    k_gemm_gu_naive<EpiAct><<<dim3(2 * DFF / 128, TR / 64), 256, 0, stream>>>((const bf16_t*)(ws + O_H2B), DM, (const bf16_t*)(ws + O_WGU), DM, DM, EpiAct{(bf16_t*)(ws + O_ACT), (const float*)(ws + O_SSQ2)});
    k_gemm_naive<2, EpiDown><<<dim3(DM / 64, TR / 64), 256, 0, stream>>>((const bf16_t*)(ws + O_ACT), DFF, (const bf16_t*)(ws + O_WDN), DFF, TR, DM, DFF, EpiDown{p.out}, (float*)(ws + O_SSQ3));
    k_p9<<<1024, 512, 0, stream>>>(p);
}
```

```cpp
#include <hip/hip_runtime.h>
#include <hip/hip_cooperative_groups.h>
namespace cg = cooperative_groups;
#include <cstdio>
#include <cstdint>

typedef unsigned short bf16_t;
typedef _Float16 f16_t;
typedef float f32x4 __attribute__((ext_vector_type(4)));
typedef unsigned u32x4 __attribute__((ext_vector_type(4)));
typedef unsigned u32x2 __attribute__((ext_vector_type(2)));

constexpr int NB = 8, SEQ = 4096, DM = 1024, NMETA = 16, L = SEQ + NMETA;
constexpr int LPAD = 48, LP = L + LPAD;
constexpr int TP = NB * LP;
constexpr int TR = NB * SEQ;
constexpr int NIN = 2528, NINP = 2560, RW = 512, RCOLS = 1824;
constexpr int QL = 384, KVL = 256, DQK = 192, DV = 128, NH = 4, RH = 8, RN = 64;
constexpr int DFF = 2816;
constexpr float RMS_EPS = 1e-6f, GN_EPS = 64e-5f;
constexpr float QSCALE = 0.07216878364870323f * 1.4426950408889634f;

constexpr size_t MiB = 1u << 20;
constexpr size_t al256(size_t x) { return (x + 255) & ~(size_t)255; }
constexpr size_t O_WIN = 0;
constexpr size_t O_WUQ = O_WIN + al256((size_t)NINP * DM * 2);
constexpr size_t O_WUKV = O_WUQ + al256((size_t)768 * QL * 2);
constexpr size_t O_LWA = O_WUKV + al256((size_t)1024 * KVL * 2);
constexpr size_t O_LG = O_LWA + al256((size_t)1024 * 256 * 2);
constexpr size_t O_WOUT = O_LG + al256((size_t)512 * 256 * 2);
constexpr size_t O_WGU = O_WOUT + al256((size_t)DM * DM * 2);
constexpr size_t O_WDN = O_WGU + al256((size_t)2 * DFF * DM * 2);
constexpr size_t O_ROPE = O_WDN + al256((size_t)DM * DFF * 2);
constexpr size_t O_RSTDQ = O_ROPE + al256((size_t)L * 32 * 8);
constexpr size_t O_RSTDKV = O_RSTDQ + al256((size_t)TP * 4);
constexpr size_t O_SSQ2 = O_RSTDKV + al256((size_t)TP * 4);
constexpr size_t O_SSQ3 = O_SSQ2 + al256((size_t)TR * 4);
constexpr size_t O_CTL = O_SSQ3 + al256((size_t)TR * 4);
constexpr size_t O_WEND = O_CTL + 65536;
static_assert(O_WEND <= 32 * MiB, "weight region");
constexpr size_t ROWB = (size_t)TP * 512 * 2;
constexpr size_t O_P = 32 * MiB;
constexpr size_t O_Q = O_P;
constexpr size_t O_V = O_Q + al256((size_t)TP * 768 * 2);
constexpr size_t O_EW = O_V + ROWB;
constexpr size_t O_B = O_EW + ROWB;
static_assert(O_B + ROWB <= O_P + al256((size_t)TP * NIN * 2), "aliases inside P");
constexpr size_t O_U1 = 193 * MiB;
constexpr size_t O_R = O_U1;
constexpr size_t O_VV = O_R + ROWB;
static_assert(O_P + al256((size_t)TP * NIN * 2) <= O_U1 && O_VV + ROWB <= 258 * MiB, "U1 region");
constexpr size_t O_KK = 258 * MiB;
constexpr size_t O_KMOD = O_KK + ROWB;
constexpr size_t O_LIN = O_KMOD + ROWB;
constexpr size_t O_CQKV = O_LIN + al256((size_t)TP * 384 * 2);
constexpr size_t O_K = O_CQKV + al256((size_t)TP * 640 * 2);
constexpr size_t O_G = O_K + al256((size_t)TP * 768 * 2);
constexpr size_t O_END1 = O_G + ROWB;
static_assert(O_END1 <= 512 * MiB, "ws");
constexpr size_t O_Y = O_LIN;
static_assert(O_Y + (size_t)TR * DM * 2 <= O_K, "Y alias");
constexpr size_t O_H2B = O_P;
constexpr size_t O_ACT = O_P + 64 * MiB;
static_assert(O_ACT + (size_t)TR * DFF * 2 <= O_Y, "ACT alias");
static_assert((size_t)TP * 512 * 4 <= (size_t)TR * DM * 4, "YRAW in d_out");

struct Params {
    const float* in[26];
    float* out;
    unsigned char* ws;
};

__device__ __forceinline__ unsigned f2bf(float f) { unsigned u = __builtin_bit_cast(unsigned, f); return (u + 0x7fffu + ((u >> 16) & 1u)) >> 16; }
__device__ __forceinline__ float bf2f(unsigned h) { return __builtin_bit_cast(float, h << 16); }
__device__ __forceinline__ unsigned pk2(float lo, float hi) { return f2bf(lo) | (f2bf(hi) << 16); }
__device__ __forceinline__ float wave_sum(float v) {
#pragma unroll
    for (int o = 1; o < 64; o <<= 1) v += __shfl_xor(v, o);
    return v;
}
__device__ __forceinline__ float sigmoidf_(float x) { return 1.f / (1.f + __expf(-x)); }
__device__ __forceinline__ int row_pos(int row) { int p = row % LP - LPAD; return p < 0 ? 0 : p; }

__constant__ double c_inv_freq[32] = {
    1.0, 0.7498942093324559, 0.5623413251903491, 0.4216965034285822, 0.31622776601683794, 0.23713737056616552, 0.1778279410038923, 0.1333521432163324,
    0.1, 0.07498942093324558, 0.05623413251903491, 0.04216965034285822, 0.03162277660168379, 0.023713737056616554, 0.01778279410038923, 0.01333521432163324,
    0.01, 0.007498942093324559, 0.005623413251903491, 0.004216965034285823, 0.0031622776601683794, 0.0023713737056616554, 0.0017782794100389228, 0.001333521432163324,
    0.001, 0.0007498942093324559, 0.0005623413251903491, 0.0004216965034285822, 0.00031622776601683794, 0.00023713737056616554, 0.00017782794100389227, 0.0001333521432163324};

__device__ __forceinline__ void sincos_d(double a, float& s, float& c) {
    const double q = __builtin_rint(a * 0.6366197723675814);
    double r = __builtin_fma(-q, 1.5707963267948966, a);
    r = __builtin_fma(-q, 6.123233995736766e-17, r);
    const double r2 = r * r;
    double sp = -1.0 / 1307674368000.0;
    sp = sp * r2 + 1.0 / 6227020800.0; sp = sp * r2 - 1.0 / 39916800.0; sp = sp * r2 + 1.0 / 362880.0; sp = sp * r2 - 1.0 / 5040.0; sp = sp * r2 + 1.0 / 120.0; sp = sp * r2 - 1.0 / 6.0;
    const double sn = r + r * r2 * sp;
    double cp = 1.0 / 87178291200.0;
    cp = cp * r2 - 1.0 / 479001600.0; cp = cp * r2 + 1.0 / 3628800.0; cp = cp * r2 - 1.0 / 40320.0; cp = cp * r2 + 1.0 / 720.0; cp = cp * r2 - 1.0 / 24.0; cp = cp * r2 + 0.5;
    const double cs = 1.0 - r2 * cp;
    const int qi = ((int)q) & 3;
    const double ss = (qi == 0) ? sn : (qi == 1) ? cs : (qi == 2) ? -sn : -cs;
    const double cc = (qi == 0) ? cs : (qi == 1) ? -sn : (qi == 2) ? -cs : sn;
    s = (float)ss; c = (float)cc;
}

struct SrcWin { const float* w; __device__ float operator()(int k, int n) const {
        if (n >= NIN) return 0.f; int ns = n;
        if (n >= 2464) { const int j = n - 2464; ns = 2464 + (j >> 1) + 32 * (j & 1); }
        return w[(size_t)k * NIN + ns]; } };
struct SrcWuq { const float* w; const float* g; __device__ float operator()(int k, int n) const {
        const int h = n / DQK, c = n % DQK; int cs = c; if (c >= 128) { const int j = c - 128; cs = 128 + (j >> 1) + 32 * (j & 1); }
        return w[(size_t)k * 768 + h * DQK + cs] * g[k]; } };
struct SrcWukv { const float* w; const float* g; __device__ float operator()(int k, int n) const { return w[(size_t)k * 1024 + n] * g[k]; } };
struct SrcLwa { const float* w2; const float* a2; __device__ float operator()(int k, int n) const {
        if (n < 512) return k < 64 ? w2[(size_t)k * 512 + n] : 0.f;
        return (k >= 64 && k < 128) ? a2[(size_t)(k - 64) * 512 + (n - 512)] : 0.f; } };
struct SrcLg { const float* g2; __device__ float operator()(int k, int n) const { return k < 160 ? g2[(size_t)k * 512 + n] : 0.f; } };
struct SrcWout { const float* w; __device__ float operator()(int k, int n) const { return w[(size_t)k * DM + n]; } };
struct SrcWgu { const float* wg; const float* wu; const float* g; __device__ float operator()(int k, int n) const {
        const int j = n >> 8, c = n & 255; const float v = c < 128 ? wg[(size_t)k * DFF + 128 * j + c] : wu[(size_t)k * DFF + 128 * j + (c - 128)];
        return v * g[k]; } };
struct SrcWdn { const float* w; __device__ float operator()(int k, int n) const { return w[(size_t)k * DM + n]; } };

template <class F>
__device__ __forceinline__ void wconv_item(const F& f, bf16_t* WT, int K, int nblk, int item, float* scr, int lane) {
    const int kb = item / nblk, nb = item % nblk, k0 = 64 * kb, n0 = 32 * nb;
#pragma unroll 8
    for (int i = 0; i < 32; ++i) { const int kk = 2 * i + (lane >> 5); scr[kk * 33 + (lane & 31)] = f(k0 + kk, n0 + (lane & 31)); }
    asm volatile("s_waitcnt lgkmcnt(0)" ::: "memory");
    const int c = lane & 7;
#pragma unroll
    for (int j = 0; j < 4; ++j) { const int n = (lane >> 3) + 8 * j; const float* s = scr + (8 * c) * 33 + n;
        u32x4 o; o.x = pk2(s[0 * 33], s[1 * 33]); o.y = pk2(s[2 * 33], s[3 * 33]); o.z = pk2(s[4 * 33], s[5 * 33]); o.w = pk2(s[6 * 33], s[7 * 33]);
        *(u32x4*)(WT + (size_t)(n0 + n) * K + k0 + 8 * c) = o; }
    asm volatile("s_waitcnt lgkmcnt(0)" ::: "memory");
}

__device__ __forceinline__ void p0_phase(const Params& p, float* scr_all, int gw, int ngw, int lane, int wave_in_block) {
    float* scr = scr_all + wave_in_block * (64 * 33);
    unsigned char* ws = p.ws;
    constexpr int I0 = (DM / 64) * (NINP / 32), I1 = (QL / 64) * (768 / 32), I2 = (KVL / 64) * (1024 / 32), I3 = (256 / 64) * (1024 / 32), I4 = (256 / 64) * (512 / 32),
                  I5 = (DM / 64) * (DM / 32), I6 = (DM / 64) * (2 * DFF / 32), I7 = (DFF / 64) * (DM / 32);
    constexpr int NIT = I0 + I1 + I2 + I3 + I4 + I5 + I6 + I7;
    for (int it = gw; it < NIT; it += ngw) {
        int r = it;
        if (r < I0) { wconv_item(SrcWin{p.in[3]}, (bf16_t*)(ws + O_WIN), DM, NINP / 32, r, scr, lane); continue; } r -= I0;
        if (r < I1) { wconv_item(SrcWuq{p.in[16], p.in[15]}, (bf16_t*)(ws + O_WUQ), QL, 768 / 32, r, scr, lane); continue; } r -= I1;
        if (r < I2) { wconv_item(SrcWukv{p.in[18], p.in[17]}, (bf16_t*)(ws + O_WUKV), KVL, 1024 / 32, r, scr, lane); continue; } r -= I2;
        if (r < I3) { wconv_item(SrcLwa{p.in[6], p.in[8]}, (bf16_t*)(ws + O_LWA), 256, 1024 / 32, r, scr, lane); continue; } r -= I3;
        if (r < I4) { wconv_item(SrcLg{p.in[9]}, (bf16_t*)(ws + O_LG), 256, 512 / 32, r, scr, lane); continue; } r -= I4;
        if (r < I5) { wconv_item(SrcWout{p.in[20]}, (bf16_t*)(ws + O_WOUT), DM, DM / 32, r, scr, lane); continue; } r -= I5;
        if (r < I6) { wconv_item(SrcWgu{p.in[22], p.in[23], p.in[21]}, (bf16_t*)(ws + O_WGU), DM, 2 * DFF / 32, r, scr, lane); continue; } r -= I6;
        wconv_item(SrcWdn{p.in[24]}, (bf16_t*)(ws + O_WDN), DFF, DM / 32, r, scr, lane);
    }
    const float* x = p.in[0]; const float* meta = p.in[1]; const float* g1 = p.in[2];
    bf16_t* U1 = (bf16_t*)(ws + O_U1);
    for (int row = gw; row < TP; row += ngw) {
        const int b = row / LP, pr = row % LP - LPAD;
        u32x2* o = (u32x2*)(U1 + (size_t)row * DM) + lane;
        if (pr < 0) {
#pragma unroll
            for (int j = 0; j < 4; ++j) o[64 * j] = (u32x2){0u, 0u};
            continue;
        }
        const float* src = pr < NMETA ? meta + (size_t)pr * DM : x + ((size_t)b * SEQ + (pr - NMETA)) * DM;
        const f32x4* xr = (const f32x4*)src + lane;
        f32x4 v[4]; float s = 0.f;
#pragma unroll
        for (int j = 0; j < 4; ++j) { v[j] = xr[64 * j]; s += (v[j].x * v[j].x + v[j].y * v[j].y) + (v[j].z * v[j].z + v[j].w * v[j].w); }
        const float rstd = 1.0f / sqrtf(wave_sum(s) * (1.f / DM) + RMS_EPS);
#pragma unroll
        for (int j = 0; j < 4; ++j) { const f32x4 g = ((const f32x4*)g1)[lane + 64 * j];
            o[64 * j] = (u32x2){pk2(v[j].x * rstd * g.x, v[j].y * rstd * g.y), pk2(v[j].z * rstd * g.z, v[j].w * rstd * g.w)}; }
    }
    float* rope = (float*)(ws + O_ROPE);
    for (int i = gw * 64 + lane; i < L * 32; i += ngw * 64) {
        const int pos = i >> 5, f = i & 31; float s, c; sincos_d((double)pos * c_inv_freq[f], s, c);
        rope[2 * i] = c; rope[2 * i + 1] = s;
    }
    float* ssq = (float*)(ws + O_SSQ2);
    for (int i = gw * 64 + lane; i < (int)((O_CTL - O_SSQ2) / 4); i += ngw * 64) ssq[i] = 0.f;
}

__device__ __forceinline__ void p2_row(const Params& p, int row, int lane) {
    unsigned char* ws = p.ws;
    const bf16_t* P = (const bf16_t*)(ws + O_P);
    const bf16_t* cur = P + (size_t)row * NIN; const bf16_t* prv = cur - NIN;
    const bool has_prev = row > 0;
    const float* mu = p.in[4]; const float* k_k = p.in[10];
    f16_t* R = (f16_t*)(ws + O_R); f16_t* VV = (f16_t*)(ws + O_VV); f16_t* KK = (f16_t*)(ws + O_KK); f16_t* KM = (f16_t*)(ws + O_KMOD);
    bf16_t* LIN = (bf16_t*)(ws + O_LIN); bf16_t* CQKV = (bf16_t*)(ws + O_CQKV); bf16_t* Kb = (bf16_t*)(ws + O_K);
    float ssq_q = 0.f, ssq_kv = 0.f;
    for (int ch = lane; ch < 320; ch += 64) {
        const bool act = ch < 316; const int c0 = 8 * ch;
        float v[8];
        {
            u32x4 a = (u32x4){0u, 0u, 0u, 0u};
            if (act) a = *(const u32x4*)(cur + c0);
            v[0] = bf2f(a.x & 0xffffu); v[1] = bf2f(a.x >> 16); v[2] = bf2f(a.y & 0xffffu); v[3] = bf2f(a.y >> 16);
            v[4] = bf2f(a.z & 0xffffu); v[5] = bf2f(a.z >> 16); v[6] = bf2f(a.w & 0xffffu); v[7] = bf2f(a.w >> 16);
        }
        if (c0 < RCOLS) {
            u32x4 b = (u32x4){0u, 0u, 0u, 0u};
            if (act && has_prev) b = *(const u32x4*)(prv + c0);
            float q[8];
            q[0] = bf2f(b.x & 0xffffu); q[1] = bf2f(b.x >> 16); q[2] = bf2f(b.y & 0xffffu); q[3] = bf2f(b.y >> 16);
            q[4] = bf2f(b.z & 0xffffu); q[5] = bf2f(b.z >> 16); q[6] = bf2f(b.w & 0xffffu); q[7] = bf2f(b.w >> 16);
#pragma unroll
            for (int j = 0; j < 8; ++j) v[j] = v[j] + (q[j] - v[j]) * mu[c0 + j];
        }
        const bool isk = (c0 >= 512 && c0 < 1024);
        float ss = 0.f; float kkv[8];
        if (isk) {
#pragma unroll
            for (int j = 0; j < 8; ++j) { kkv[j] = v[j] * k_k[c0 - 512 + j]; ss += kkv[j] * kkv[j]; }
        }
        ss += __shfl_xor(ss, 1); ss += __shfl_xor(ss, 2); ss += __shfl_xor(ss, 4);
        if (!act) continue;
        if (c0 < 512) {
#pragma unroll
            for (int j = 0; j < 8; ++j) R[(size_t)row * 512 + c0 + j] = (f16_t)v[j];
        } else if (c0 < 1024) {
            const float inv = 1.f / fmaxf(sqrtf(ss), 1e-12f);
#pragma unroll
            for (int j = 0; j < 8; ++j) { KM[(size_t)row * 512 + c0 - 512 + j] = (f16_t)v[j]; KK[(size_t)row * 512 + c0 - 512 + j] = (f16_t)(kkv[j] * inv); }
        } else if (c0 < 1536) {
#pragma unroll
            for (int j = 0; j < 8; ++j) VV[(size_t)row * 512 + c0 - 1024 + j] = (f16_t)v[j];
        } else if (c0 < 1600) {
#pragma unroll
            for (int j = 0; j < 8; ++j) LIN[(size_t)row * 384 + c0 - 1536 + j] = (bf16_t)f2bf(tanhf(v[j]));
        } else if (c0 < 1664) {
#pragma unroll
            for (int j = 0; j < 8; ++j) LIN[(size_t)row * 384 + c0 - 1536 + j] = (bf16_t)f2bf(v[j]);
        } else if (c0 < 1824) {
#pragma unroll
            for (int j = 0; j < 8; ++j) LIN[(size_t)row * 384 + c0 - 1536 + j] = (bf16_t)f2bf(sigmoidf_(v[j]));
        } else if (c0 < 2208) {
#pragma unroll
            for (int j = 0; j < 8; ++j) { CQKV[(size_t)row * 640 + c0 - 1824 + j] = (bf16_t)f2bf(v[j]); ssq_q += v[j] * v[j]; }
        } else if (c0 < 2464) {
#pragma unroll
            for (int j = 0; j < 8; ++j) { CQKV[(size_t)row * 640 + c0 - 1824 + j] = (bf16_t)f2bf(v[j]); ssq_kv += v[j] * v[j]; }
        } else {
            const float* t = (const float*)(ws + O_ROPE) + ((size_t)row_pos(row) * 32 + ((c0 - 2464) >> 1)) * 2;
            float o[8];
#pragma unroll
            for (int j = 0; j < 4; ++j) { const float cs = t[2 * j], sn = t[2 * j + 1]; o[2 * j] = v[2 * j] * cs - v[2 * j + 1] * sn; o[2 * j + 1] = v[2 * j + 1] * cs + v[2 * j] * sn; }
            u32x4 w; w.x = pk2(o[0], o[1]); w.y = pk2(o[2], o[3]); w.z = pk2(o[4], o[5]); w.w = pk2(o[6], o[7]);
#pragma unroll
            for (int h = 0; h < NH; ++h) *(u32x4*)(Kb + (size_t)row * 768 + h * DQK + 128 + (c0 - 2464)) = w;
        }
    }
    if (lane < 12) *(u32x4*)(LIN + (size_t)row * 384 + 288 + 8 * lane) = (u32x4){0u, 0u, 0u, 0u};
    ssq_q = wave_sum(ssq_q); ssq_kv = wave_sum(ssq_kv);
    if (lane == 0) { ((float*)(ws + O_RSTDQ))[row] = 1.0f / sqrtf(ssq_q * (1.f / QL) + RMS_EPS); ((float*)(ws + O_RSTDKV))[row] = 1.0f / sqrtf(ssq_kv * (1.f / KVL) + RMS_EPS); }
}
namespace pg8 {
#define PG8_LAS __attribute__((address_space(3)))
typedef short bf16x8 __attribute__((ext_vector_type(8)));
constexpr int BM = 256, BK = 64, HALF = 128, HTB = HALF * BK * 2, STAGE_BYTES = 8 * HTB, NXCD = 8, WGM = 8;
__host__ __device__ __forceinline__ int lds_byte(int r, int c) { const int st = (r >> 4) * 2 + (c >> 5), rr = r & 15, cc = c & 31, ob = rr * 64 + cc * 2; return st * 1024 + (ob ^ (((ob >> 9) & 1) << 5)); }
__host__ __device__ __forceinline__ void stage_rc(int b, int& R, int& C) { const int st = b / 1024, sb = b % 1024, swz = sb ^ (((sb >> 9) & 1) << 5); R = (st >> 1) * 16 + swz / 64; C = (st & 1) * 32 + (swz % 64) / 2; }
__host__ __device__ __forceinline__ int perm32(int rho) { const int n = rho >> 4, i = rho & 15; return 8 * (i >> 2) + 4 * n + (i & 3); }
struct Unit { int pm, pn; };
struct Gemm { const bf16_t* A; const bf16_t* Bt; int lda, ldb, K; };
struct StaticOrder {
    int nM, nN, nwg, G, c;
    __host__ __device__ void init(int M, int N, int G_, int c_) { nM = M / BM; nN = N / BM; nwg = nM * nN; G = G_; c = c_; }
    __host__ __device__ bool next(int i, Unit& u) const {
        const long L = (long)i * G + c; if (L >= nwg) return false;
        int wgid = (int)L; { const int q = nwg / NXCD, r = nwg % NXCD, xcd = wgid % NXCD, off = wgid / NXCD; wgid = (xcd < r ? xcd * (q + 1) : r * (q + 1) + (xcd - r) * q) + off; }
        const int nig = WGM * nN, gid = wgid / nig, fm = gid * WGM, gsz = (nM - fm) < WGM ? (nM - fm) : WGM;
        u.pm = fm + ((wgid % nig) % gsz); u.pn = (wgid % nig) / gsz; return true;
    }
};
template <class F> struct Epi8 {
    F f;
    __device__ __forceinline__ void operator()(const f32x4 (&acc)[2][2][4][2], const Unit& u, int wr, int wc, int fr, int fq) const {
        const int col = u.pn * BM + wc * 32 + 8 * fq;
#pragma unroll
        for (int ai = 0; ai < 2; ++ai)
#pragma unroll
            for (int m = 0; m < 4; ++m) f(u.pm * BM + ai * HALF + wr * 64 + m * 16 + fr, col, acc[ai][0][m][0], acc[ai][0][m][1], acc[ai][1][m][0], acc[ai][1][m][1]);
    }
};

template <class Epi, bool ALIGN_EPI>
__device__ __forceinline__ void gemm_phase(PG8_LAS unsigned char* lds, const Gemm g, const StaticOrder& S, const Epi& E) {
    const int tid = threadIdx.x, wid = __builtin_amdgcn_readfirstlane(tid >> 6), lane = tid & 63, wr = wid >> 2, wc = wid & 3, fr = lane & 15, fq = lane >> 4;
    const int K = g.K, nt = K / BK;
    unsigned voffA[2], voffB[2];
#pragma unroll
    for (int i = 0; i < 2; ++i) { int R, C; stage_rc(tid * 16 + i * 8192, R, C); const int Rb = (R & ~31) + perm32(R & 31);
        voffA[i] = (unsigned)(R * g.lda + C) * 2u; voffB[i] = (unsigned)(Rb * g.ldb + C) * 2u; }
    const size_t kstep = (size_t)(BK * 2);
    const size_t hstepA = (size_t)HALF * g.lda * 2, hstepB = (size_t)HALF * g.ldb * 2;
    const size_t tstepA = 2 * hstepA, tstepB = 2 * hstepB;
    const unsigned ldsw = (unsigned)wid * 1024u;
    const int aoff = lds_byte(wr * 64 + fr, fq * 8), boff = lds_byte(wc * 32 + fr, fq * 8);
#define PG8_SA(b, h) (((b) * 2 + (h)) * HTB)
#define PG8_SB(b, h) ((4 + (b) * 2 + (h)) * HTB)
#define PG8_STAGE(bufoff, gbase, voff) do { _Pragma("unroll") for (int _i = 0; _i < 2; ++_i) \
        __builtin_amdgcn_global_load_lds((const unsigned*)((const char*)(gbase) + (voff)[_i]), (PG8_LAS unsigned*)(lds + (bufoff) + ldsw + _i * 8192), 16, 0, 0); } while (0)
#define PG8_LDA(dst, b, h) do { _Pragma("unroll") for (int m = 0; m < 4; ++m) _Pragma("unroll") for (int k = 0; k < 2; ++k) dst[m][k] = *(const PG8_LAS bf16x8*)(lds + PG8_SA(b, h) + aoff + m * 2048 + k * 1024); } while (0)
#define PG8_LDB(dst, b, h) do { _Pragma("unroll") for (int n = 0; n < 2; ++n) _Pragma("unroll") for (int k = 0; k < 2; ++k) dst[n][k] = *(const PG8_LAS bf16x8*)(lds + PG8_SB(b, h) + boff + n * 2048 + k * 1024); } while (0)
#define PG8_MMA(ai, bj, At, Bt) do { __builtin_amdgcn_s_setprio(1); _Pragma("unroll") for (int m = 0; m < 4; ++m) _Pragma("unroll") for (int n = 0; n < 2; ++n) _Pragma("unroll") for (int k = 0; k < 2; ++k) \
        acc[ai][bj][m][n] = __builtin_amdgcn_mfma_f32_16x16x32_bf16(Bt[n][k], At[m][k], acc[ai][bj][m][n], 0, 0, 0); __builtin_amdgcn_s_setprio(0); } while (0)
#define PG8_WAIT_V(n) asm volatile("s_waitcnt vmcnt(" #n ")" ::: "memory")
#define PG8_WAIT_L(n) asm volatile("s_waitcnt lgkmcnt(" #n ")" ::: "memory")
#define PG8_BAR __builtin_amdgcn_s_barrier()
#define PG8_SCHED __builtin_amdgcn_sched_barrier(0)
    Unit cur, nxt; int ui = 0;
    if (!S.next(0, cur)) return;
    f32x4 acc[2][2][4][2];
#pragma unroll
    for (int a = 0; a < 2; ++a)
#pragma unroll
        for (int b = 0; b < 2; ++b)
#pragma unroll
            for (int m = 0; m < 4; ++m)
#pragma unroll
                for (int n = 0; n < 2; ++n) acc[a][b][m][n] = (f32x4){0.f, 0.f, 0.f, 0.f};
    bf16x8 At[4][2], B0[2][2], B1[2][2];
    const char* cA = (const char*)g.A + (size_t)cur.pm * tstepA; const char* cB = (const char*)g.Bt + (size_t)cur.pn * tstepB;
    PG8_STAGE(PG8_SB(0, 0), cB, voffB); PG8_STAGE(PG8_SB(0, 1), cB + hstepB, voffB); PG8_STAGE(PG8_SA(0, 0), cA, voffA); PG8_STAGE(PG8_SA(0, 1), cA + hstepA, voffA);
    if (wr == 1) PG8_BAR;
    PG8_WAIT_V(2); PG8_BAR;
    PG8_STAGE(PG8_SB(1, 0), cB + kstep, voffB); PG8_STAGE(PG8_SA(1, 0), cA + kstep, voffA); PG8_STAGE(PG8_SB(1, 1), cB + hstepB + kstep, voffB);
    PG8_WAIT_V(6); PG8_BAR;
#pragma nounroll
    for (;;) {
        const bool has_next = S.next(ui + 1, nxt);
        const char* nA = has_next ? (const char*)g.A + (size_t)nxt.pm * tstepA : cA; const char* nB = has_next ? (const char*)g.Bt + (size_t)nxt.pn * tstepB : cB;
#pragma nounroll
        for (int t = 0; t < nt; t += 2) {
            const bool last = (t == nt - 2);
            const char* a1 = cA + (size_t)(t + 1) * kstep;
            const char* a2 = last ? nA : cA + (size_t)(t + 2) * kstep; const char* b2 = last ? nB : cB + (size_t)(t + 2) * kstep;
            const char* a3 = a2 + kstep; const char* b3 = b2 + kstep;
            PG8_LDB(B0, 0, 0); PG8_LDB(B1, 0, 1); PG8_SCHED; PG8_LDA(At, 0, 0); PG8_STAGE(PG8_SA(1, 1), a1 + hstepA, voffA);
            PG8_WAIT_V(8); PG8_WAIT_L(0); PG8_BAR; PG8_MMA(0, 0, At, B0); PG8_MMA(0, 1, At, B1); PG8_BAR; PG8_SCHED;
            PG8_LDA(At, 0, 1); PG8_STAGE(PG8_SB(0, 0), b2, voffB); PG8_STAGE(PG8_SB(0, 1), b2 + hstepB, voffB); PG8_STAGE(PG8_SA(0, 0), a2, voffA);
            PG8_WAIT_V(8); PG8_WAIT_L(0); PG8_BAR; PG8_MMA(1, 0, At, B0); PG8_MMA(1, 1, At, B1); PG8_BAR; PG8_SCHED;
            PG8_LDB(B0, 1, 0); PG8_LDB(B1, 1, 1); PG8_SCHED; PG8_LDA(At, 1, 0); PG8_STAGE(PG8_SA(0, 1), a2 + hstepA, voffA);
            PG8_WAIT_V(8); PG8_WAIT_L(0); PG8_BAR; PG8_MMA(0, 0, At, B0); PG8_MMA(0, 1, At, B1); PG8_BAR; PG8_SCHED;
            PG8_LDA(At, 1, 1); PG8_STAGE(PG8_SB(1, 0), b3, voffB); PG8_STAGE(PG8_SB(1, 1), b3 + hstepB, voffB); PG8_STAGE(PG8_SA(1, 0), a3, voffA);
            PG8_WAIT_V(8); PG8_WAIT_L(0); PG8_BAR; PG8_MMA(1, 0, At, B0); PG8_MMA(1, 1, At, B1); PG8_BAR; PG8_SCHED;
        }
        if constexpr (ALIGN_EPI) { if (wr == 0) PG8_BAR; }
        E(acc, cur, wr, wc, fr, fq);
        if (!has_next) break;
#pragma unroll
        for (int a = 0; a < 2; ++a)
#pragma unroll
            for (int b = 0; b < 2; ++b)
#pragma unroll
                for (int m = 0; m < 4; ++m)
#pragma unroll
                    for (int n = 0; n < 2; ++n) acc[a][b][m][n] = (f32x4){0.f, 0.f, 0.f, 0.f};
        cur = nxt; cA = nA; cB = nB; ++ui;
        if constexpr (ALIGN_EPI) { if (wr == 1) PG8_BAR; }
    }
    PG8_WAIT_V(0);
    if constexpr (!ALIGN_EPI) { if (wr == 0) PG8_BAR; }
    PG8_BAR;
#undef PG8_SA
#undef PG8_SB
#undef PG8_STAGE
#undef PG8_LDA
#undef PG8_LDB
#undef PG8_MMA
#undef PG8_WAIT_V
#undef PG8_WAIT_L
#undef PG8_BAR
#undef PG8_SCHED
}
}

__device__ __forceinline__ u32x4 pack8(const f32x4& a0, const f32x4& a1) { u32x4 w; w.x = pk2(a0[0], a0[1]); w.y = pk2(a0[2], a0[3]); w.z = pk2(a1[0], a1[1]); w.w = pk2(a1[2], a1[3]); return w; }
typedef _Float16 f16x8 __attribute__((ext_vector_type(8)));
struct FP {
    bf16_t* P;
    __device__ __forceinline__ void operator()(int row, int col, const f32x4& a0, const f32x4& a1, const f32x4& b0, const f32x4& b1) const {
        if (col < NIN) *(u32x4*)(P + (size_t)row * NIN + col) = pack8(a0, a1);
        if (col + 128 < NIN) *(u32x4*)(P + (size_t)row * NIN + col + 128) = pack8(b0, b1);
    }
};
struct FQ {
    bf16_t* Q; const float* rstd; const float* rope;
    __device__ __forceinline__ void one(int row, int col, float rs, f32x4 a0, f32x4 a1) const {
        a0 = a0 * rs; a1 = a1 * rs;
        const int c = col % DQK;
        if (c >= 128) { const f32x4* t = (const f32x4*)(rope + ((size_t)row_pos(row) * 32 + ((c - 128) >> 1)) * 2); const f32x4 t0 = t[0], t1 = t[1];
            f32x4 o0, o1;
            o0[0] = a0[0] * t0[0] - a0[1] * t0[1]; o0[1] = a0[1] * t0[0] + a0[0] * t0[1]; o0[2] = a0[2] * t0[2] - a0[3] * t0[3]; o0[3] = a0[3] * t0[2] + a0[2] * t0[3];
            o1[0] = a1[0] * t1[0] - a1[1] * t1[1]; o1[1] = a1[1] * t1[0] + a1[0] * t1[1]; o1[2] = a1[2] * t1[2] - a1[3] * t1[3]; o1[3] = a1[3] * t1[2] + a1[2] * t1[3];
            a0 = o0; a1 = o1; }
        *(u32x4*)(Q + (size_t)row * 768 + col) = pack8(a0, a1);
    }
    __device__ __forceinline__ void operator()(int row, int col, const f32x4& a0, const f32x4& a1, const f32x4& b0, const f32x4& b1) const {
        const float rs = rstd[row] * QSCALE; one(row, col, rs, a0, a1); one(row, col + 128, rs, b0, b1); }
};
struct FKV {
    bf16_t* K; bf16_t* V; const float* rstd;
    __device__ __forceinline__ void one(int row, int col, float rs, const f32x4& a0, const f32x4& a1) const {
        const int h = col >> 8, c = col & 255; const u32x4 w = pack8(a0 * rs, a1 * rs);
        if (c < 128) *(u32x4*)(K + (size_t)row * 768 + h * DQK + c) = w; else *(u32x4*)(V + (size_t)row * 512 + h * DV + (c - 128)) = w; }
    __device__ __forceinline__ void operator()(int row, int col, const f32x4& a0, const f32x4& a1, const f32x4& b0, const f32x4& b1) const {
        const float rs = rstd[row]; one(row, col, rs, a0, a1); one(row, col + 128, rs, b0, b1); }
};
struct FLwa {
    f16_t* EW; f16_t* KMOD; const f16_t* KK; f16_t* Bv; const float* w0; const float* a0p; const float* k_a;
    __device__ __forceinline__ void one(int row, int col, const f32x4& a0, const f32x4& a1) const {
        float v[8] = {a0[0], a0[1], a0[2], a0[3], a1[0], a1[1], a1[2], a1[3]};
        if (col < 512) {
            f16x8 o;
#pragma unroll
            for (int j = 0; j < 8; ++j) { const float xx = w0[col + j] + v[j]; const float sp = (-xx > 20.f) ? -xx : __logf(1.f + __expf(-xx)); o[j] = (f16_t)__expf(-sp - 0.5f); }
            *(f16x8*)(EW + (size_t)row * 512 + col) = o;
        } else {
            const int c = col - 512; const size_t idx = (size_t)row * 512 + c;
            const f16x8 kv = *(const f16x8*)(KMOD + idx), kkv = *(const f16x8*)(KK + idx); f16x8 ko, bo;
#pragma unroll
            for (int j = 0; j < 8; ++j) { const float a = sigmoidf_(a0p[c + j] + v[j]); ko[j] = (f16_t)((float)kv[j] * (1.f + (a - 1.f) * k_a[c + j])); bo[j] = (f16_t)((float)kkv[j] * a); }
            *(f16x8*)(KMOD + idx) = ko; *(f16x8*)(Bv + idx) = bo;
        }
    }
    __device__ __forceinline__ void operator()(int row, int col, const f32x4& a0, const f32x4& a1, const f32x4& b0, const f32x4& b1) const { one(row, col, a0, a1); one(row, col + 128, b0, b1); }
};
struct FG { bf16_t* G;
    __device__ __forceinline__ void operator()(int row, int col, const f32x4& a0, const f32x4& a1, const f32x4& b0, const f32x4& b1) const {
        *(u32x4*)(G + (size_t)row * 512 + col) = pack8(a0, a1); *(u32x4*)(G + (size_t)row * 512 + col + 128) = pack8(b0, b1); } };
struct FOut {
    const float* x; float* H2; bf16_t* H2B; float* ssq;
    __device__ __forceinline__ float one(size_t idx, const f32x4& a0, const f32x4& a1) const {
        const f32x4 h0 = *(const f32x4*)(x + idx) + a0, h1 = *(const f32x4*)(x + idx + 4) + a1;
        *(f32x4*)(H2 + idx) = h0; *(f32x4*)(H2 + idx + 4) = h1; *(u32x4*)(H2B + idx) = pack8(h0, h1);
        return (h0[0] * h0[0] + h0[1] * h0[1]) + (h0[2] * h0[2] + h0[3] * h0[3]) + (h1[0] * h1[0] + h1[1] * h1[1]) + (h1[2] * h1[2] + h1[3] * h1[3]); }
    __device__ __forceinline__ void operator()(int row, int col, const f32x4& a0, const f32x4& a1, const f32x4& b0, const f32x4& b1) const {
        float s = one((size_t)row * DM + col, a0, a1) + one((size_t)row * DM + col + 128, b0, b1);
        s += __shfl_xor(s, 16); s += __shfl_xor(s, 32);
        if ((threadIdx.x & 63) < 16) atomicAdd(ssq + row, s); }
};
struct FAct {
    bf16_t* ACT; const float* ssq;
    __device__ __forceinline__ void operator()(int row, int col, const f32x4& a0, const f32x4& a1, const f32x4& b0, const f32x4& b1) const {
        const float rs = 1.0f / sqrtf(ssq[row] * (1.f / DM) + RMS_EPS);
        f32x4 o0, o1;
#pragma unroll
        for (int j = 0; j < 4; ++j) { const float g0 = a0[j] * rs, g1 = a1[j] * rs; o0[j] = g0 * sigmoidf_(g0) * (b0[j] * rs); o1[j] = g1 * sigmoidf_(g1) * (b1[j] * rs); }
        *(u32x4*)(ACT + (size_t)row * DFF + (col >> 8) * 128 + (col & 127)) = pack8(o0, o1); }
};
struct FDown {
    float* H; float* ssq;
    __device__ __forceinline__ float one(size_t idx, const f32x4& a0, const f32x4& a1) const {
        const f32x4 h0 = *(const f32x4*)(H + idx) + a0, h1 = *(const f32x4*)(H + idx + 4) + a1; *(f32x4*)(H + idx) = h0; *(f32x4*)(H + idx + 4) = h1;
        return (h0[0] * h0[0] + h0[1] * h0[1]) + (h0[2] * h0[2] + h0[3] * h0[3]) + (h1[0] * h1[0] + h1[1] * h1[1]) + (h1[2] * h1[2] + h1[3] * h1[3]); }
    __device__ __forceinline__ void operator()(int row, int col, const f32x4& a0, const f32x4& a1, const f32x4& b0, const f32x4& b1) const {
        float s = one((size_t)row * DM + col, a0, a1) + one((size_t)row * DM + col + 128, b0, b1);
        s += __shfl_xor(s, 16); s += __shfl_xor(s, 32);
        if ((threadIdx.x & 63) < 16) atomicAdd(ssq + row, s); }
};

__device__ __forceinline__ void scan_simple_unit(const Params& p, int unit, int t256) {
    unsigned char* ws = p.ws;
    const f16_t* R = (const f16_t*)(ws + O_R); const f16_t* VV = (const f16_t*)(ws + O_VV); const f16_t* KK = (const f16_t*)(ws + O_KK); const f16_t* KM = (const f16_t*)(ws + O_KMOD);
    const f16_t* EW = (const f16_t*)(ws + O_EW); const f16_t* Bv = (const f16_t*)(ws + O_B);
    float* YRAW = p.out;
    const int bh = unit >> 2, quarter = unit & 3, b = bh >> 3, h = bh & 7;
    const int il = t256 >> 4, c = t256 & 15, i = 16 * quarter + il;
    float S[4] = {0.f, 0.f, 0.f, 0.f};
    const size_t base = ((size_t)b * LP + LPAD) * 512 + h * 64;
    for (int t = 0; t < L; ++t) {
        const size_t o = base + (size_t)t * 512 + 4 * c;
        float w[4], kk[4], bb[4], k[4], r[4];
#pragma unroll
        for (int j = 0; j < 4; ++j) { w[j] = __expf(-(float)EW[o + j]); kk[j] = (float)KK[o + j]; bb[j] = (float)Bv[o + j]; k[j] = (float)KM[o + j]; r[j] = (float)R[o + j]; }
        const float v = (float)VV[base + (size_t)t * 512 + i];
        float sa = 0.f;
#pragma unroll
        for (int j = 0; j < 4; ++j) sa += S[j] * kk[j];
        sa += __shfl_xor(sa, 1); sa += __shfl_xor(sa, 2); sa += __shfl_xor(sa, 4); sa += __shfl_xor(sa, 8);
        sa = -sa;
        float y = 0.f;
#pragma unroll
        for (int j = 0; j < 4; ++j) { S[j] = S[j] * w[j] + sa * bb[j] + v * k[j]; y += S[j] * r[j]; }
        y += __shfl_xor(y, 1); y += __shfl_xor(y, 2); y += __shfl_xor(y, 4); y += __shfl_xor(y, 8);
        if (c == 0) YRAW[base + (size_t)t * 512 + i] = y;
    }
}

__device__ __forceinline__ void attn_simple_unit(const Params& p, float* sm, int unit, int tid) {
    float* Qs = sm;
    float* Ks = Qs + 64 * 192;
    float* Vs = Ks + 64 * 193;
    float* Ps = Vs + 64 * 128;
    unsigned char* ws = p.ws;
    const bf16_t* Q = (const bf16_t*)(ws + O_Q); const bf16_t* Kb = (const bf16_t*)(ws + O_K); const bf16_t* V = (const bf16_t*)(ws + O_V);
    bf16_t* Y = (bf16_t*)(ws + O_Y); const float* og = p.in[19];
    const int qt = unit & 63, h = (unit >> 6) & 3, b = unit >> 8;
    const size_t rb = (size_t)b * LP;
    const int qrow0 = 64 + 64 * qt;
    __syncthreads();
    for (int i = tid; i < 64 * 192; i += 512) { const int r = i / 192, d = i % 192; Qs[i] = bf2f(Q[(rb + qrow0 + r) * 768 + h * DQK + d]); }
    const int qi = (tid & 255) >> 2, sub = tid & 3; const bool act = tid < 256;
    float m = -1e30f, l = 0.f; float o[32];
#pragma unroll
    for (int j = 0; j < 32; ++j) o[j] = 0.f;
    const int nkt = qt + 2;
    for (int kt = 0; kt < nkt; ++kt) {
        __syncthreads();
        for (int i = tid; i < 64 * 192; i += 512) { const int r = i / 192, d = i % 192; Ks[r * 193 + d] = bf2f(Kb[(rb + 64 * kt + r) * 768 + h * DQK + d]); }
        for (int i = tid; i < 64 * 128; i += 512) { const int r = i >> 7, d = i & 127; Vs[i] = bf2f(V[(rb + 64 * kt + r) * 512 + h * DV + d]); }
        __syncthreads();
        float scale = 1.f;
        if (act) {
            float sc[16]; float mx = -1e30f;
#pragma unroll
            for (int kk = 0; kk < 16; ++kk) {
                const int key = sub + 4 * kk; float s = 0.f;
                for (int d = 0; d < 192; ++d) s += Qs[qi * 192 + d] * Ks[key * 193 + d];
                const int krow = 64 * kt + key;
                if (krow < LPAD || krow > qrow0 + qi) s = -1e30f;
                sc[kk] = s; mx = fmaxf(mx, s);
            }
            mx = fmaxf(mx, __shfl_xor(mx, 1)); mx = fmaxf(mx, __shfl_xor(mx, 2));
            const float mn = fmaxf(m, mx); scale = exp2f(m - mn);
            float ps = 0.f;
#pragma unroll
            for (int kk = 0; kk < 16; ++kk) { const float pv = (sc[kk] <= -1e29f) ? 0.f : exp2f(sc[kk] - mn); Ps[qi * 65 + sub + 4 * kk] = pv; ps += pv; }
            ps += __shfl_xor(ps, 1); ps += __shfl_xor(ps, 2);
            l = l * scale + ps; m = mn;
        }
        __syncthreads();
        if (act) {
#pragma unroll
            for (int j = 0; j < 32; ++j) o[j] *= scale;
            for (int key = 0; key < 64; ++key) { const float pv = Ps[qi * 65 + key];
#pragma unroll
                for (int j = 0; j < 32; ++j) o[j] += pv * Vs[key * 128 + sub * 32 + j]; }
        }
    }
    if (act) {
        const float il = 1.f / l; float ss = 0.f;
#pragma unroll
        for (int j = 0; j < 32; ++j) { o[j] *= il; ss += o[j] * o[j]; }
        ss += __shfl_xor(ss, 1); ss += __shfl_xor(ss, 2);
        const float rs = 1.0f / sqrtf(ss * (1.f / DV) + RMS_EPS);
        const size_t yrow = (size_t)b * SEQ + 64 * qt + qi;
#pragma unroll
        for (int j = 0; j < 32; ++j) Y[yrow * DM + 512 + h * DV + sub * 32 + j] = (bf16_t)f2bf(o[j] * rs * og[h * DV + sub * 32 + j]);
    }
}

__device__ __forceinline__ void p5_phase(const Params& p, int gw, int ngw, int lane) {
    unsigned char* ws = p.ws;
    const float* YRAW = p.out;
    const f16_t* R = (const f16_t*)(ws + O_R); const f16_t* VV = (const f16_t*)(ws + O_VV); const f16_t* KM = (const f16_t*)(ws + O_KMOD); const bf16_t* G = (const bf16_t*)(ws + O_G);
    bf16_t* Y = (bf16_t*)(ws + O_Y);
    const float* r_k = p.in[12]; const float* ln_w = p.in[13]; const float* ln_b = p.in[14];
    for (int it = gw; it < TR * RH; it += ngw) {
        const int rr = it >> 3, h = it & 7, b = rr / SEQ, s = rr % SEQ;
        const size_t idx = ((size_t)b * LP + 64 + s) * 512 + h * 64 + lane;
        const float y = YRAW[idx];
        const float mean = wave_sum(y) * (1.f / 64.f); const float d = y - mean; const float var = wave_sum(d * d) * (1.f / 64.f);
        const float r = (float)R[idx], k = (float)KM[idx], v = (float)VV[idx];
        const float bonus = wave_sum(r * k * r_k[h * 64 + lane]);
        float yo = d * (1.0f / sqrtf(var + GN_EPS)) * ln_w[h * 64 + lane] + ln_b[h * 64 + lane] + bonus * v;
        yo *= bf2f(G[idx]);
        Y[(size_t)rr * DM + h * 64 + lane] = (bf16_t)f2bf(yo);
    }
}
__device__ __forceinline__ void p9_phase(const Params& p, int gw, int ngw, int lane) {
    const float* ssq = (const float*)(p.ws + O_SSQ3); const float* g = p.in[25];
    for (int row = gw; row < TR; row += ngw) {
        const float rs = 1.0f / sqrtf(ssq[row] * (1.f / DM) + RMS_EPS);
        f32x4* o = (f32x4*)(p.out + (size_t)row * DM) + lane;
#pragma unroll
        for (int j = 0; j < 4; ++j) { const f32x4 gv = ((const f32x4*)g)[lane + 64 * j]; f32x4 v = o[64 * j]; v = v * rs * gv; o[64 * j] = v; }
    }
}

#ifndef PH_MASK
#define PH_MASK 0xFFFF
#endif
#define PH(k) ((PH_MASK >> (k)) & 1)
constexpr int LDS_BYTES = 153600;
constexpr int LDS_MISC = LDS_BYTES - 256;
__global__ void __launch_bounds__(512, 2) mega_fwd(Params p) {
    extern __shared__ __attribute__((aligned(16))) unsigned char lds[];
    cg::grid_group grid = cg::this_grid();
    const int tid = threadIdx.x, lane = tid & 63, wave = tid >> 6;
    const int G = gridDim.x, gw = blockIdx.x * 8 + wave, ngw = G * 8;
    unsigned char* ws = p.ws;
    PG8_LAS unsigned char* ldsg = (PG8_LAS unsigned char*)lds;
    unsigned* ctl = (unsigned*)(ws + O_CTL);
    if (PH(0)) p0_phase(p, (float*)lds, gw, ngw, lane, wave);
    if (blockIdx.x == 0 && tid < 64) ctl[tid] = 0u;
    grid.sync();
    if (PH(1)) { pg8::Gemm g{(const bf16_t*)(ws + O_U1), (const bf16_t*)(ws + O_WIN), DM, DM, DM}; pg8::StaticOrder S; S.init(TP, NINP, G, blockIdx.x);
      pg8::Epi8<FP> E{FP{(bf16_t*)(ws + O_P)}}; pg8::gemm_phase<pg8::Epi8<FP>, true>(ldsg, g, S, E); }
    grid.sync();
    if (PH(2)) for (int row = gw; row < TP; row += ngw) p2_row(p, row, lane);
    grid.sync();
    if (PH(3)) { pg8::Gemm g{(const bf16_t*)(ws + O_CQKV), (const bf16_t*)(ws + O_WUQ), 640, QL, QL}; pg8::StaticOrder S; S.init(TP, 768, G, blockIdx.x);
      pg8::Epi8<FQ> E{FQ{(bf16_t*)(ws + O_Q), (const float*)(ws + O_RSTDQ), (const float*)(ws + O_ROPE)}}; pg8::gemm_phase<pg8::Epi8<FQ>, true>(ldsg, g, S, E); }
    if (PH(4)) { pg8::Gemm g{(const bf16_t*)(ws + O_CQKV) + 384, (const bf16_t*)(ws + O_WUKV), 640, KVL, KVL}; pg8::StaticOrder S; S.init(TP, 1024, G, blockIdx.x);
      pg8::Epi8<FKV> E{FKV{(bf16_t*)(ws + O_K), (bf16_t*)(ws + O_V), (const float*)(ws + O_RSTDKV)}}; pg8::gemm_phase<pg8::Epi8<FKV>, true>(ldsg, g, S, E); }
    if (PH(5)) { pg8::Gemm g{(const bf16_t*)(ws + O_LIN), (const bf16_t*)(ws + O_LWA), 384, 256, 256}; pg8::StaticOrder S; S.init(TP, 1024, G, blockIdx.x);
      pg8::Epi8<FLwa> E{FLwa{(f16_t*)(ws + O_EW), (f16_t*)(ws + O_KMOD), (const f16_t*)(ws + O_KK), (f16_t*)(ws + O_B), p.in[5], p.in[7], p.in[11]}}; pg8::gemm_phase<pg8::Epi8<FLwa>, true>(ldsg, g, S, E); }
    if (PH(6)) { pg8::Gemm g{(const bf16_t*)(ws + O_LIN) + 128, (const bf16_t*)(ws + O_LG), 384, 256, 256}; pg8::StaticOrder S; S.init(TP, 512, G, blockIdx.x);
      pg8::Epi8<FG> E{FG{(bf16_t*)(ws + O_G)}}; pg8::gemm_phase<pg8::Epi8<FG>, true>(ldsg, g, S, E); }
    grid.sync();
    if (PH(7)) if (blockIdx.x < 128) scan_simple_unit(p, blockIdx.x * 2 + (tid >> 8), tid & 255);
    if (PH(8)) {
        volatile unsigned* bc = (volatile unsigned*)(lds + LDS_MISC);
        for (;;) {
            __syncthreads();
            if (tid == 0) bc[0] = atomicAdd(ctl + 0, 1u);
            __syncthreads();
            const unsigned u = bc[0];
            if (u >= (unsigned)(NB * NH * 64)) break;
            const int qt = 63 - (int)(u >> 5), bh = (int)(u & 31);
            attn_simple_unit(p, (float*)lds, (bh << 6) | qt, tid);
        }
    }
    grid.sync();
    if (PH(9)) p5_phase(p, gw, ngw, lane);
    grid.sync();
    if (PH(10)) { pg8::Gemm g{(const bf16_t*)(ws + O_Y), (const bf16_t*)(ws + O_WOUT), DM, DM, DM}; pg8::StaticOrder S; S.init(TR, DM, G, blockIdx.x);
      pg8::Epi8<FOut> E{FOut{p.in[0], p.out, (bf16_t*)(ws + O_H2B), (float*)(ws + O_SSQ2)}}; pg8::gemm_phase<pg8::Epi8<FOut>, true>(ldsg, g, S, E); }
    grid.sync();
    if (PH(11)) { pg8::Gemm g{(const bf16_t*)(ws + O_H2B), (const bf16_t*)(ws + O_WGU), DM, DM, DM}; pg8::StaticOrder S; S.init(TR, 2 * DFF, G, blockIdx.x);
      pg8::Epi8<FAct> E{FAct{(bf16_t*)(ws + O_ACT), (const float*)(ws + O_SSQ2)}}; pg8::gemm_phase<pg8::Epi8<FAct>, true>(ldsg, g, S, E); }
    grid.sync();
    if (PH(12)) { pg8::Gemm g{(const bf16_t*)(ws + O_ACT), (const bf16_t*)(ws + O_WDN), DFF, DFF, DFF}; pg8::StaticOrder S; S.init(TR, DM, G, blockIdx.x);
      pg8::Epi8<FDown> E{FDown{p.out, (float*)(ws + O_SSQ3)}}; pg8::gemm_phase<pg8::Epi8<FDown>, true>(ldsg, g, S, E); }
    grid.sync();
    if (PH(13)) p9_phase(p, gw, ngw, lane);
}

extern "C" void kernel_launch(void* const* d_in, const int* in_sizes, int n_in, void* d_out, int out_size, void* d_ws, size_t ws_size, hipStream_t stream) {
    static int grid_blocks = 0;
    if (grid_blocks == 0) {
        if (n_in != 26 || out_size != TR * DM || ws_size < 512 * MiB) { fprintf(stderr, "kernel_launch: unexpected sizes n_in=%d out=%d ws=%zu\n", n_in, out_size, ws_size); grid_blocks = -1; return; }
        int dev = 0, cus = 0, per_cu = 0;
        (void)hipGetDevice(&dev); (void)hipDeviceGetAttribute(&cus, hipDeviceAttributeMultiprocessorCount, dev);
        (void)hipFuncSetAttribute((const void*)mega_fwd, hipFuncAttributeMaxDynamicSharedMemorySize, LDS_BYTES);
        (void)hipOccupancyMaxActiveBlocksPerMultiprocessor(&per_cu, (const void*)mega_fwd, 512, LDS_BYTES);
        if (per_cu < 1) { fprintf(stderr, "kernel_launch: occupancy query says %d blocks per CU\n", per_cu); per_cu = 1; }
        if (per_cu > 1) per_cu = 1;
        grid_blocks = cus * per_cu;
    }
    if (grid_blocks < 0) return;
    Params p{};
    for (int i = 0; i < 26; ++i) p.in[i] = (const float*)d_in[i];
    p.out = (float*)d_out; p.ws = (unsigned char*)d_ws;
    void* args[] = {&p};
    hipError_t e = hipLaunchCooperativeKernel((const void*)mega_fwd, dim3(grid_blocks), dim3(512), args, LDS_BYTES, stream);
    if (e != hipSuccess) fprintf(stderr, "cooperative launch failed: %s (grid %d)\n", hipGetErrorString(e), grid_blocks);
}
```

```cpp
#include <hip/hip_runtime.h>
#include <hip/hip_cooperative_groups.h>
namespace cg = cooperative_groups;
#include <cstdio>
#include <cstdint>

typedef unsigned short bf16_t;
typedef _Float16 f16_t;
typedef float f32x4 __attribute__((ext_vector_type(4)));
typedef unsigned u32x4 __attribute__((ext_vector_type(4)));
typedef unsigned u32x2 __attribute__((ext_vector_type(2)));

constexpr int NB = 8, SEQ = 4096, DM = 1024, NMETA = 16, L = SEQ + NMETA;
constexpr int LPAD = 48, LP = L + LPAD;
constexpr int TP = NB * LP;
constexpr int TR = NB * SEQ;
constexpr int NIN = 2528, NINP = 2560, RW = 512, RCOLS = 1824;
constexpr int QL = 384, KVL = 256, DQK = 192, DV = 128, NH = 4, RH = 8, RN = 64;
constexpr int DFF = 2816;
constexpr float RMS_EPS = 1e-6f, GN_EPS = 64e-5f;
constexpr float QSCALE = 0.07216878364870323f * 1.4426950408889634f;

constexpr size_t MiB = 1u << 20;
constexpr size_t al256(size_t x) { return (x + 255) & ~(size_t)255; }
constexpr size_t O_WIN = 0;
constexpr size_t O_WUQ = O_WIN + al256((size_t)NINP * DM * 2);
constexpr size_t O_WUKV = O_WUQ + al256((size_t)768 * QL * 2);
constexpr size_t O_LWA = O_WUKV + al256((size_t)1024 * KVL * 2);
constexpr size_t O_LG = O_LWA + al256((size_t)1024 * 256 * 2);
constexpr size_t O_WOUT = O_LG + al256((size_t)512 * 256 * 2);
constexpr size_t O_WGU = O_WOUT + al256((size_t)DM * DM * 2);
constexpr size_t O_WDN = O_WGU + al256((size_t)2 * DFF * DM * 2);
constexpr size_t O_ROPE = O_WDN + al256((size_t)DM * DFF * 2);
constexpr size_t O_RSTDQ = O_ROPE + al256((size_t)L * 32 * 8);
constexpr size_t O_RSTDKV = O_RSTDQ + al256((size_t)TP * 4);
constexpr size_t O_SSQ2 = O_RSTDKV + al256((size_t)TP * 4);
constexpr size_t O_SSQ3 = O_SSQ2 + al256((size_t)TR * 4);
constexpr size_t O_CTL = O_SSQ3 + al256((size_t)TR * 4);
constexpr size_t O_WEND = O_CTL + 65536;
static_assert(O_WEND <= 32 * MiB, "weight region");
constexpr size_t ROWB = (size_t)TP * 512 * 2;
constexpr size_t O_P = 32 * MiB;
constexpr size_t O_Q = O_P;
constexpr size_t O_V = O_Q + al256((size_t)TP * 768 * 2);
constexpr size_t O_EW = O_V + ROWB;
constexpr size_t O_B = O_EW + ROWB;
static_assert(O_B + ROWB <= O_P + al256((size_t)TP * NIN * 2), "aliases inside P");
constexpr size_t O_U1 = 193 * MiB;
constexpr size_t O_R = O_U1;
constexpr size_t O_VV = O_R + ROWB;
static_assert(O_P + al256((size_t)TP * NIN * 2) <= O_U1 && O_VV + ROWB <= 258 * MiB, "U1 region");
constexpr size_t O_KK = 258 * MiB;
constexpr size_t O_KMOD = O_KK + ROWB;
constexpr size_t O_LIN = O_KMOD + ROWB;
constexpr size_t O_CQKV = O_LIN + al256((size_t)TP * 384 * 2);
constexpr size_t O_K = O_CQKV + al256((size_t)TP * 640 * 2);
constexpr size_t O_G = O_K + al256((size_t)TP * 768 * 2);
constexpr size_t O_END1 = O_G + ROWB;
static_assert(O_END1 <= 512 * MiB, "ws");
constexpr size_t O_Y = O_LIN;
static_assert(O_Y + (size_t)TR * DM * 2 <= O_K, "Y alias");
constexpr size_t O_H2B = O_P;
constexpr size_t O_ACT = O_P + 64 * MiB;
static_assert(O_ACT + (size_t)TR * DFF * 2 <= O_Y, "ACT alias");
static_assert((size_t)TP * 512 * 4 <= (size_t)TR * DM * 4, "YRAW in d_out");

struct Params {
    const float* in[26];
    float* out;
    unsigned char* ws;
};

__device__ __forceinline__ unsigned f2bf(float f) { unsigned u = __builtin_bit_cast(unsigned, f); return (u + 0x7fffu + ((u >> 16) & 1u)) >> 16; }
__device__ __forceinline__ float bf2f(unsigned h) { return __builtin_bit_cast(float, h << 16); }
__device__ __forceinline__ unsigned pk2(float lo, float hi) { return f2bf(lo) | (f2bf(hi) << 16); }
__device__ __forceinline__ float wave_sum(float v) {
#pragma unroll
    for (int o = 1; o < 64; o <<= 1) v += __shfl_xor(v, o);
    return v;
}
__device__ __forceinline__ float sigmoidf_(float x) { return 1.f / (1.f + __expf(-x)); }
__device__ __forceinline__ int row_pos(int row) { int p = row % LP - LPAD; return p < 0 ? 0 : p; }

__constant__ double c_inv_freq[32] = {
    1.0, 0.7498942093324559, 0.5623413251903491, 0.4216965034285822, 0.31622776601683794, 0.23713737056616552, 0.1778279410038923, 0.1333521432163324,
    0.1, 0.07498942093324558, 0.05623413251903491, 0.04216965034285822, 0.03162277660168379, 0.023713737056616554, 0.01778279410038923, 0.01333521432163324,
    0.01, 0.007498942093324559, 0.005623413251903491, 0.004216965034285823, 0.0031622776601683794, 0.0023713737056616554, 0.0017782794100389228, 0.001333521432163324,
    0.001, 0.0007498942093324559, 0.0005623413251903491, 0.0004216965034285822, 0.00031622776601683794, 0.00023713737056616554, 0.00017782794100389227, 0.0001333521432163324};

__device__ __forceinline__ void sincos_d(double a, float& s, float& c) {
    const double q = __builtin_rint(a * 0.6366197723675814);
    double r = __builtin_fma(-q, 1.5707963267948966, a);
    r = __builtin_fma(-q, 6.123233995736766e-17, r);
    const double r2 = r * r;
    double sp = -1.0 / 1307674368000.0;
    sp = sp * r2 + 1.0 / 6227020800.0; sp = sp * r2 - 1.0 / 39916800.0; sp = sp * r2 + 1.0 / 362880.0; sp = sp * r2 - 1.0 / 5040.0; sp = sp * r2 + 1.0 / 120.0; sp = sp * r2 - 1.0 / 6.0;
    const double sn = r + r * r2 * sp;
    double cp = 1.0 / 87178291200.0;
    cp = cp * r2 - 1.0 / 479001600.0; cp = cp * r2 + 1.0 / 3628800.0; cp = cp * r2 - 1.0 / 40320.0; cp = cp * r2 + 1.0 / 720.0; cp = cp * r2 - 1.0 / 24.0; cp = cp * r2 + 0.5;
    const double cs = 1.0 - r2 * cp;
    const int qi = ((int)q) & 3;
    const double ss = (qi == 0) ? sn : (qi == 1) ? cs : (qi == 2) ? -sn : -cs;
    const double cc = (qi == 0) ? cs : (qi == 1) ? -sn : (qi == 2) ? -cs : sn;
    s = (float)ss; c = (float)cc;
}

struct SrcWin { const float* w; __device__ float operator()(int k, int n) const {
        if (n >= NIN) return 0.f; int ns = n;
        if (n >= 2464) { const int j = n - 2464; ns = 2464 + (j >> 1) + 32 * (j & 1); }
        return w[(size_t)k * NIN + ns]; } };
struct SrcWuq { const float* w; const float* g; __device__ float operator()(int k, int n) const {
        const int h = n / DQK, c = n % DQK; int cs = c; if (c >= 128) { const int j = c - 128; cs = 128 + (j >> 1) + 32 * (j & 1); }
        return w[(size_t)k * 768 + h * DQK + cs] * g[k]; } };
struct SrcWukv { const float* w; const float* g; __device__ float operator()(int k, int n) const { return w[(size_t)k * 1024 + n] * g[k]; } };
struct SrcLwa { const float* w2; const float* a2; __device__ float operator()(int k, int n) const {
        if (n < 512) return k < 64 ? w2[(size_t)k * 512 + n] : 0.f;
        return (k >= 64 && k < 128) ? a2[(size_t)(k - 64) * 512 + (n - 512)] : 0.f; } };
struct SrcLg { const float* g2; __device__ float operator()(int k, int n) const { return k < 160 ? g2[(size_t)k * 512 + n] : 0.f; } };
struct SrcWout { const float* w; __device__ float operator()(int k, int n) const { return w[(size_t)k * DM + n]; } };
struct SrcWgu { const float* wg; const float* wu; const float* g; __device__ float operator()(int k, int n) const {
        const int j = n >> 8, c = n & 255; const float v = c < 128 ? wg[(size_t)k * DFF + 128 * j + c] : wu[(size_t)k * DFF + 128 * j + (c - 128)];
        return v * g[k]; } };
struct SrcWdn { const float* w; __device__ float operator()(int k, int n) const { return w[(size_t)k * DM + n]; } };

template <class F>
__device__ __forceinline__ void wconv_item(const F& f, bf16_t* WT, int K, int nblk, int item, float* scr, int lane) {
    const int kb = item / nblk, nb = item % nblk, k0 = 64 * kb, n0 = 32 * nb;
#pragma unroll 8
    for (int i = 0; i < 32; ++i) { const int kk = 2 * i + (lane >> 5); scr[kk * 33 + (lane & 31)] = f(k0 + kk, n0 + (lane & 31)); }
    asm volatile("s_waitcnt lgkmcnt(0)" ::: "memory");
    const int c = lane & 7;
#pragma unroll
    for (int j = 0; j < 4; ++j) { const int n = (lane >> 3) + 8 * j; const float* s = scr + (8 * c) * 33 + n;
        u32x4 o; o.x = pk2(s[0 * 33], s[1 * 33]); o.y = pk2(s[2 * 33], s[3 * 33]); o.z = pk2(s[4 * 33], s[5 * 33]); o.w = pk2(s[6 * 33], s[7 * 33]);
        *(u32x4*)(WT + (size_t)(n0 + n) * K + k0 + 8 * c) = o; }
    asm volatile("s_waitcnt lgkmcnt(0)" ::: "memory");
}

__device__ __forceinline__ void p0_phase(const Params& p, float* scr_all, int gw, int ngw, int lane, int wave_in_block) {
    float* scr = scr_all + wave_in_block * (64 * 33);
    unsigned char* ws = p.ws;
    constexpr int I0 = (DM / 64) * (NINP / 32), I1 = (QL / 64) * (768 / 32), I2 = (KVL / 64) * (1024 / 32), I3 = (256 / 64) * (1024 / 32), I4 = (256 / 64) * (512 / 32),
                  I5 = (DM / 64) * (DM / 32), I6 = (DM / 64) * (2 * DFF / 32), I7 = (DFF / 64) * (DM / 32);
    constexpr int NIT = I0 + I1 + I2 + I3 + I4 + I5 + I6 + I7;
    for (int it = gw; it < NIT; it += ngw) {
        int r = it;
        if (r < I0) { wconv_item(SrcWin{p.in[3]}, (bf16_t*)(ws + O_WIN), DM, NINP / 32, r, scr, lane); continue; } r -= I0;
        if (r < I1) { wconv_item(SrcWuq{p.in[16], p.in[15]}, (bf16_t*)(ws + O_WUQ), QL, 768 / 32, r, scr, lane); continue; } r -= I1;
        if (r < I2) { wconv_item(SrcWukv{p.in[18], p.in[17]}, (bf16_t*)(ws + O_WUKV), KVL, 1024 / 32, r, scr, lane); continue; } r -= I2;
        if (r < I3) { wconv_item(SrcLwa{p.in[6], p.in[8]}, (bf16_t*)(ws + O_LWA), 256, 1024 / 32, r, scr, lane); continue; } r -= I3;
        if (r < I4) { wconv_item(SrcLg{p.in[9]}, (bf16_t*)(ws + O_LG), 256, 512 / 32, r, scr, lane); continue; } r -= I4;
        if (r < I5) { wconv_item(SrcWout{p.in[20]}, (bf16_t*)(ws + O_WOUT), DM, DM / 32, r, scr, lane); continue; } r -= I5;
        if (r < I6) { wconv_item(SrcWgu{p.in[22], p.in[23], p.in[21]}, (bf16_t*)(ws + O_WGU), DM, 2 * DFF / 32, r, scr, lane); continue; } r -= I6;
        wconv_item(SrcWdn{p.in[24]}, (bf16_t*)(ws + O_WDN), DFF, DM / 32, r, scr, lane);
    }
    const float* x = p.in[0]; const float* meta = p.in[1]; const float* g1 = p.in[2];
    bf16_t* U1 = (bf16_t*)(ws + O_U1);
    for (int row = gw; row < TP; row += ngw) {
        const int b = row / LP, pr = row % LP - LPAD;
        u32x2* o = (u32x2*)(U1 + (size_t)row * DM) + lane;
        if (pr < 0) {
#pragma unroll
            for (int j = 0; j < 4; ++j) o[64 * j] = (u32x2){0u, 0u};
            continue;
        }
        const float* src = pr < NMETA ? meta + (size_t)pr * DM : x + ((size_t)b * SEQ + (pr - NMETA)) * DM;
        const f32x4* xr = (const f32x4*)src + lane;
        f32x4 v[4]; float s = 0.f;
#pragma unroll
        for (int j = 0; j < 4; ++j) { v[j] = xr[64 * j]; s += (v[j].x * v[j].x + v[j].y * v[j].y) + (v[j].z * v[j].z + v[j].w * v[j].w); }
        const float rstd = 1.0f / sqrtf(wave_sum(s) * (1.f / DM) + RMS_EPS);
#pragma unroll
        for (int j = 0; j < 4; ++j) { const f32x4 g = ((const f32x4*)g1)[lane + 64 * j];
            o[64 * j] = (u32x2){pk2(v[j].x * rstd * g.x, v[j].y * rstd * g.y), pk2(v[j].z * rstd * g.z, v[j].w * rstd * g.w)}; }
    }
    float* rope = (float*)(ws + O_ROPE);
    for (int i = gw * 64 + lane; i < L * 32; i += ngw * 64) {
        const int pos = i >> 5, f = i & 31; float s, c; sincos_d((double)pos * c_inv_freq[f], s, c);
        rope[2 * i] = c; rope[2 * i + 1] = s;
    }
    float* ssq = (float*)(ws + O_SSQ2);
    for (int i = gw * 64 + lane; i < (int)((O_CTL - O_SSQ2) / 4); i += ngw * 64) ssq[i] = 0.f;
}

__device__ __forceinline__ void p2_row(const Params& p, int row, int lane) {
    unsigned char* ws = p.ws;
    const bf16_t* P = (const bf16_t*)(ws + O_P);
    const bf16_t* cur = P + (size_t)row * NIN; const bf16_t* prv = cur - NIN;
    const bool has_prev = row > 0;
    const float* mu = p.in[4]; const float* k_k = p.in[10];
    f16_t* R = (f16_t*)(ws + O_R); f16_t* VV = (f16_t*)(ws + O_VV); f16_t* KK = (f16_t*)(ws + O_KK); f16_t* KM = (f16_t*)(ws + O_KMOD);
    bf16_t* LIN = (bf16_t*)(ws + O_LIN); bf16_t* CQKV = (bf16_t*)(ws + O_CQKV); bf16_t* Kb = (bf16_t*)(ws + O_K);
    float ssq_q = 0.f, ssq_kv = 0.f;
    for (int ch = lane; ch < 320; ch += 64) {
        const bool act = ch < 316; const int c0 = 8 * ch;
        float v[8];
        {
            u32x4 a = (u32x4){0u, 0u, 0u, 0u};
            if (act) a = *(const u32x4*)(cur + c0);
            v[0] = bf2f(a.x & 0xffffu); v[1] = bf2f(a.x >> 16); v[2] = bf2f(a.y & 0xffffu); v[3] = bf2f(a.y >> 16);
            v[4] = bf2f(a.z & 0xffffu); v[5] = bf2f(a.z >> 16); v[6] = bf2f(a.w & 0xffffu); v[7] = bf2f(a.w >> 16);
        }
        if (c0 < RCOLS) {
            u32x4 b = (u32x4){0u, 0u, 0u, 0u};
            if (act && has_prev) b = *(const u32x4*)(prv + c0);
            float q[8];
            q[0] = bf2f(b.x & 0xffffu); q[1] = bf2f(b.x >> 16); q[2] = bf2f(b.y & 0xffffu); q[3] = bf2f(b.y >> 16);
            q[4] = bf2f(b.z & 0xffffu); q[5] = bf2f(b.z >> 16); q[6] = bf2f(b.w & 0xffffu); q[7] = bf2f(b.w >> 16);
#pragma unroll
            for (int j = 0; j < 8; ++j) v[j] = v[j] + (q[j] - v[j]) * mu[c0 + j];
        }
        const bool isk = (c0 >= 512 && c0 < 1024);
        float ss = 0.f; float kkv[8];
        if (isk) {
#pragma unroll
            for (int j = 0; j < 8; ++j) { kkv[j] = v[j] * k_k[c0 - 512 + j]; ss += kkv[j] * kkv[j]; }
        }
        ss += __shfl_xor(ss, 1); ss += __shfl_xor(ss, 2); ss += __shfl_xor(ss, 4);
        if (!act) continue;
        if (c0 < 512) {
#pragma unroll
            for (int j = 0; j < 8; ++j) R[(size_t)row * 512 + c0 + j] = (f16_t)v[j];
        } else if (c0 < 1024) {
            const float inv = 1.f / fmaxf(sqrtf(ss), 1e-12f);
#pragma unroll
            for (int j = 0; j < 8; ++j) { KM[(size_t)row * 512 + c0 - 512 + j] = (f16_t)v[j]; KK[(size_t)row * 512 + c0 - 512 + j] = (f16_t)(kkv[j] * inv); }
        } else if (c0 < 1536) {
#pragma unroll
            for (int j = 0; j < 8; ++j) VV[(size_t)row * 512 + c0 - 1024 + j] = (f16_t)v[j];
        } else if (c0 < 1600) {
#pragma unroll
            for (int j = 0; j < 8; ++j) LIN[(size_t)row * 384 + c0 - 1536 + j] = (bf16_t)f2bf(tanhf(v[j]));
        } else if (c0 < 1664) {
#pragma unroll
            for (int j = 0; j < 8; ++j) LIN[(size_t)row * 384 + c0 - 1536 + j] = (bf16_t)f2bf(v[j]);
        } else if (c0 < 1824) {
#pragma unroll
            for (int j = 0; j < 8; ++j) LIN[(size_t)row * 384 + c0 - 1536 + j] = (bf16_t)f2bf(sigmoidf_(v[j]));
        } else if (c0 < 2208) {
#pragma unroll
            for (int j = 0; j < 8; ++j) { CQKV[(size_t)row * 640 + c0 - 1824 + j] = (bf16_t)f2bf(v[j]); ssq_q += v[j] * v[j]; }
        } else if (c0 < 2464) {
#pragma unroll
            for (int j = 0; j < 8; ++j) { CQKV[(size_t)row * 640 + c0 - 1824 + j] = (bf16_t)f2bf(v[j]); ssq_kv += v[j] * v[j]; }
        } else {
            const float* t = (const float*)(ws + O_ROPE) + ((size_t)row_pos(row) * 32 + ((c0 - 2464) >> 1)) * 2;
            float o[8];
#pragma unroll
            for (int j = 0; j < 4; ++j) { const float cs = t[2 * j], sn = t[2 * j + 1]; o[2 * j] = v[2 * j] * cs - v[2 * j + 1] * sn; o[2 * j + 1] = v[2 * j + 1] * cs + v[2 * j] * sn; }
            u32x4 w; w.x = pk2(o[0], o[1]); w.y = pk2(o[2], o[3]); w.z = pk2(o[4], o[5]); w.w = pk2(o[6], o[7]);
#pragma unroll
            for (int h = 0; h < NH; ++h) *(u32x4*)(Kb + (size_t)row * 768 + h * DQK + 128 + (c0 - 2464)) = w;
        }
    }
    if (lane < 12) *(u32x4*)(LIN + (size_t)row * 384 + 288 + 8 * lane) = (u32x4){0u, 0u, 0u, 0u};
    ssq_q = wave_sum(ssq_q); ssq_kv = wave_sum(ssq_kv);
    if (lane == 0) { ((float*)(ws + O_RSTDQ))[row] = 1.0f / sqrtf(ssq_q * (1.f / QL) + RMS_EPS); ((float*)(ws + O_RSTDKV))[row] = 1.0f / sqrtf(ssq_kv * (1.f / KVL) + RMS_EPS); }
}
namespace pg8 {
#define PG8_LAS __attribute__((address_space(3)))
typedef short bf16x8 __attribute__((ext_vector_type(8)));
constexpr int BM = 256, BK = 64, HALF = 128, HTB = HALF * BK * 2, STAGE_BYTES = 8 * HTB, NXCD = 8, WGM = 8;
__host__ __device__ __forceinline__ int lds_byte(int r, int c) { const int st = (r >> 4) * 2 + (c >> 5), rr = r & 15, cc = c & 31, ob = rr * 64 + cc * 2; return st * 1024 + (ob ^ (((ob >> 9) & 1) << 5)); }
__host__ __device__ __forceinline__ void stage_rc(int b, int& R, int& C) { const int st = b / 1024, sb = b % 1024, swz = sb ^ (((sb >> 9) & 1) << 5); R = (st >> 1) * 16 + swz / 64; C = (st & 1) * 32 + (swz % 64) / 2; }
__host__ __device__ __forceinline__ int perm32(int rho) { const int n = rho >> 4, i = rho & 15; return 8 * (i >> 2) + 4 * n + (i & 3); }
struct Unit { int pm, pn; };
struct Gemm { const bf16_t* A; const bf16_t* Bt; int lda, ldb, K; };
struct StaticOrder {
    int nM, nN, nwg, G, c;
    __host__ __device__ void init(int M, int N, int G_, int c_) { nM = M / BM; nN = N / BM; nwg = nM * nN; G = G_; c = c_; }
    __host__ __device__ bool next(int i, Unit& u) const {
        const long L = (long)i * G + c; if (L >= nwg) return false;
        int wgid = (int)L; { const int q = nwg / NXCD, r = nwg % NXCD, xcd = wgid % NXCD, off = wgid / NXCD; wgid = (xcd < r ? xcd * (q + 1) : r * (q + 1) + (xcd - r) * q) + off; }
        const int nig = WGM * nN, gid = wgid / nig, fm = gid * WGM, gsz = (nM - fm) < WGM ? (nM - fm) : WGM;
        u.pm = fm + ((wgid % nig) % gsz); u.pn = (wgid % nig) / gsz; return true;
    }
};
template <class F> struct Epi8 {
    F f;
    __device__ __forceinline__ void operator()(const f32x4 (&acc)[2][2][4][2], const Unit& u, int wr, int wc, int fr, int fq) const {
        const int col = u.pn * BM + wc * 32 + 8 * fq;
#pragma unroll
        for (int ai = 0; ai < 2; ++ai)
#pragma unroll
            for (int m = 0; m < 4; ++m) f(u.pm * BM + ai * HALF + wr * 64 + m * 16 + fr, col, acc[ai][0][m][0], acc[ai][0][m][1], acc[ai][1][m][0], acc[ai][1][m][1]);
    }
};

template <class Epi, bool ALIGN_EPI>
__device__ __forceinline__ void gemm_phase(PG8_LAS unsigned char* lds, const Gemm g, const StaticOrder& S, const Epi& E) {
    const int tid = threadIdx.x, wid = __builtin_amdgcn_readfirstlane(tid >> 6), lane = tid & 63, wr = wid >> 2, wc = wid & 3, fr = lane & 15, fq = lane >> 4;
    const int K = g.K, nt = K / BK;
    unsigned voffA[2], voffB[2];
#pragma unroll
    for (int i = 0; i < 2; ++i) { int R, C; stage_rc(tid * 16 + i * 8192, R, C); const int Rb = (R & ~31) + perm32(R & 31);
        voffA[i] = (unsigned)(R * g.lda + C) * 2u; voffB[i] = (unsigned)(Rb * g.ldb + C) * 2u; }
    const size_t kstep = (size_t)(BK * 2);
    const size_t hstepA = (size_t)HALF * g.lda * 2, hstepB = (size_t)HALF * g.ldb * 2;
    const size_t tstepA = 2 * hstepA, tstepB = 2 * hstepB;
    const unsigned ldsw = (unsigned)wid * 1024u;
    const int aoff = lds_byte(wr * 64 + fr, fq * 8), boff = lds_byte(wc * 32 + fr, fq * 8);
#define PG8_SA(b, h) (((b) * 2 + (h)) * HTB)
#define PG8_SB(b, h) ((4 + (b) * 2 + (h)) * HTB)
#define PG8_STAGE(bufoff, gbase, voff) do { _Pragma("unroll") for (int _i = 0; _i < 2; ++_i) \
        __builtin_amdgcn_global_load_lds((const unsigned*)((const char*)(gbase) + (voff)[_i]), (PG8_LAS unsigned*)(lds + (bufoff) + ldsw + _i * 8192), 16, 0, 0); } while (0)
#define PG8_LDA(dst, b, h) do { _Pragma("unroll") for (int m = 0; m < 4; ++m) _Pragma("unroll") for (int k = 0; k < 2; ++k) dst[m][k] = *(const PG8_LAS bf16x8*)(lds + PG8_SA(b, h) + aoff + m * 2048 + k * 1024); } while (0)
#define PG8_LDB(dst, b, h) do { _Pragma("unroll") for (int n = 0; n < 2; ++n) _Pragma("unroll") for (int k = 0; k < 2; ++k) dst[n][k] = *(const PG8_LAS bf16x8*)(lds + PG8_SB(b, h) + boff + n * 2048 + k * 1024); } while (0)
#define PG8_MMA(ai, bj, At, Bt) do { __builtin_amdgcn_s_setprio(1); _Pragma("unroll") for (int m = 0; m < 4; ++m) _Pragma("unroll") for (int n = 0; n < 2; ++n) _Pragma("unroll") for (int k = 0; k < 2; ++k) \
        acc[ai][bj][m][n] = __builtin_amdgcn_mfma_f32_16x16x32_bf16(Bt[n][k], At[m][k], acc[ai][bj][m][n], 0, 0, 0); __builtin_amdgcn_s_setprio(0); } while (0)
#define PG8_WAIT_V(n) asm volatile("s_waitcnt vmcnt(" #n ")" ::: "memory")
#define PG8_WAIT_L(n) asm volatile("s_waitcnt lgkmcnt(" #n ")" ::: "memory")
#define PG8_BAR __builtin_amdgcn_s_barrier()
#define PG8_SCHED __builtin_amdgcn_sched_barrier(0)
    Unit cur, nxt; int ui = 0;
    if (!S.next(0, cur)) return;
    f32x4 acc[2][2][4][2];
#pragma unroll
    for (int a = 0; a < 2; ++a)
#pragma unroll
        for (int b = 0; b < 2; ++b)
#pragma unroll
            for (int m = 0; m < 4; ++m)
#pragma unroll
                for (int n = 0; n < 2; ++n) acc[a][b][m][n] = (f32x4){0.f, 0.f, 0.f, 0.f};
    bf16x8 At[4][2], B0[2][2], B1[2][2];
    const char* cA = (const char*)g.A + (size_t)cur.pm * tstepA; const char* cB = (const char*)g.Bt + (size_t)cur.pn * tstepB;
    PG8_STAGE(PG8_SB(0, 0), cB, voffB); PG8_STAGE(PG8_SB(0, 1), cB + hstepB, voffB); PG8_STAGE(PG8_SA(0, 0), cA, voffA); PG8_STAGE(PG8_SA(0, 1), cA + hstepA, voffA);
    if (wr == 1) PG8_BAR;
    PG8_WAIT_V(2); PG8_BAR;
    PG8_STAGE(PG8_SB(1, 0), cB + kstep, voffB); PG8_STAGE(PG8_SA(1, 0), cA + kstep, voffA); PG8_STAGE(PG8_SB(1, 1), cB + hstepB + kstep, voffB);
    PG8_WAIT_V(6); PG8_BAR;
#pragma nounroll
    for (;;) {
        const bool has_next = S.next(ui + 1, nxt);
        const char* nA = has_next ? (const char*)g.A + (size_t)nxt.pm * tstepA : cA; const char* nB = has_next ? (const char*)g.Bt + (size_t)nxt.pn * tstepB : cB;
#pragma nounroll
        for (int t = 0; t < nt; t += 2) {
            const bool last = (t == nt - 2);
            const char* a1 = cA + (size_t)(t + 1) * kstep;
            const char* a2 = last ? nA : cA + (size_t)(t + 2) * kstep; const char* b2 = last ? nB : cB + (size_t)(t + 2) * kstep;
            const char* a3 = a2 + kstep; const char* b3 = b2 + kstep;
            PG8_LDB(B0, 0, 0); PG8_LDB(B1, 0, 1); PG8_SCHED; PG8_LDA(At, 0, 0); PG8_STAGE(PG8_SA(1, 1), a1 + hstepA, voffA);
            PG8_WAIT_V(8); PG8_WAIT_L(0); PG8_BAR; PG8_MMA(0, 0, At, B0); PG8_MMA(0, 1, At, B1); PG8_BAR; PG8_SCHED;
            PG8_LDA(At, 0, 1); PG8_STAGE(PG8_SB(0, 0), b2, voffB); PG8_STAGE(PG8_SB(0, 1), b2 + hstepB, voffB); PG8_STAGE(PG8_SA(0, 0), a2, voffA);
            PG8_WAIT_V(8); PG8_WAIT_L(0); PG8_BAR; PG8_MMA(1, 0, At, B0); PG8_MMA(1, 1, At, B1); PG8_BAR; PG8_SCHED;
            PG8_LDB(B0, 1, 0); PG8_LDB(B1, 1, 1); PG8_SCHED; PG8_LDA(At, 1, 0); PG8_STAGE(PG8_SA(0, 1), a2 + hstepA, voffA);
            PG8_WAIT_V(8); PG8_WAIT_L(0); PG8_BAR; PG8_MMA(0, 0, At, B0); PG8_MMA(0, 1, At, B1); PG8_BAR; PG8_SCHED;
            PG8_LDA(At, 1, 1); PG8_STAGE(PG8_SB(1, 0), b3, voffB); PG8_STAGE(PG8_SB(1, 1), b3 + hstepB, voffB); PG8_STAGE(PG8_SA(1, 0), a3, voffA);
            PG8_WAIT_V(8); PG8_WAIT_L(0); PG8_BAR; PG8_MMA(1, 0, At, B0); PG8_MMA(1, 1, At, B1); PG8_BAR; PG8_SCHED;
        }
        if constexpr (ALIGN_EPI) { if (wr == 0) PG8_BAR; }
        E(acc, cur, wr, wc, fr, fq);
        if (!has_next) break;
#pragma unroll
        for (int a = 0; a < 2; ++a)
#pragma unroll
            for (int b = 0; b < 2; ++b)
#pragma unroll
                for (int m = 0; m < 4; ++m)
#pragma unroll
                    for (int n = 0; n < 2; ++n) acc[a][b][m][n] = (f32x4){0.f, 0.f, 0.f, 0.f};
        cur = nxt; cA = nA; cB = nB; ++ui;
        if constexpr (ALIGN_EPI) { if (wr == 1) PG8_BAR; }
    }
    PG8_WAIT_V(0);
    if constexpr (!ALIGN_EPI) { if (wr == 0) PG8_BAR; }
    PG8_BAR;
#undef PG8_SA
#undef PG8_SB
#undef PG8_STAGE
#undef PG8_LDA
#undef PG8_LDB
#undef PG8_MMA
#undef PG8_WAIT_V
#undef PG8_WAIT_L
#undef PG8_BAR
#undef PG8_SCHED
}
}

__device__ __forceinline__ u32x4 pack8(const f32x4& a0, const f32x4& a1) { u32x4 w; w.x = pk2(a0[0], a0[1]); w.y = pk2(a0[2], a0[3]); w.z = pk2(a1[0], a1[1]); w.w = pk2(a1[2], a1[3]); return w; }
typedef _Float16 f16x8 __attribute__((ext_vector_type(8)));
struct FP {
    bf16_t* P;
    __device__ __forceinline__ void operator()(int row, int col, const f32x4& a0, const f32x4& a1, const f32x4& b0, const f32x4& b1) const {
        if (col < NIN) *(u32x4*)(P + (size_t)row * NIN + col) = pack8(a0, a1);
        if (col + 128 < NIN) *(u32x4*)(P + (size_t)row * NIN + col + 128) = pack8(b0, b1);
    }
};
struct FQ {
    bf16_t* Q; const float* rstd; const float* rope;
    __device__ __forceinline__ void one(int row, int col, float rs, f32x4 a0, f32x4 a1) const {
        a0 = a0 * rs; a1 = a1 * rs;
        const int c = col % DQK;
        if (c >= 128) { const f32x4* t = (const f32x4*)(rope + ((size_t)row_pos(row) * 32 + ((c - 128) >> 1)) * 2); const f32x4 t0 = t[0], t1 = t[1];
            f32x4 o0, o1;
            o0[0] = a0[0] * t0[0] - a0[1] * t0[1]; o0[1] = a0[1] * t0[0] + a0[0] * t0[1]; o0[2] = a0[2] * t0[2] - a0[3] * t0[3]; o0[3] = a0[3] * t0[2] + a0[2] * t0[3];
            o1[0] = a1[0] * t1[0] - a1[1] * t1[1]; o1[1] = a1[1] * t1[0] + a1[0] * t1[1]; o1[2] = a1[2] * t1[2] - a1[3] * t1[3]; o1[3] = a1[3] * t1[2] + a1[2] * t1[3];
            a0 = o0; a1 = o1; }
        *(u32x4*)(Q + (size_t)row * 768 + col) = pack8(a0, a1);
    }
    __device__ __forceinline__ void operator()(int row, int col, const f32x4& a0, const f32x4& a1, const f32x4& b0, const f32x4& b1) const {
        const float rs = rstd[row] * QSCALE; one(row, col, rs, a0, a1); one(row, col + 128, rs, b0, b1); }
};
struct FKV {
    bf16_t* K; bf16_t* V; const float* rstd;
    __device__ __forceinline__ void one(int row, int col, float rs, const f32x4& a0, const f32x4& a1) const {
        const int h = col >> 8, c = col & 255; const u32x4 w = pack8(a0 * rs, a1 * rs);
        if (c < 128) *(u32x4*)(K + (size_t)row * 768 + h * DQK + c) = w; else *(u32x4*)(V + (size_t)row * 512 + h * DV + (c - 128)) = w; }
    __device__ __forceinline__ void operator()(int row, int col, const f32x4& a0, const f32x4& a1, const f32x4& b0, const f32x4& b1) const {
        const float rs = rstd[row]; one(row, col, rs, a0, a1); one(row, col + 128, rs, b0, b1); }
};
struct FLwa {
    f16_t* EW; f16_t* KMOD; const f16_t* KK; f16_t* Bv; const float* w0; const float* a0p; const float* k_a;
    __device__ __forceinline__ void one(int row, int col, const f32x4& a0, const f32x4& a1) const {
        float v[8] = {a0[0], a0[1], a0[2], a0[3], a1[0], a1[1], a1[2], a1[3]};
        if (col < 512) {
            f16x8 o;
#pragma unroll
            for (int j = 0; j < 8; ++j) { const float xx = w0[col + j] + v[j]; const float sp = (-xx > 20.f) ? -xx : __logf(1.f + __expf(-xx)); o[j] = (f16_t)__expf(-sp - 0.5f); }
            *(f16x8*)(EW + (size_t)row * 512 + col) = o;
        } else {
            const int c = col - 512; const size_t idx = (size_t)row * 512 + c;
            const f16x8 kv = *(const f16x8*)(KMOD + idx), kkv = *(const f16x8*)(KK + idx); f16x8 ko, bo;
#pragma unroll
            for (int j = 0; j < 8; ++j) { const float a = sigmoidf_(a0p[c + j] + v[j]); ko[j] = (f16_t)((float)kv[j] * (1.f + (a - 1.f) * k_a[c + j])); bo[j] = (f16_t)((float)kkv[j] * a); }
            *(f16x8*)(KMOD + idx) = ko; *(f16x8*)(Bv + idx) = bo;
        }
    }
    __device__ __forceinline__ void operator()(int row, int col, const f32x4& a0, const f32x4& a1, const f32x4& b0, const f32x4& b1) const { one(row, col, a0, a1); one(row, col + 128, b0, b1); }
};
struct FG { bf16_t* G;
    __device__ __forceinline__ void operator()(int row, int col, const f32x4& a0, const f32x4& a1, const f32x4& b0, const f32x4& b1) const {
        *(u32x4*)(G + (size_t)row * 512 + col) = pack8(a0, a1); *(u32x4*)(G + (size_t)row * 512 + col + 128) = pack8(b0, b1); } };
struct FOut {
    const float* x; float* H2; bf16_t* H2B; float* ssq;
    __device__ __forceinline__ float one(size_t idx, const f32x4& a0, const f32x4& a1) const {
        const f32x4 h0 = *(const f32x4*)(x + idx) + a0, h1 = *(const f32x4*)(x + idx + 4) + a1;
        *(f32x4*)(H2 + idx) = h0; *(f32x4*)(H2 + idx + 4) = h1; *(u32x4*)(H2B + idx) = pack8(h0, h1);
        return (h0[0] * h0[0] + h0[1] * h0[1]) + (h0[2] * h0[2] + h0[3] * h0[3]) + (h1[0] * h1[0] + h1[1] * h1[1]) + (h1[2] * h1[2] + h1[3] * h1[3]); }
    __device__ __forceinline__ void operator()(int row, int col, const f32x4& a0, const f32x4& a1, const f32x4& b0, const f32x4& b1) const {
        float s = one((size_t)row * DM + col, a0, a1) + one((size_t)row * DM + col + 128, b0, b1);
        s += __shfl_xor(s, 16); s += __shfl_xor(s, 32);
        if ((threadIdx.x & 63) < 16) atomicAdd(ssq + row, s); }
};
struct FAct {
    bf16_t* ACT; const float* ssq;
    __device__ __forceinline__ void operator()(int row, int col, const f32x4& a0, const f32x4& a1, const f32x4& b0, const f32x4& b1) const {
        const float rs = 1.0f / sqrtf(ssq[row] * (1.f / DM) + RMS_EPS);
        f32x4 o0, o1;
#pragma unroll
        for (int j = 0; j < 4; ++j) { const float g0 = a0[j] * rs, g1 = a1[j] * rs; o0[j] = g0 * sigmoidf_(g0) * (b0[j] * rs); o1[j] = g1 * sigmoidf_(g1) * (b1[j] * rs); }
        *(u32x4*)(ACT + (size_t)row * DFF + (col >> 8) * 128 + (col & 127)) = pack8(o0, o1); }
};
struct FDown {
    float* H; float* ssq;
    __device__ __forceinline__ float one(size_t idx, const f32x4& a0, const f32x4& a1) const {
        const f32x4 h0 = *(const f32x4*)(H + idx) + a0, h1 = *(const f32x4*)(H + idx + 4) + a1; *(f32x4*)(H + idx) = h0; *(f32x4*)(H + idx + 4) = h1;
        return (h0[0] * h0[0] + h0[1] * h0[1]) + (h0[2] * h0[2] + h0[3] * h0[3]) + (h1[0] * h1[0] + h1[1] * h1[1]) + (h1[2] * h1[2] + h1[3] * h1[3]); }
    __device__ __forceinline__ void operator()(int row, int col, const f32x4& a0, const f32x4& a1, const f32x4& b0, const f32x4& b1) const {
        float s = one((size_t)row * DM + col, a0, a1) + one((size_t)row * DM + col + 128, b0, b1);
        s += __shfl_xor(s, 16); s += __shfl_xor(s, 32);
        if ((threadIdx.x & 63) < 16) atomicAdd(ssq + row, s); }
};

__device__ __forceinline__ void scan_simple_unit(const Params& p, int unit, int t256) {
    unsigned char* ws = p.ws;
    const f16_t* R = (const f16_t*)(ws + O_R); const f16_t* VV = (const f16_t*)(ws + O_VV); const f16_t* KK = (const f16_t*)(ws + O_KK); const f16_t* KM = (const f16_t*)(ws + O_KMOD);
    const f16_t* EW = (const f16_t*)(ws + O_EW); const f16_t* Bv = (const f16_t*)(ws + O_B);
    float* YRAW = p.out;
    const int bh = unit >> 2, quarter = unit & 3, b = bh >> 3, h = bh & 7;
    const int il = t256 >> 4, c = t256 & 15, i = 16 * quarter + il;
    float S[4] = {0.f, 0.f, 0.f, 0.f};
    const size_t base = ((size_t)b * LP + LPAD) * 512 + h * 64;
    for (int t = 0; t < L; ++t) {
        const size_t o = base + (size_t)t * 512 + 4 * c;
        float w[4], kk[4], bb[4], k[4], r[4];
#pragma unroll
        for (int j = 0; j < 4; ++j) { w[j] = __expf(-(float)EW[o + j]); kk[j] = (float)KK[o + j]; bb[j] = (float)Bv[o + j]; k[j] = (float)KM[o + j]; r[j] = (float)R[o + j]; }
        const float v = (float)VV[base + (size_t)t * 512 + i];
        float sa = 0.f;
#pragma unroll
        for (int j = 0; j < 4; ++j) sa += S[j] * kk[j];
        sa += __shfl_xor(sa, 1); sa += __shfl_xor(sa, 2); sa += __shfl_xor(sa, 4); sa += __shfl_xor(sa, 8);
        sa = -sa;
        float y = 0.f;
#pragma unroll
        for (int j = 0; j < 4; ++j) { S[j] = S[j] * w[j] + sa * bb[j] + v * k[j]; y += S[j] * r[j]; }
        y += __shfl_xor(y, 1); y += __shfl_xor(y, 2); y += __shfl_xor(y, 4); y += __shfl_xor(y, 8);
        if (c == 0) YRAW[base + (size_t)t * 512 + i] = y;
    }
}

__device__ __forceinline__ void attn_simple_unit(const Params& p, float* sm, int unit, int tid) {
    float* Qs = sm;
    float* Ks = Qs + 64 * 192;
    float* Vs = Ks + 64 * 193;
    float* Ps = Vs + 64 * 128;
    unsigned char* ws = p.ws;
    const bf16_t* Q = (const bf16_t*)(ws + O_Q); const bf16_t* Kb = (const bf16_t*)(ws + O_K); const bf16_t* V = (const bf16_t*)(ws + O_V);
    bf16_t* Y = (bf16_t*)(ws + O_Y); const float* og = p.in[19];
    const int qt = unit & 63, h = (unit >> 6) & 3, b = unit >> 8;
    const size_t rb = (size_t)b * LP;
    const int qrow0 = 64 + 64 * qt;
    __syncthreads();
    for (int i = tid; i < 64 * 192; i += 512) { const int r = i / 192, d = i % 192; Qs[i] = bf2f(Q[(rb + qrow0 + r) * 768 + h * DQK + d]); }
    const int qi = (tid & 255) >> 2, sub = tid & 3; const bool act = tid < 256;
    float m = -1e30f, l = 0.f; float o[32];
#pragma unroll
    for (int j = 0; j < 32; ++j) o[j] = 0.f;
    const int nkt = qt + 2;
    for (int kt = 0; kt < nkt; ++kt) {
        __syncthreads();
        for (int i = tid; i < 64 * 192; i += 512) { const int r = i / 192, d = i % 192; Ks[r * 193 + d] = bf2f(Kb[(rb + 64 * kt + r) * 768 + h * DQK + d]); }
        for (int i = tid; i < 64 * 128; i += 512) { const int r = i >> 7, d = i & 127; Vs[i] = bf2f(V[(rb + 64 * kt + r) * 512 + h * DV + d]); }
        __syncthreads();
        float scale = 1.f;
        if (act) {
            float sc[16]; float mx = -1e30f;
#pragma unroll
            for (int kk = 0; kk < 16; ++kk) {
                const int key = sub + 4 * kk; float s = 0.f;
                for (int d = 0; d < 192; ++d) s += Qs[qi * 192 + d] * Ks[key * 193 + d];
                const int krow = 64 * kt + key;
                if (krow < LPAD || krow > qrow0 + qi) s = -1e30f;
                sc[kk] = s; mx = fmaxf(mx, s);
            }
            mx = fmaxf(mx, __shfl_xor(mx, 1)); mx = fmaxf(mx, __shfl_xor(mx, 2));
            const float mn = fmaxf(m, mx); scale = exp2f(m - mn);
            float ps = 0.f;
#pragma unroll
            for (int kk = 0; kk < 16; ++kk) { const float pv = (sc[kk] <= -1e29f) ? 0.f : exp2f(sc[kk] - mn); Ps[qi * 65 + sub + 4 * kk] = pv; ps += pv; }
            ps += __shfl_xor(ps, 1); ps += __shfl_xor(ps, 2);
            l = l * scale + ps; m = mn;
        }
        __syncthreads();
        if (act) {
#pragma unroll
            for (int j = 0; j < 32; ++j) o[j] *= scale;
            for (int key = 0; key < 64; ++key) { const float pv = Ps[qi * 65 + key];
#pragma unroll
                for (int j = 0; j < 32; ++j) o[j] += pv * Vs[key * 128 + sub * 32 + j]; }
        }
    }
    if (act) {
        const float il = 1.f / l; float ss = 0.f;
#pragma unroll
        for (int j = 0; j < 32; ++j) { o[j] *= il; ss += o[j] * o[j]; }
        ss += __shfl_xor(ss, 1); ss += __shfl_xor(ss, 2);
        const float rs = 1.0f / sqrtf(ss * (1.f / DV) + RMS_EPS);
        const size_t yrow = (size_t)b * SEQ + 64 * qt + qi;
#pragma unroll
        for (int j = 0; j < 32; ++j) Y[yrow * DM + 512 + h * DV + sub * 32 + j] = (bf16_t)f2bf(o[j] * rs * og[h * DV + sub * 32 + j]);
    }
}

namespace att {
#define ATT_LAS __attribute__((address_space(3)))
typedef float f32x16 __attribute__((ext_vector_type(16)));
typedef short bf16x8 __attribute__((ext_vector_type(8)));
typedef short s16x4 __attribute__((ext_vector_type(4)));
typedef float f32x2_t __attribute__((ext_vector_type(2)));
typedef __bf16 bf16x2_t __attribute__((ext_vector_type(2)));
constexpr int KROW = 400, VROW = 320, KBUF = 64 * KROW, VBUF = 64 * VROW;
constexpr int L_K = 0, L_V = 2 * KBUF, L_SCR = 2 * KBUF + 2 * VBUF, ATT_LDS = L_SCR + 8 * 256;
__device__ __forceinline__ int crow(int i, int hi) { return (i & 3) + 8 * (i >> 2) + 4 * hi; }
__device__ __forceinline__ unsigned cvtpk(float lo, float hi) { f32x2_t v = {lo, hi}; bf16x2_t b = __builtin_convertvector(v, bf16x2_t); return __builtin_bit_cast(unsigned, b); }
template <int K> __device__ __forceinline__ float swz_xor(float x) { return __builtin_bit_cast(float, __builtin_amdgcn_ds_swizzle(__builtin_bit_cast(int, x), 0x1F | (K << 10))); }
__device__ __forceinline__ float x32_max(float x) { auto r = __builtin_amdgcn_permlane32_swap(__builtin_bit_cast(unsigned, x), __builtin_bit_cast(unsigned, x), false, false); return fmaxf(__builtin_bit_cast(float, r[0]), __builtin_bit_cast(float, r[1])); }
__device__ __forceinline__ float x32_sum(float x) { auto r = __builtin_amdgcn_permlane32_swap(__builtin_bit_cast(unsigned, x), __builtin_bit_cast(unsigned, x), false, false); return __builtin_bit_cast(float, r[0]) + __builtin_bit_cast(float, r[1]); }
__device__ __forceinline__ s16x4 vtr(const ATT_LAS unsigned char* p) { return __builtin_bit_cast(s16x4, __builtin_amdgcn_ds_read_tr16_b64_v4i16((ATT_LAS s16x4*)p)); }

__device__ __forceinline__ void attn_unit(const Params& p, ATT_LAS unsigned char* lds, int b, int h, int qblk) {
    const int tid = threadIdx.x, lane = tid & 63, r32 = lane & 31, hi = lane >> 5; const int w = __builtin_amdgcn_readfirstlane(tid >> 6);
    unsigned char* ws = p.ws;
    const bf16_t* Q = (const bf16_t*)(ws + O_Q); const bf16_t* Kg = (const bf16_t*)(ws + O_K); const bf16_t* Vg = (const bf16_t*)(ws + O_V);
    const size_t rowbase = (size_t)b * LP;
    const int qrow = 64 + 256 * qblk + 32 * w + r32;
    const int NT = 4 * qblk + 5, jband = 4 * qblk + 1, jdiag = jband + (w >> 1);
    bf16x8 qf[12];
    { const bf16_t* qp = Q + (rowbase + qrow) * 768 + h * DQK + 8 * hi;
#pragma unroll
      for (int s = 0; s < 12; ++s) qf[s] = *(const bf16x8*)(qp + 16 * s); }
    const unsigned char* kbase = (const unsigned char*)(Kg + rowbase * 768 + h * DQK);
    const unsigned char* vbase = (const unsigned char*)(Vg + rowbase * 512 + h * DV);
    const unsigned sr = (unsigned)tid >> 3, sc8 = ((unsigned)tid & 7u) * 16u;
    const unsigned ko = sr * 1536u + sc8, vo = sr * 1024u + sc8, kl = (unsigned)L_K + sr * KROW + sc8, vl = (unsigned)L_V + sr * VROW + sc8;
    u32x4 sk[3], sv[2];
#define ATT_LOAD(j) do { const unsigned char* kb_ = kbase + (size_t)(j) * (64 * 768 * 2) + ko; const unsigned char* vb_ = vbase + (size_t)(j) * (64 * 512 * 2) + vo; \
                         _Pragma("unroll") for (int i_ = 0; i_ < 3; ++i_) sk[i_] = *(const u32x4*)(kb_ + 128 * i_); \
                         _Pragma("unroll") for (int i_ = 0; i_ < 2; ++i_) sv[i_] = *(const u32x4*)(vb_ + 128 * i_); } while (0)
#define ATT_WRITE(buf) do { _Pragma("unroll") for (int i_ = 0; i_ < 3; ++i_) *(ATT_LAS u32x4*)(lds + kl + (buf) * KBUF + 128 * i_) = sk[i_]; \
                            _Pragma("unroll") for (int i_ = 0; i_ < 2; ++i_) *(ATT_LAS u32x4*)(lds + vl + (buf) * VBUF + 128 * i_) = sv[i_]; } while (0)
    ATT_LAS float* scr = (ATT_LAS float*)(lds + L_SCR + w * 256);
    f32x16 o[4];
#pragma unroll
    for (int d = 0; d < 4; ++d)
#pragma unroll
        for (int i = 0; i < 16; ++i) o[d][i] = 0.f;
    float m = -1e30f, lsum = 0.f;
    const ATT_LAS unsigned char* kp0 = lds + L_K + r32 * KROW + hi * 16;
    const ATT_LAS unsigned char* vp0 = lds + L_V + (4 * hi + ((lane & 15) >> 2)) * VROW + (((lane >> 4) & 1) * 16 + (lane & 3) * 4) * 2;
    ATT_LOAD(0); ATT_WRITE(0);
    __syncthreads();
#pragma nounroll
    for (int j = 0; j < NT; ++j) {
        const int buf = j & 1;
        if (j + 1 < NT) ATT_LOAD(j + 1);
        if (j <= jdiag) {
            const ATT_LAS unsigned char* kp = kp0 + buf * KBUF;
            f32x16 p0, p1;
#pragma unroll
            for (int i = 0; i < 16; ++i) { p0[i] = 0.f; p1[i] = 0.f; }
#pragma unroll
            for (int s = 0; s < 12; ++s) {
                const bf16x8 k0 = *(const ATT_LAS bf16x8*)(kp + s * 32), k1 = *(const ATT_LAS bf16x8*)(kp + 32 * KROW + s * 32);
                p0 = __builtin_amdgcn_mfma_f32_32x32x16_bf16(k0, qf[s], p0, 0, 0, 0);
                p1 = __builtin_amdgcn_mfma_f32_32x32x16_bf16(k1, qf[s], p1, 0, 0, 0);
                if ((s & 3) == 3) __builtin_amdgcn_sched_barrier(0);
            }
            if (j == 0 || j >= jband) {
#pragma unroll
                for (int i = 0; i < 16; ++i) { const int kr = 64 * j + crow(i, hi);
                    if (kr < LPAD || kr > qrow) p0[i] = -1e30f;
                    if (kr + 32 < LPAD || kr + 32 > qrow) p1[i] = -1e30f; }
            }
            float mx = fmaxf(p0[0], p1[0]);
#pragma unroll
            for (int i = 1; i < 16; ++i) mx = fmaxf(mx, fmaxf(p0[i], p1[i]));
            mx = x32_max(mx);
            const float mn = fmaxf(m, mx);
            const bool grew = mn > m;
            const float alpha = __builtin_amdgcn_exp2f(m - mn);
            m = mn;
            float rs = 0.f;
#pragma unroll
            for (int i = 0; i < 16; ++i) { p0[i] = __builtin_amdgcn_exp2f(p0[i] - mn); p1[i] = __builtin_amdgcn_exp2f(p1[i] - mn); rs += p0[i] + p1[i]; }
            lsum = lsum * alpha + rs;
            if (__any(grew)) {
                if (hi == 0) scr[r32] = alpha;
#pragma unroll
                for (int g = 0; g < 4; ++g) { const f32x4 a4 = *(const ATT_LAS f32x4*)(scr + 8 * g + 4 * hi);
#pragma unroll
                    for (int d = 0; d < 4; ++d) { o[d][4 * g + 0] *= a4[0]; o[d][4 * g + 1] *= a4[1]; o[d][4 * g + 2] *= a4[2]; o[d][4 * g + 3] *= a4[3]; } }
            }
            u32x4 pw[4];
#pragma unroll
            for (int s = 0; s < 2; ++s) {
                pw[s] = (u32x4){cvtpk(p0[8 * s], p0[8 * s + 1]), cvtpk(p0[8 * s + 2], p0[8 * s + 3]), cvtpk(p0[8 * s + 4], p0[8 * s + 5]), cvtpk(p0[8 * s + 6], p0[8 * s + 7])};
                pw[2 + s] = (u32x4){cvtpk(p1[8 * s], p1[8 * s + 1]), cvtpk(p1[8 * s + 2], p1[8 * s + 3]), cvtpk(p1[8 * s + 4], p1[8 * s + 5]), cvtpk(p1[8 * s + 6], p1[8 * s + 7])};
            }
            const ATT_LAS unsigned char* vp = vp0 + buf * VBUF;
            __builtin_amdgcn_sched_barrier(0);
#pragma unroll
            for (int ks = 0; ks < 4; ++ks) {
                const bf16x8 pa = __builtin_bit_cast(bf16x8, pw[ks]);
#pragma unroll
                for (int d = 0; d < 4; ++d) {
                    const s16x4 lo = vtr(vp + (16 * ks) * VROW + 64 * d), hh = vtr(vp + (16 * ks + 8) * VROW + 64 * d);
                    const bf16x8 vb = (bf16x8){lo[0], lo[1], lo[2], lo[3], hh[0], hh[1], hh[2], hh[3]};
                    o[d] = __builtin_amdgcn_mfma_f32_32x32x16_bf16(pa, vb, o[d], 0, 0, 0);
                }
                __builtin_amdgcn_sched_barrier(0);
            }
        }
        if (j + 1 < NT) ATT_WRITE(buf ^ 1);
        __syncthreads();
    }
#undef ATT_LOAD
#undef ATT_WRITE
    const float ltot = x32_sum(lsum);
    if (hi == 0) scr[32 + r32] = ltot;
    const float* og = p.in[19] + h * DV;
    float gl[4];
#pragma unroll
    for (int d = 0; d < 4; ++d) gl[d] = og[32 * d + r32];
    bf16_t* Y = (bf16_t*)(ws + O_Y) + ((size_t)b * SEQ + 256 * qblk + 32 * w) * DM + 512 + h * DV + r32;
#pragma unroll
    for (int g = 0; g < 4; ++g) {
        const f32x4 l4 = *(const ATT_LAS f32x4*)(scr + 32 + 8 * g + 4 * hi);
#pragma unroll
        for (int e = 0; e < 4; ++e) {
            const int i = 4 * g + e;
            float ss = o[0][i] * o[0][i] + o[1][i] * o[1][i] + o[2][i] * o[2][i] + o[3][i] * o[3][i];
            ss += swz_xor<1>(ss); ss += swz_xor<2>(ss); ss += swz_xor<4>(ss); ss += swz_xor<8>(ss); ss += swz_xor<16>(ss);
            const float inv = 1.f / l4[e];
            const float sc = inv / sqrtf(ss * inv * inv * (1.f / DV) + RMS_EPS);
            bf16_t* yr = Y + (size_t)crow(i, hi) * DM;
#pragma unroll
            for (int d = 0; d < 4; ++d) yr[32 * d] = (bf16_t)f2bf(o[d][i] * sc * gl[d]);
        }
    }
}
}

__device__ __forceinline__ void p5_phase(const Params& p, int gw, int ngw, int lane) {
    unsigned char* ws = p.ws;
    const float* YRAW = p.out;
    const f16_t* R = (const f16_t*)(ws + O_R); const f16_t* VV = (const f16_t*)(ws + O_VV); const f16_t* KM = (const f16_t*)(ws + O_KMOD); const bf16_t* G = (const bf16_t*)(ws + O_G);
    bf16_t* Y = (bf16_t*)(ws + O_Y);
    const float* r_k = p.in[12]; const float* ln_w = p.in[13]; const float* ln_b = p.in[14];
    for (int it = gw; it < TR * RH; it += ngw) {
        const int rr = it >> 3, h = it & 7, b = rr / SEQ, s = rr % SEQ;
        const size_t idx = ((size_t)b * LP + 64 + s) * 512 + h * 64 + lane;
        const float y = YRAW[idx];
        const float mean = wave_sum(y) * (1.f / 64.f); const float d = y - mean; const float var = wave_sum(d * d) * (1.f / 64.f);
        const float r = (float)R[idx], k = (float)KM[idx], v = (float)VV[idx];
        const float bonus = wave_sum(r * k * r_k[h * 64 + lane]);
        float yo = d * (1.0f / sqrtf(var + GN_EPS)) * ln_w[h * 64 + lane] + ln_b[h * 64 + lane] + bonus * v;
        yo *= bf2f(G[idx]);
        Y[(size_t)rr * DM + h * 64 + lane] = (bf16_t)f2bf(yo);
    }
}
__device__ __forceinline__ void p9_phase(const Params& p, int gw, int ngw, int lane) {
    const float* ssq = (const float*)(p.ws + O_SSQ3); const float* g = p.in[25];
    for (int row = gw; row < TR; row += ngw) {
        const float rs = 1.0f / sqrtf(ssq[row] * (1.f / DM) + RMS_EPS);
        f32x4* o = (f32x4*)(p.out + (size_t)row * DM) + lane;
#pragma unroll
        for (int j = 0; j < 4; ++j) { const f32x4 gv = ((const f32x4*)g)[lane + 64 * j]; f32x4 v = o[64 * j]; v = v * rs * gv; o[64 * j] = v; }
    }
}

#ifndef PH_MASK
#define PH_MASK 0xFFFF
#endif
#define PH(k) ((PH_MASK >> (k)) & 1)
constexpr int LDS_BYTES = 153600;
constexpr int LDS_MISC = LDS_BYTES - 256;
__global__ void __launch_bounds__(512, 2) mega_fwd(Params p) {
    extern __shared__ __attribute__((aligned(16))) unsigned char lds[];
    cg::grid_group grid = cg::this_grid();
    const int tid = threadIdx.x, lane = tid & 63, wave = tid >> 6;
    const int G = gridDim.x, gw = blockIdx.x * 8 + wave, ngw = G * 8;
    unsigned char* ws = p.ws;
    PG8_LAS unsigned char* ldsg = (PG8_LAS unsigned char*)lds;
    unsigned* ctl = (unsigned*)(ws + O_CTL);
    if (PH(0)) p0_phase(p, (float*)lds, gw, ngw, lane, wave);
    if (blockIdx.x == 0 && tid < 64) ctl[tid] = 0u;
    grid.sync();
    if (PH(1)) { pg8::Gemm g{(const bf16_t*)(ws + O_U1), (const bf16_t*)(ws + O_WIN), DM, DM, DM}; pg8::StaticOrder S; S.init(TP, NINP, G, blockIdx.x);
      pg8::Epi8<FP> E{FP{(bf16_t*)(ws + O_P)}}; pg8::gemm_phase<pg8::Epi8<FP>, true>(ldsg, g, S, E); }
    grid.sync();
    if (PH(2)) for (int row = gw; row < TP; row += ngw) p2_row(p, row, lane);
    grid.sync();
    if (PH(3)) { pg8::Gemm g{(const bf16_t*)(ws + O_CQKV), (const bf16_t*)(ws + O_WUQ), 640, QL, QL}; pg8::StaticOrder S; S.init(TP, 768, G, blockIdx.x);
      pg8::Epi8<FQ> E{FQ{(bf16_t*)(ws + O_Q), (const float*)(ws + O_RSTDQ), (const float*)(ws + O_ROPE)}}; pg8::gemm_phase<pg8::Epi8<FQ>, true>(ldsg, g, S, E); }
    if (PH(4)) { pg8::Gemm g{(const bf16_t*)(ws + O_CQKV) + 384, (const bf16_t*)(ws + O_WUKV), 640, KVL, KVL}; pg8::StaticOrder S; S.init(TP, 1024, G, blockIdx.x);
      pg8::Epi8<FKV> E{FKV{(bf16_t*)(ws + O_K), (bf16_t*)(ws + O_V), (const float*)(ws + O_RSTDKV)}}; pg8::gemm_phase<pg8::Epi8<FKV>, true>(ldsg, g, S, E); }
    if (PH(5)) { pg8::Gemm g{(const bf16_t*)(ws + O_LIN), (const bf16_t*)(ws + O_LWA), 384, 256, 256}; pg8::StaticOrder S; S.init(TP, 1024, G, blockIdx.x);
      pg8::Epi8<FLwa> E{FLwa{(f16_t*)(ws + O_EW), (f16_t*)(ws + O_KMOD), (const f16_t*)(ws + O_KK), (f16_t*)(ws + O_B), p.in[5], p.in[7], p.in[11]}}; pg8::gemm_phase<pg8::Epi8<FLwa>, true>(ldsg, g, S, E); }
    if (PH(6)) { pg8::Gemm g{(const bf16_t*)(ws + O_LIN) + 128, (const bf16_t*)(ws + O_LG), 384, 256, 256}; pg8::StaticOrder S; S.init(TP, 512, G, blockIdx.x);
      pg8::Epi8<FG> E{FG{(bf16_t*)(ws + O_G)}}; pg8::gemm_phase<pg8::Epi8<FG>, true>(ldsg, g, S, E); }
    grid.sync();
    if (PH(7)) if (blockIdx.x < 128) scan_simple_unit(p, blockIdx.x * 2 + (tid >> 8), tid & 255);
    if (PH(8)) {
        const int vcu = (G % 8 == 0) ? (int)(blockIdx.x % 8) * (G / 8) + (int)(blockIdx.x / 8) : (int)blockIdx.x;
        for (int pr = vcu; pr < NB * NH * 8; pr += G) {
            const int bh = pr >> 3, q0 = pr & 7;
#pragma nounroll
            for (int u2 = 0; u2 < 2; ++u2) att::attn_unit(p, ldsg, bh >> 2, bh & 3, u2 ? q0 : 15 - q0);
        }
    }
    grid.sync();
    if (PH(9)) p5_phase(p, gw, ngw, lane);
    grid.sync();
    if (PH(10)) { pg8::Gemm g{(const bf16_t*)(ws + O_Y), (const bf16_t*)(ws + O_WOUT), DM, DM, DM}; pg8::StaticOrder S; S.init(TR, DM, G, blockIdx.x);
      pg8::Epi8<FOut> E{FOut{p.in[0], p.out, (bf16_t*)(ws + O_H2B), (float*)(ws + O_SSQ2)}}; pg8::gemm_phase<pg8::Epi8<FOut>, true>(ldsg, g, S, E); }
    grid.sync();
    if (PH(11)) { pg8::Gemm g{(const bf16_t*)(ws + O_H2B), (const bf16_t*)(ws + O_WGU), DM, DM, DM}; pg8::StaticOrder S; S.init(TR, 2 * DFF, G, blockIdx.x);
      pg8::Epi8<FAct> E{FAct{(bf16_t*)(ws + O_ACT), (const float*)(ws + O_SSQ2)}}; pg8::gemm_phase<pg8::Epi8<FAct>, true>(ldsg, g, S, E); }
    grid.sync();
    if (PH(12)) { pg8::Gemm g{(const bf16_t*)(ws + O_ACT), (const bf16_t*)(ws + O_WDN), DFF, DFF, DFF}; pg8::StaticOrder S; S.init(TR, DM, G, blockIdx.x);
      pg8::Epi8<FDown> E{FDown{p.out, (float*)(ws + O_SSQ3)}}; pg8::gemm_phase<pg8::Epi8<FDown>, true>(ldsg, g, S, E); }
    grid.sync();
    if (PH(13)) p9_phase(p, gw, ngw, lane);
}

extern "C" void kernel_launch(void* const* d_in, const int* in_sizes, int n_in, void* d_out, int out_size, void* d_ws, size_t ws_size, hipStream_t stream) {
    static int grid_blocks = 0;
    if (grid_blocks == 0) {
        if (n_in != 26 || out_size != TR * DM || ws_size < 512 * MiB) { fprintf(stderr, "kernel_launch: unexpected sizes n_in=%d out=%d ws=%zu\n", n_in, out_size, ws_size); grid_blocks = -1; return; }
        int dev = 0, cus = 0, per_cu = 0;
        (void)hipGetDevice(&dev); (void)hipDeviceGetAttribute(&cus, hipDeviceAttributeMultiprocessorCount, dev);
        (void)hipFuncSetAttribute((const void*)mega_fwd, hipFuncAttributeMaxDynamicSharedMemorySize, LDS_BYTES);
        (void)hipOccupancyMaxActiveBlocksPerMultiprocessor(&per_cu, (const void*)mega_fwd, 512, LDS_BYTES);
        if (per_cu < 1) { fprintf(stderr, "kernel_launch: occupancy query says %d blocks per CU\n", per_cu); per_cu = 1; }
        if (per_cu > 1) per_cu = 1;
        grid_blocks = cus * per_cu;
    }
    if (grid_blocks < 0) return;
    Params p{};
    for (int i = 0; i < 26; ++i) p.in[i] = (const float*)d_in[i];
    p.out = (float*)d_out; p.ws = (unsigned char*)d_ws;
    void* args[] = {&p};
    hipError_t e = hipLaunchCooperativeKernel((const void*)mega_fwd, dim3(grid_blocks), dim3(512), args, LDS_BYTES, stream);
    if (e != hipSuccess) fprintf(stderr, "cooperative launch failed: %s (grid %d)\n", hipGetErrorString(e), grid_blocks);
}
```

```cpp
#include <hip/hip_runtime.h>
#include <hip/hip_cooperative_groups.h>
namespace cg = cooperative_groups;
#include <cstdio>
#include <cstdint>

typedef unsigned short bf16_t;
typedef _Float16 f16_t;
typedef float f32x4 __attribute__((ext_vector_type(4)));
typedef unsigned u32x4 __attribute__((ext_vector_type(4)));
typedef unsigned u32x2 __attribute__((ext_vector_type(2)));

constexpr int NB = 8, SEQ = 4096, DM = 1024, NMETA = 16, L = SEQ + NMETA;
constexpr int LPAD = 48, LP = L + LPAD;
constexpr int TP = NB * LP;
constexpr int TR = NB * SEQ;
constexpr int NIN = 2528, NINP = 2560, RW = 512, RCOLS = 1824;
constexpr int QL = 384, KVL = 256, DQK = 192, DV = 128, NH = 4, RH = 8, RN = 64;
constexpr int DFF = 2816;
constexpr float RMS_EPS = 1e-6f, GN_EPS = 64e-5f;
constexpr float QSCALE = 0.07216878364870323f * 1.4426950408889634f;

constexpr size_t MiB = 1u << 20;
constexpr size_t al256(size_t x) { return (x + 255) & ~(size_t)255; }
constexpr size_t O_WIN = 0;
constexpr size_t O_WUQ = O_WIN + al256((size_t)NINP * DM * 2);
constexpr size_t O_WUKV = O_WUQ + al256((size_t)768 * QL * 2);
constexpr size_t O_LWA = O_WUKV + al256((size_t)1024 * KVL * 2);
constexpr size_t O_LG = O_LWA + al256((size_t)1024 * 256 * 2);
constexpr size_t O_WOUT = O_LG + al256((size_t)512 * 256 * 2);
constexpr size_t O_WGU = O_WOUT + al256((size_t)DM * DM * 2);
constexpr size_t O_WDN = O_WGU + al256((size_t)2 * DFF * DM * 2);
constexpr size_t O_ROPE = O_WDN + al256((size_t)DM * DFF * 2);
constexpr size_t O_RSTDQ = O_ROPE + al256((size_t)L * 32 * 8);
constexpr size_t O_RSTDKV = O_RSTDQ + al256((size_t)TP * 4);
constexpr size_t O_SSQ2 = O_RSTDKV + al256((size_t)TP * 4);
constexpr size_t O_SSQ3 = O_SSQ2 + al256((size_t)TR * 4);
constexpr size_t O_CTL = O_SSQ3 + al256((size_t)TR * 4);
constexpr size_t O_WEND = O_CTL + 65536;
static_assert(O_WEND <= 32 * MiB, "weight region");
constexpr size_t ROWB = (size_t)TP * 512 * 2;
constexpr size_t O_P = 32 * MiB;
constexpr size_t O_Q = O_P;
constexpr size_t O_V = O_Q + al256((size_t)TP * 768 * 2);
constexpr size_t O_EW = O_V + ROWB;
constexpr size_t O_B = O_EW + ROWB;
static_assert(O_B + ROWB <= O_P + al256((size_t)TP * NIN * 2), "aliases inside P");
constexpr size_t O_U1 = 193 * MiB;
constexpr size_t O_R = O_U1;
constexpr size_t O_VV = O_R + ROWB;
static_assert(O_P + al256((size_t)TP * NIN * 2) <= O_U1 && O_VV + ROWB <= 258 * MiB, "U1 region");
constexpr size_t O_KK = 258 * MiB;
constexpr size_t O_KMOD = O_KK + ROWB;
constexpr size_t O_LIN = O_KMOD + ROWB;
constexpr size_t O_CQKV = O_LIN + al256((size_t)TP * 384 * 2);
constexpr size_t O_K = O_CQKV + al256((size_t)TP * 640 * 2);
constexpr size_t O_G = O_K + al256((size_t)TP * 768 * 2);
constexpr size_t O_END1 = O_G + ROWB;
static_assert(O_END1 <= 512 * MiB, "ws");
constexpr size_t O_Y = O_LIN;
static_assert(O_Y + (size_t)TR * DM * 2 <= O_K, "Y alias");
constexpr size_t O_H2B = O_P;
constexpr size_t O_ACT = O_P + 64 * MiB;
static_assert(O_ACT + (size_t)TR * DFF * 2 <= O_Y, "ACT alias");
static_assert((size_t)TP * 512 * 4 <= (size_t)TR * DM * 4, "YRAW in d_out");

struct Params {
    const float* in[26];
    float* out;
    unsigned char* ws;
};

__device__ __forceinline__ unsigned f2bf(float f) { unsigned u = __builtin_bit_cast(unsigned, f); return (u + 0x7fffu + ((u >> 16) & 1u)) >> 16; }
__device__ __forceinline__ float bf2f(unsigned h) { return __builtin_bit_cast(float, h << 16); }
__device__ __forceinline__ unsigned pk2(float lo, float hi) { return f2bf(lo) | (f2bf(hi) << 16); }
__device__ __forceinline__ float wave_sum(float v) {
#pragma unroll
    for (int o = 1; o < 64; o <<= 1) v += __shfl_xor(v, o);
    return v;
}
__device__ __forceinline__ float sigmoidf_(float x) { return 1.f / (1.f + __expf(-x)); }
__device__ __forceinline__ int row_pos(int row) { int p = row % LP - LPAD; return p < 0 ? 0 : p; }

__constant__ double c_inv_freq[32] = {
    1.0, 0.7498942093324559, 0.5623413251903491, 0.4216965034285822, 0.31622776601683794, 0.23713737056616552, 0.1778279410038923, 0.1333521432163324,
    0.1, 0.07498942093324558, 0.05623413251903491, 0.04216965034285822, 0.03162277660168379, 0.023713737056616554, 0.01778279410038923, 0.01333521432163324,
    0.01, 0.007498942093324559, 0.005623413251903491, 0.004216965034285823, 0.0031622776601683794, 0.0023713737056616554, 0.0017782794100389228, 0.001333521432163324,
    0.001, 0.0007498942093324559, 0.0005623413251903491, 0.0004216965034285822, 0.00031622776601683794, 0.00023713737056616554, 0.00017782794100389227, 0.0001333521432163324};

__device__ __forceinline__ void sincos_d(double a, float& s, float& c) {
    const double q = __builtin_rint(a * 0.6366197723675814);
    double r = __builtin_fma(-q, 1.5707963267948966, a);
    r = __builtin_fma(-q, 6.123233995736766e-17, r);
    const double r2 = r * r;
    double sp = -1.0 / 1307674368000.0;
    sp = sp * r2 + 1.0 / 6227020800.0; sp = sp * r2 - 1.0 / 39916800.0; sp = sp * r2 + 1.0 / 362880.0; sp = sp * r2 - 1.0 / 5040.0; sp = sp * r2 + 1.0 / 120.0; sp = sp * r2 - 1.0 / 6.0;
    const double sn = r + r * r2 * sp;
    double cp = 1.0 / 87178291200.0;
    cp = cp * r2 - 1.0 / 479001600.0; cp = cp * r2 + 1.0 / 3628800.0; cp = cp * r2 - 1.0 / 40320.0; cp = cp * r2 + 1.0 / 720.0; cp = cp * r2 - 1.0 / 24.0; cp = cp * r2 + 0.5;
    const double cs = 1.0 - r2 * cp;
    const int qi = ((int)q) & 3;
    const double ss = (qi == 0) ? sn : (qi == 1) ? cs : (qi == 2) ? -sn : -cs;
    const double cc = (qi == 0) ? cs : (qi == 1) ? -sn : (qi == 2) ? -cs : sn;
    s = (float)ss; c = (float)cc;
}

struct SrcWin { const float* w; __device__ float operator()(int k, int n) const {
        if (n >= NIN) return 0.f; int ns = n;
        if (n >= 2464) { const int j = n - 2464; ns = 2464 + (j >> 1) + 32 * (j & 1); }
        return w[(size_t)k * NIN + ns]; } };
struct SrcWuq { const float* w; const float* g; __device__ float operator()(int k, int n) const {
        const int h = n / DQK, c = n % DQK; int cs = c; if (c >= 128) { const int j = c - 128; cs = 128 + (j >> 1) + 32 * (j & 1); }
        return w[(size_t)k * 768 + h * DQK + cs] * g[k]; } };
struct SrcWukv { const float* w; const float* g; __device__ float operator()(int k, int n) const { return w[(size_t)k * 1024 + n] * g[k]; } };
struct SrcLwa { const float* w2; const float* a2; __device__ float operator()(int k, int n) const {
        if (n < 512) return k < 64 ? w2[(size_t)k * 512 + n] : 0.f;
        return (k >= 64 && k < 128) ? a2[(size_t)(k - 64) * 512 + (n - 512)] : 0.f; } };
struct SrcLg { const float* g2; __device__ float operator()(int k, int n) const { return k < 160 ? g2[(size_t)k * 512 + n] : 0.f; } };
struct SrcWout { const float* w; __device__ float operator()(int k, int n) const { return w[(size_t)k * DM + n]; } };
struct SrcWgu { const float* wg; const float* wu; const float* g; __device__ float operator()(int k, int n) const {
        const int j = n >> 8, c = n & 255; const float v = c < 128 ? wg[(size_t)k * DFF + 128 * j + c] : wu[(size_t)k * DFF + 128 * j + (c - 128)];
        return v * g[k]; } };
struct SrcWdn { const float* w; __device__ float operator()(int k, int n) const { return w[(size_t)k * DM + n]; } };

template <class F>
__device__ __forceinline__ void wconv_item(const F& f, bf16_t* WT, int K, int nblk, int item, float* scr, int lane) {
    const int kb = item / nblk, nb = item % nblk, k0 = 64 * kb, n0 = 32 * nb;
#pragma unroll 8
    for (int i = 0; i < 32; ++i) { const int kk = 2 * i + (lane >> 5); scr[kk * 33 + (lane & 31)] = f(k0 + kk, n0 + (lane & 31)); }
    asm volatile("s_waitcnt lgkmcnt(0)" ::: "memory");
    const int c = lane & 7;
#pragma unroll
    for (int j = 0; j < 4; ++j) { const int n = (lane >> 3) + 8 * j; const float* s = scr + (8 * c) * 33 + n;
        u32x4 o; o.x = pk2(s[0 * 33], s[1 * 33]); o.y = pk2(s[2 * 33], s[3 * 33]); o.z = pk2(s[4 * 33], s[5 * 33]); o.w = pk2(s[6 * 33], s[7 * 33]);
        *(u32x4*)(WT + (size_t)(n0 + n) * K + k0 + 8 * c) = o; }
    asm volatile("s_waitcnt lgkmcnt(0)" ::: "memory");
}

__device__ __forceinline__ void p0_phase(const Params& p, float* scr_all, int gw, int ngw, int lane, int wave_in_block) {
    float* scr = scr_all + wave_in_block * (64 * 33);
    unsigned char* ws = p.ws;
    constexpr int I0 = (DM / 64) * (NINP / 32), I1 = (QL / 64) * (768 / 32), I2 = (KVL / 64) * (1024 / 32), I3 = (256 / 64) * (1024 / 32), I4 = (256 / 64) * (512 / 32),
                  I5 = (DM / 64) * (DM / 32), I6 = (DM / 64) * (2 * DFF / 32), I7 = (DFF / 64) * (DM / 32);
    constexpr int NIT = I0 + I1 + I2 + I3 + I4 + I5 + I6 + I7;
    for (int it = gw; it < NIT; it += ngw) {
        int r = it;
        if (r < I0) { wconv_item(SrcWin{p.in[3]}, (bf16_t*)(ws + O_WIN), DM, NINP / 32, r, scr, lane); continue; } r -= I0;
        if (r < I1) { wconv_item(SrcWuq{p.in[16], p.in[15]}, (bf16_t*)(ws + O_WUQ), QL, 768 / 32, r, scr, lane); continue; } r -= I1;
        if (r < I2) { wconv_item(SrcWukv{p.in[18], p.in[17]}, (bf16_t*)(ws + O_WUKV), KVL, 1024 / 32, r, scr, lane); continue; } r -= I2;
        if (r < I3) { wconv_item(SrcLwa{p.in[6], p.in[8]}, (bf16_t*)(ws + O_LWA), 256, 1024 / 32, r, scr, lane); continue; } r -= I3;
        if (r < I4) { wconv_item(SrcLg{p.in[9]}, (bf16_t*)(ws + O_LG), 256, 512 / 32, r, scr, lane); continue; } r -= I4;
        if (r < I5) { wconv_item(SrcWout{p.in[20]}, (bf16_t*)(ws + O_WOUT), DM, DM / 32, r, scr, lane); continue; } r -= I5;
        if (r < I6) { wconv_item(SrcWgu{p.in[22], p.in[23], p.in[21]}, (bf16_t*)(ws + O_WGU), DM, 2 * DFF / 32, r, scr, lane); continue; } r -= I6;
        wconv_item(SrcWdn{p.in[24]}, (bf16_t*)(ws + O_WDN), DFF, DM / 32, r, scr, lane);
    }
    const float* x = p.in[0]; const float* meta = p.in[1]; const float* g1 = p.in[2];
    bf16_t* U1 = (bf16_t*)(ws + O_U1);
    for (int row = gw; row < TP; row += ngw) {
        const int b = row / LP, pr = row % LP - LPAD;
        u32x2* o = (u32x2*)(U1 + (size_t)row * DM) + lane;
        if (pr < 0) {
#pragma unroll
            for (int j = 0; j < 4; ++j) o[64 * j] = (u32x2){0u, 0u};
            continue;
        }
        const float* src = pr < NMETA ? meta + (size_t)pr * DM : x + ((size_t)b * SEQ + (pr - NMETA)) * DM;
        const f32x4* xr = (const f32x4*)src + lane;
        f32x4 v[4]; float s = 0.f;
#pragma unroll
        for (int j = 0; j < 4; ++j) { v[j] = xr[64 * j]; s += (v[j].x * v[j].x + v[j].y * v[j].y) + (v[j].z * v[j].z + v[j].w * v[j].w); }
        const float rstd = 1.0f / sqrtf(wave_sum(s) * (1.f / DM) + RMS_EPS);
#pragma unroll
        for (int j = 0; j < 4; ++j) { const f32x4 g = ((const f32x4*)g1)[lane + 64 * j];
            o[64 * j] = (u32x2){pk2(v[j].x * rstd * g.x, v[j].y * rstd * g.y), pk2(v[j].z * rstd * g.z, v[j].w * rstd * g.w)}; }
    }
    float* rope = (float*)(ws + O_ROPE);
    for (int i = gw * 64 + lane; i < L * 32; i += ngw * 64) {
        const int pos = i >> 5, f = i & 31; float s, c; sincos_d((double)pos * c_inv_freq[f], s, c);
        rope[2 * i] = c; rope[2 * i + 1] = s;
    }
    float* ssq = (float*)(ws + O_SSQ2);
    for (int i = gw * 64 + lane; i < (int)((O_CTL - O_SSQ2) / 4); i += ngw * 64) ssq[i] = 0.f;
}

__device__ __forceinline__ void p2_row(const Params& p, int row, int lane) {
    unsigned char* ws = p.ws;
    const bf16_t* P = (const bf16_t*)(ws + O_P);
    const bf16_t* cur = P + (size_t)row * NIN; const bf16_t* prv = cur - NIN;
    const bool has_prev = row > 0;
    const float* mu = p.in[4]; const float* k_k = p.in[10];
    f16_t* R = (f16_t*)(ws + O_R); f16_t* VV = (f16_t*)(ws + O_VV); f16_t* KK = (f16_t*)(ws + O_KK); f16_t* KM = (f16_t*)(ws + O_KMOD);
    bf16_t* LIN = (bf16_t*)(ws + O_LIN); bf16_t* CQKV = (bf16_t*)(ws + O_CQKV); bf16_t* Kb = (bf16_t*)(ws + O_K);
    float ssq_q = 0.f, ssq_kv = 0.f;
    for (int ch = lane; ch < 320; ch += 64) {
        const bool act = ch < 316; const int c0 = 8 * ch;
        float v[8];
        {
            u32x4 a = (u32x4){0u, 0u, 0u, 0u};
            if (act) a = *(const u32x4*)(cur + c0);
            v[0] = bf2f(a.x & 0xffffu); v[1] = bf2f(a.x >> 16); v[2] = bf2f(a.y & 0xffffu); v[3] = bf2f(a.y >> 16);
            v[4] = bf2f(a.z & 0xffffu); v[5] = bf2f(a.z >> 16); v[6] = bf2f(a.w & 0xffffu); v[7] = bf2f(a.w >> 16);
        }
        if (c0 < RCOLS) {
            u32x4 b = (u32x4){0u, 0u, 0u, 0u};
            if (act && has_prev) b = *(const u32x4*)(prv + c0);
            float q[8];
            q[0] = bf2f(b.x & 0xffffu); q[1] = bf2f(b.x >> 16); q[2] = bf2f(b.y & 0xffffu); q[3] = bf2f(b.y >> 16);
            q[4] = bf2f(b.z & 0xffffu); q[5] = bf2f(b.z >> 16); q[6] = bf2f(b.w & 0xffffu); q[7] = bf2f(b.w >> 16);
#pragma unroll
            for (int j = 0; j < 8; ++j) v[j] = v[j] + (q[j] - v[j]) * mu[c0 + j];
        }
        const bool isk = (c0 >= 512 && c0 < 1024);
        float ss = 0.f; float kkv[8];
        if (isk) {
#pragma unroll
            for (int j = 0; j < 8; ++j) { kkv[j] = v[j] * k_k[c0 - 512 + j]; ss += kkv[j] * kkv[j]; }
        }
        ss += __shfl_xor(ss, 1); ss += __shfl_xor(ss, 2); ss += __shfl_xor(ss, 4);
        if (!act) continue;
        if (c0 < 512) {
#pragma unroll
            for (int j = 0; j < 8; ++j) R[(size_t)row * 512 + c0 + j] = (f16_t)v[j];
        } else if (c0 < 1024) {
            const float inv = 1.f / fmaxf(sqrtf(ss), 1e-12f);
#pragma unroll
            for (int j = 0; j < 8; ++j) { KM[(size_t)row * 512 + c0 - 512 + j] = (f16_t)v[j]; KK[(size_t)row * 512 + c0 - 512 + j] = (f16_t)(kkv[j] * inv); }
        } else if (c0 < 1536) {
#pragma unroll
            for (int j = 0; j < 8; ++j) VV[(size_t)row * 512 + c0 - 1024 + j] = (f16_t)v[j];
        } else if (c0 < 1600) {
#pragma unroll
            for (int j = 0; j < 8; ++j) LIN[(size_t)row * 384 + c0 - 1536 + j] = (bf16_t)f2bf(tanhf(v[j]));
        } else if (c0 < 1664) {
#pragma unroll
            for (int j = 0; j < 8; ++j) LIN[(size_t)row * 384 + c0 - 1536 + j] = (bf16_t)f2bf(v[j]);
        } else if (c0 < 1824) {
#pragma unroll
            for (int j = 0; j < 8; ++j) LIN[(size_t)row * 384 + c0 - 1536 + j] = (bf16_t)f2bf(sigmoidf_(v[j]));
        } else if (c0 < 2208) {
#pragma unroll
            for (int j = 0; j < 8; ++j) { CQKV[(size_t)row * 640 + c0 - 1824 + j] = (bf16_t)f2bf(v[j]); ssq_q += v[j] * v[j]; }
        } else if (c0 < 2464) {
#pragma unroll
            for (int j = 0; j < 8; ++j) { CQKV[(size_t)row * 640 + c0 - 1824 + j] = (bf16_t)f2bf(v[j]); ssq_kv += v[j] * v[j]; }
        } else {
            const float* t = (const float*)(ws + O_ROPE) + ((size_t)row_pos(row) * 32 + ((c0 - 2464) >> 1)) * 2;
            float o[8];
#pragma unroll
            for (int j = 0; j < 4; ++j) { const float cs = t[2 * j], sn = t[2 * j + 1]; o[2 * j] = v[2 * j] * cs - v[2 * j + 1] * sn; o[2 * j + 1] = v[2 * j + 1] * cs + v[2 * j] * sn; }
            u32x4 w; w.x = pk2(o[0], o[1]); w.y = pk2(o[2], o[3]); w.z = pk2(o[4], o[5]); w.w = pk2(o[6], o[7]);
#pragma unroll
            for (int h = 0; h < NH; ++h) *(u32x4*)(Kb + (size_t)row * 768 + h * DQK + 128 + (c0 - 2464)) = w;
        }
    }
    if (lane < 12) *(u32x4*)(LIN + (size_t)row * 384 + 288 + 8 * lane) = (u32x4){0u, 0u, 0u, 0u};
    ssq_q = wave_sum(ssq_q); ssq_kv = wave_sum(ssq_kv);
    if (lane == 0) { ((float*)(ws + O_RSTDQ))[row] = 1.0f / sqrtf(ssq_q * (1.f / QL) + RMS_EPS); ((float*)(ws + O_RSTDKV))[row] = 1.0f / sqrtf(ssq_kv * (1.f / KVL) + RMS_EPS); }
}
namespace pg8 {
#define PG8_LAS __attribute__((address_space(3)))
typedef short bf16x8 __attribute__((ext_vector_type(8)));
constexpr int BM = 256, BK = 64, HALF = 128, HTB = HALF * BK * 2, STAGE_BYTES = 8 * HTB, NXCD = 8, WGM = 8;
__host__ __device__ __forceinline__ int lds_byte(int r, int c) { const int st = (r >> 4) * 2 + (c >> 5), rr = r & 15, cc = c & 31, ob = rr * 64 + cc * 2; return st * 1024 + (ob ^ (((ob >> 9) & 1) << 5)); }
__host__ __device__ __forceinline__ void stage_rc(int b, int& R, int& C) { const int st = b / 1024, sb = b % 1024, swz = sb ^ (((sb >> 9) & 1) << 5); R = (st >> 1) * 16 + swz / 64; C = (st & 1) * 32 + (swz % 64) / 2; }
__host__ __device__ __forceinline__ int perm32(int rho) { const int n = rho >> 4, i = rho & 15; return 8 * (i >> 2) + 4 * n + (i & 3); }
struct Unit { int pm, pn; };
struct Gemm { const bf16_t* A; const bf16_t* Bt; int lda, ldb, K; };
struct StaticOrder {
    int nM, nN, nwg, G, c;
    __host__ __device__ void init(int M, int N, int G_, int c_) { nM = M / BM; nN = N / BM; nwg = nM * nN; G = G_; c = c_; }
    __host__ __device__ bool next(int i, Unit& u) const {
        const long L = (long)i * G + c; if (L >= nwg) return false;
        int wgid = (int)L; { const int q = nwg / NXCD, r = nwg % NXCD, xcd = wgid % NXCD, off = wgid / NXCD; wgid = (xcd < r ? xcd * (q + 1) : r * (q + 1) + (xcd - r) * q) + off; }
        const int nig = WGM * nN, gid = wgid / nig, fm = gid * WGM, gsz = (nM - fm) < WGM ? (nM - fm) : WGM;
        u.pm = fm + ((wgid % nig) % gsz); u.pn = (wgid % nig) / gsz; return true;
    }
};
template <class F> struct Epi8 {
    F f;
    __device__ __forceinline__ void operator()(const f32x4 (&acc)[2][2][4][2], const Unit& u, int wr, int wc, int fr, int fq) const {
        const int col = u.pn * BM + wc * 32 + 8 * fq;
#pragma unroll
        for (int ai = 0; ai < 2; ++ai)
#pragma unroll
            for (int m = 0; m < 4; ++m) f(u.pm * BM + ai * HALF + wr * 64 + m * 16 + fr, col, acc[ai][0][m][0], acc[ai][0][m][1], acc[ai][1][m][0], acc[ai][1][m][1]);
    }
};

template <class Epi, bool ALIGN_EPI>
__device__ __forceinline__ void gemm_phase(PG8_LAS unsigned char* lds, const Gemm g, const StaticOrder& S, const Epi& E) {
    const int tid = threadIdx.x, wid = __builtin_amdgcn_readfirstlane(tid >> 6), lane = tid & 63, wr = wid >> 2, wc = wid & 3, fr = lane & 15, fq = lane >> 4;
    const int K = g.K, nt = K / BK;
    unsigned voffA[2], voffB[2];
#pragma unroll
    for (int i = 0; i < 2; ++i) { int R, C; stage_rc(tid * 16 + i * 8192, R, C); const int Rb = (R & ~31) + perm32(R & 31);
        voffA[i] = (unsigned)(R * g.lda + C) * 2u; voffB[i] = (unsigned)(Rb * g.ldb + C) * 2u; }
    const size_t kstep = (size_t)(BK * 2);
    const size_t hstepA = (size_t)HALF * g.lda * 2, hstepB = (size_t)HALF * g.ldb * 2;
    const size_t tstepA = 2 * hstepA, tstepB = 2 * hstepB;
    const unsigned ldsw = (unsigned)wid * 1024u;
    const int aoff = lds_byte(wr * 64 + fr, fq * 8), boff = lds_byte(wc * 32 + fr, fq * 8);
#define PG8_SA(b, h) (((b) * 2 + (h)) * HTB)
#define PG8_SB(b, h) ((4 + (b) * 2 + (h)) * HTB)
#define PG8_STAGE(bufoff, gbase, voff) do { _Pragma("unroll") for (int _i = 0; _i < 2; ++_i) \
        __builtin_amdgcn_global_load_lds((const unsigned*)((const char*)(gbase) + (voff)[_i]), (PG8_LAS unsigned*)(lds + (bufoff) + ldsw + _i * 8192), 16, 0, 0); } while (0)
#define PG8_LDA(dst, b, h) do { _Pragma("unroll") for (int m = 0; m < 4; ++m) _Pragma("unroll") for (int k = 0; k < 2; ++k) dst[m][k] = *(const PG8_LAS bf16x8*)(lds + PG8_SA(b, h) + aoff + m * 2048 + k * 1024); } while (0)
#define PG8_LDB(dst, b, h) do { _Pragma("unroll") for (int n = 0; n < 2; ++n) _Pragma("unroll") for (int k = 0; k < 2; ++k) dst[n][k] = *(const PG8_LAS bf16x8*)(lds + PG8_SB(b, h) + boff + n * 2048 + k * 1024); } while (0)
#define PG8_MMA(ai, bj, At, Bt) do { __builtin_amdgcn_s_setprio(1); _Pragma("unroll") for (int m = 0; m < 4; ++m) _Pragma("unroll") for (int n = 0; n < 2; ++n) _Pragma("unroll") for (int k = 0; k < 2; ++k) \
        acc[ai][bj][m][n] = __builtin_amdgcn_mfma_f32_16x16x32_bf16(Bt[n][k], At[m][k], acc[ai][bj][m][n], 0, 0, 0); __builtin_amdgcn_s_setprio(0); } while (0)
#define PG8_WAIT_V(n) asm volatile("s_waitcnt vmcnt(" #n ")" ::: "memory")
#define PG8_WAIT_L(n) asm volatile("s_waitcnt lgkmcnt(" #n ")" ::: "memory")
#define PG8_BAR __builtin_amdgcn_s_barrier()
#define PG8_SCHED __builtin_amdgcn_sched_barrier(0)
    Unit cur, nxt; int ui = 0;
    if (!S.next(0, cur)) return;
    f32x4 acc[2][2][4][2];
#pragma unroll
    for (int a = 0; a < 2; ++a)
#pragma unroll
        for (int b = 0; b < 2; ++b)
#pragma unroll
            for (int m = 0; m < 4; ++m)
#pragma unroll
                for (int n = 0; n < 2; ++n) acc[a][b][m][n] = (f32x4){0.f, 0.f, 0.f, 0.f};
    bf16x8 At[4][2], B0[2][2], B1[2][2];
    const char* cA = (const char*)g.A + (size_t)cur.pm * tstepA; const char* cB = (const char*)g.Bt + (size_t)cur.pn * tstepB;
    PG8_STAGE(PG8_SB(0, 0), cB, voffB); PG8_STAGE(PG8_SB(0, 1), cB + hstepB, voffB); PG8_STAGE(PG8_SA(0, 0), cA, voffA); PG8_STAGE(PG8_SA(0, 1), cA + hstepA, voffA);
    if (wr == 1) PG8_BAR;
    PG8_WAIT_V(2); PG8_BAR;
    PG8_STAGE(PG8_SB(1, 0), cB + kstep, voffB); PG8_STAGE(PG8_SA(1, 0), cA + kstep, voffA); PG8_STAGE(PG8_SB(1, 1), cB + hstepB + kstep, voffB);
    PG8_WAIT_V(6); PG8_BAR;
#pragma nounroll
    for (;;) {
        const bool has_next = S.next(ui + 1, nxt);
        const char* nA = has_next ? (const char*)g.A + (size_t)nxt.pm * tstepA : cA; const char* nB = has_next ? (const char*)g.Bt + (size_t)nxt.pn * tstepB : cB;
#pragma nounroll
        for (int t = 0; t < nt; t += 2) {
            const bool last = (t == nt - 2);
            const char* a1 = cA + (size_t)(t + 1) * kstep;
            const char* a2 = last ? nA : cA + (size_t)(t + 2) * kstep; const char* b2 = last ? nB : cB + (size_t)(t + 2) * kstep;
            const char* a3 = a2 + kstep; const char* b3 = b2 + kstep;
            PG8_LDB(B0, 0, 0); PG8_LDB(B1, 0, 1); PG8_SCHED; PG8_LDA(At, 0, 0); PG8_STAGE(PG8_SA(1, 1), a1 + hstepA, voffA);
            PG8_WAIT_V(8); PG8_WAIT_L(0); PG8_BAR; PG8_MMA(0, 0, At, B0); PG8_MMA(0, 1, At, B1); PG8_BAR; PG8_SCHED;
            PG8_LDA(At, 0, 1); PG8_STAGE(PG8_SB(0, 0), b2, voffB); PG8_STAGE(PG8_SB(0, 1), b2 + hstepB, voffB); PG8_STAGE(PG8_SA(0, 0), a2, voffA);
            PG8_WAIT_V(8); PG8_WAIT_L(0); PG8_BAR; PG8_MMA(1, 0, At, B0); PG8_MMA(1, 1, At, B1); PG8_BAR; PG8_SCHED;
            PG8_LDB(B0, 1, 0); PG8_LDB(B1, 1, 1); PG8_SCHED; PG8_LDA(At, 1, 0); PG8_STAGE(PG8_SA(0, 1), a2 + hstepA, voffA);
            PG8_WAIT_V(8); PG8_WAIT_L(0); PG8_BAR; PG8_MMA(0, 0, At, B0); PG8_MMA(0, 1, At, B1); PG8_BAR; PG8_SCHED;
            PG8_LDA(At, 1, 1); PG8_STAGE(PG8_SB(1, 0), b3, voffB); PG8_STAGE(PG8_SB(1, 1), b3 + hstepB, voffB); PG8_STAGE(PG8_SA(1, 0), a3, voffA);
            PG8_WAIT_V(8); PG8_WAIT_L(0); PG8_BAR; PG8_MMA(1, 0, At, B0); PG8_MMA(1, 1, At, B1); PG8_BAR; PG8_SCHED;
        }
        if constexpr (ALIGN_EPI) { if (wr == 0) PG8_BAR; }
        E(acc, cur, wr, wc, fr, fq);
        if (!has_next) break;
#pragma unroll
        for (int a = 0; a < 2; ++a)
#pragma unroll
            for (int b = 0; b < 2; ++b)
#pragma unroll
                for (int m = 0; m < 4; ++m)
#pragma unroll
                    for (int n = 0; n < 2; ++n) acc[a][b][m][n] = (f32x4){0.f, 0.f, 0.f, 0.f};
        cur = nxt; cA = nA; cB = nB; ++ui;
        if constexpr (ALIGN_EPI) { if (wr == 1) PG8_BAR; }
    }
    PG8_WAIT_V(0);
    if constexpr (!ALIGN_EPI) { if (wr == 0) PG8_BAR; }
    PG8_BAR;
#undef PG8_SA
#undef PG8_SB
#undef PG8_STAGE
#undef PG8_LDA
#undef PG8_LDB
#undef PG8_MMA
#undef PG8_WAIT_V
#undef PG8_WAIT_L
#undef PG8_BAR
#undef PG8_SCHED
}
}

__device__ __forceinline__ u32x4 pack8(const f32x4& a0, const f32x4& a1) { u32x4 w; w.x = pk2(a0[0], a0[1]); w.y = pk2(a0[2], a0[3]); w.z = pk2(a1[0], a1[1]); w.w = pk2(a1[2], a1[3]); return w; }
typedef _Float16 f16x8 __attribute__((ext_vector_type(8)));
struct FP {
    bf16_t* P;
    __device__ __forceinline__ void operator()(int row, int col, const f32x4& a0, const f32x4& a1, const f32x4& b0, const f32x4& b1) const {
        if (col < NIN) *(u32x4*)(P + (size_t)row * NIN + col) = pack8(a0, a1);
        if (col + 128 < NIN) *(u32x4*)(P + (size_t)row * NIN + col + 128) = pack8(b0, b1);
    }
};
struct FQ {
    bf16_t* Q; const float* rstd; const float* rope;
    __device__ __forceinline__ void one(int row, int col, float rs, f32x4 a0, f32x4 a1) const {
        a0 = a0 * rs; a1 = a1 * rs;
        const int c = col % DQK;
        if (c >= 128) { const f32x4* t = (const f32x4*)(rope + ((size_t)row_pos(row) * 32 + ((c - 128) >> 1)) * 2); const f32x4 t0 = t[0], t1 = t[1];
            f32x4 o0, o1;
            o0[0] = a0[0] * t0[0] - a0[1] * t0[1]; o0[1] = a0[1] * t0[0] + a0[0] * t0[1]; o0[2] = a0[2] * t0[2] - a0[3] * t0[3]; o0[3] = a0[3] * t0[2] + a0[2] * t0[3];
            o1[0] = a1[0] * t1[0] - a1[1] * t1[1]; o1[1] = a1[1] * t1[0] + a1[0] * t1[1]; o1[2] = a1[2] * t1[2] - a1[3] * t1[3]; o1[3] = a1[3] * t1[2] + a1[2] * t1[3];
            a0 = o0; a1 = o1; }
        *(u32x4*)(Q + (size_t)row * 768 + col) = pack8(a0, a1);
    }
    __device__ __forceinline__ void operator()(int row, int col, const f32x4& a0, const f32x4& a1, const f32x4& b0, const f32x4& b1) const {
        const float rs = rstd[row] * QSCALE; one(row, col, rs, a0, a1); one(row, col + 128, rs, b0, b1); }
};
struct FKV {
    bf16_t* K; bf16_t* V; const float* rstd;
    __device__ __forceinline__ void one(int row, int col, float rs, const f32x4& a0, const f32x4& a1) const {
        const int h = col >> 8, c = col & 255; const u32x4 w = pack8(a0 * rs, a1 * rs);
        if (c < 128) *(u32x4*)(K + (size_t)row * 768 + h * DQK + c) = w; else *(u32x4*)(V + (size_t)row * 512 + h * DV + (c - 128)) = w; }
    __device__ __forceinline__ void operator()(int row, int col, const f32x4& a0, const f32x4& a1, const f32x4& b0, const f32x4& b1) const {
        const float rs = rstd[row]; one(row, col, rs, a0, a1); one(row, col + 128, rs, b0, b1); }
};
struct FLwa {
    f16_t* EW; f16_t* KMOD; const f16_t* KK; f16_t* Bv; const float* w0; const float* a0p; const float* k_a;
    __device__ __forceinline__ void one(int row, int col, const f32x4& a0, const f32x4& a1) const {
        float v[8] = {a0[0], a0[1], a0[2], a0[3], a1[0], a1[1], a1[2], a1[3]};
        if (col < 512) {
            f16x8 o;
#pragma unroll
            for (int j = 0; j < 8; ++j) { const float xx = w0[col + j] + v[j]; const float sp = (-xx > 20.f) ? -xx : __logf(1.f + __expf(-xx)); o[j] = (f16_t)__expf(-sp - 0.5f); }
            *(f16x8*)(EW + (size_t)row * 512 + col) = o;
        } else {
            const int c = col - 512; const size_t idx = (size_t)row * 512 + c;
            const f16x8 kv = *(const f16x8*)(KMOD + idx), kkv = *(const f16x8*)(KK + idx); f16x8 ko, bo;
#pragma unroll
            for (int j = 0; j < 8; ++j) { const float a = sigmoidf_(a0p[c + j] + v[j]); ko[j] = (f16_t)((float)kv[j] * (1.f + (a - 1.f) * k_a[c + j])); bo[j] = (f16_t)((float)kkv[j] * a); }
            *(f16x8*)(KMOD + idx) = ko; *(f16x8*)(Bv + idx) = bo;
        }
    }
    __device__ __forceinline__ void operator()(int row, int col, const f32x4& a0, const f32x4& a1, const f32x4& b0, const f32x4& b1) const { one(row, col, a0, a1); one(row, col + 128, b0, b1); }
};
struct FG { bf16_t* G;
    __device__ __forceinline__ void operator()(int row, int col, const f32x4& a0, const f32x4& a1, const f32x4& b0, const f32x4& b1) const {
        *(u32x4*)(G + (size_t)row * 512 + col) = pack8(a0, a1); *(u32x4*)(G + (size_t)row * 512 + col + 128) = pack8(b0, b1); } };
struct FOut {
    const float* x; float* H2; bf16_t* H2B; float* ssq;
    __device__ __forceinline__ float one(size_t idx, const f32x4& a0, const f32x4& a1) const {
        const f32x4 h0 = *(const f32x4*)(x + idx) + a0, h1 = *(const f32x4*)(x + idx + 4) + a1;
        *(f32x4*)(H2 + idx) = h0; *(f32x4*)(H2 + idx + 4) = h1; *(u32x4*)(H2B + idx) = pack8(h0, h1);
        return (h0[0] * h0[0] + h0[1] * h0[1]) + (h0[2] * h0[2] + h0[3] * h0[3]) + (h1[0] * h1[0] + h1[1] * h1[1]) + (h1[2] * h1[2] + h1[3] * h1[3]); }
    __device__ __forceinline__ void operator()(int row, int col, const f32x4& a0, const f32x4& a1, const f32x4& b0, const f32x4& b1) const {
        float s = one((size_t)row * DM + col, a0, a1) + one((size_t)row * DM + col + 128, b0, b1);
        s += __shfl_xor(s, 16); s += __shfl_xor(s, 32);
        if ((threadIdx.x & 63) < 16) atomicAdd(ssq + row, s); }
};
struct FAct {
    bf16_t* ACT; const float* ssq;
    __device__ __forceinline__ void operator()(int row, int col, const f32x4& a0, const f32x4& a1, const f32x4& b0, const f32x4& b1) const {
        const float rs = 1.0f / sqrtf(ssq[row] * (1.f / DM) + RMS_EPS);
        f32x4 o0, o1;
#pragma unroll
        for (int j = 0; j < 4; ++j) { const float g0 = a0[j] * rs, g1 = a1[j] * rs; o0[j] = g0 * sigmoidf_(g0) * (b0[j] * rs); o1[j] = g1 * sigmoidf_(g1) * (b1[j] * rs); }
        *(u32x4*)(ACT + (size_t)row * DFF + (col >> 8) * 128 + (col & 127)) = pack8(o0, o1); }
};
struct FDown {
    float* H; float* ssq;
    __device__ __forceinline__ float one(size_t idx, const f32x4& a0, const f32x4& a1) const {
        const f32x4 h0 = *(const f32x4*)(H + idx) + a0, h1 = *(const f32x4*)(H + idx + 4) + a1; *(f32x4*)(H + idx) = h0; *(f32x4*)(H + idx + 4) = h1;
        return (h0[0] * h0[0] + h0[1] * h0[1]) + (h0[2] * h0[2] + h0[3] * h0[3]) + (h1[0] * h1[0] + h1[1] * h1[1]) + (h1[2] * h1[2] + h1[3] * h1[3]); }
    __device__ __forceinline__ void operator()(int row, int col, const f32x4& a0, const f32x4& a1, const f32x4& b0, const f32x4& b1) const {
        float s = one((size_t)row * DM + col, a0, a1) + one((size_t)row * DM + col + 128, b0, b1);
        s += __shfl_xor(s, 16); s += __shfl_xor(s, 32);
        if ((threadIdx.x & 63) < 16) atomicAdd(ssq + row, s); }
};

__device__ __forceinline__ void scan_simple_unit(const Params& p, int unit, int t256) {
    unsigned char* ws = p.ws;
    const f16_t* R = (const f16_t*)(ws + O_R); const f16_t* VV = (const f16_t*)(ws + O_VV); const f16_t* KK = (const f16_t*)(ws + O_KK); const f16_t* KM = (const f16_t*)(ws + O_KMOD);
    const f16_t* EW = (const f16_t*)(ws + O_EW); const f16_t* Bv = (const f16_t*)(ws + O_B);
    float* YRAW = p.out;
    const int bh = unit >> 2, quarter = unit & 3, b = bh >> 3, h = bh & 7;
    const int il = t256 >> 4, c = t256 & 15, i = 16 * quarter + il;
    float S[4] = {0.f, 0.f, 0.f, 0.f};
    const size_t base = ((size_t)b * LP + LPAD) * 512 + h * 64;
    for (int t = 0; t < L; ++t) {
        const size_t o = base + (size_t)t * 512 + 4 * c;
        float w[4], kk[4], bb[4], k[4], r[4];
#pragma unroll
        for (int j = 0; j < 4; ++j) { w[j] = __expf(-(float)EW[o + j]); kk[j] = (float)KK[o + j]; bb[j] = (float)Bv[o + j]; k[j] = (float)KM[o + j]; r[j] = (float)R[o + j]; }
        const float v = (float)VV[base + (size_t)t * 512 + i];
        float sa = 0.f;
#pragma unroll
        for (int j = 0; j < 4; ++j) sa += S[j] * kk[j];
        sa += __shfl_xor(sa, 1); sa += __shfl_xor(sa, 2); sa += __shfl_xor(sa, 4); sa += __shfl_xor(sa, 8);
        sa = -sa;
        float y = 0.f;
#pragma unroll
        for (int j = 0; j < 4; ++j) { S[j] = S[j] * w[j] + sa * bb[j] + v * k[j]; y += S[j] * r[j]; }
        y += __shfl_xor(y, 1); y += __shfl_xor(y, 2); y += __shfl_xor(y, 4); y += __shfl_xor(y, 8);
        if (c == 0) YRAW[base + (size_t)t * 512 + i] = y;
    }
}

__device__ __forceinline__ void attn_simple_unit(const Params& p, float* sm, int unit, int tid) {
    float* Qs = sm;
    float* Ks = Qs + 64 * 192;
    float* Vs = Ks + 64 * 193;
    float* Ps = Vs + 64 * 128;
    unsigned char* ws = p.ws;
    const bf16_t* Q = (const bf16_t*)(ws + O_Q); const bf16_t* Kb = (const bf16_t*)(ws + O_K); const bf16_t* V = (const bf16_t*)(ws + O_V);
    bf16_t* Y = (bf16_t*)(ws + O_Y); const float* og = p.in[19];
    const int qt = unit & 63, h = (unit >> 6) & 3, b = unit >> 8;
    const size_t rb = (size_t)b * LP;
    const int qrow0 = 64 + 64 * qt;
    __syncthreads();
    for (int i = tid; i < 64 * 192; i += 512) { const int r = i / 192, d = i % 192; Qs[i] = bf2f(Q[(rb + qrow0 + r) * 768 + h * DQK + d]); }
    const int qi = (tid & 255) >> 2, sub = tid & 3; const bool act = tid < 256;
    float m = -1e30f, l = 0.f; float o[32];
#pragma unroll
    for (int j = 0; j < 32; ++j) o[j] = 0.f;
    const int nkt = qt + 2;
    for (int kt = 0; kt < nkt; ++kt) {
        __syncthreads();
        for (int i = tid; i < 64 * 192; i += 512) { const int r = i / 192, d = i % 192; Ks[r * 193 + d] = bf2f(Kb[(rb + 64 * kt + r) * 768 + h * DQK + d]); }
        for (int i = tid; i < 64 * 128; i += 512) { const int r = i >> 7, d = i & 127; Vs[i] = bf2f(V[(rb + 64 * kt + r) * 512 + h * DV + d]); }
        __syncthreads();
        float scale = 1.f;
        if (act) {
            float sc[16]; float mx = -1e30f;
#pragma unroll
            for (int kk = 0; kk < 16; ++kk) {
                const int key = sub + 4 * kk; float s = 0.f;
                for (int d = 0; d < 192; ++d) s += Qs[qi * 192 + d] * Ks[key * 193 + d];
                const int krow = 64 * kt + key;
                if (krow < LPAD || krow > qrow0 + qi) s = -1e30f;
                sc[kk] = s; mx = fmaxf(mx, s);
            }
            mx = fmaxf(mx, __shfl_xor(mx, 1)); mx = fmaxf(mx, __shfl_xor(mx, 2));
            const float mn = fmaxf(m, mx); scale = exp2f(m - mn);
            float ps = 0.f;
#pragma unroll
            for (int kk = 0; kk < 16; ++kk) { const float pv = (sc[kk] <= -1e29f) ? 0.f : exp2f(sc[kk] - mn); Ps[qi * 65 + sub + 4 * kk] = pv; ps += pv; }
            ps += __shfl_xor(ps, 1); ps += __shfl_xor(ps, 2);
            l = l * scale + ps; m = mn;
        }
        __syncthreads();
        if (act) {
#pragma unroll
            for (int j = 0; j < 32; ++j) o[j] *= scale;
            for (int key = 0; key < 64; ++key) { const float pv = Ps[qi * 65 + key];
#pragma unroll
                for (int j = 0; j < 32; ++j) o[j] += pv * Vs[key * 128 + sub * 32 + j]; }
        }
    }
    if (act) {
        const float il = 1.f / l; float ss = 0.f;
#pragma unroll
        for (int j = 0; j < 32; ++j) { o[j] *= il; ss += o[j] * o[j]; }
        ss += __shfl_xor(ss, 1); ss += __shfl_xor(ss, 2);
        const float rs = 1.0f / sqrtf(ss * (1.f / DV) + RMS_EPS);
        const size_t yrow = (size_t)b * SEQ + 64 * qt + qi;
#pragma unroll
        for (int j = 0; j < 32; ++j) Y[yrow * DM + 512 + h * DV + sub * 32 + j] = (bf16_t)f2bf(o[j] * rs * og[h * DV + sub * 32 + j]);
    }
}

namespace scan {
#define SC_LAS __attribute__((address_space(3)))
constexpr int TS = 32, STEP_F = 5 * 64 + 16, BUF_F = TS * STEP_F, NCH = (L + TS - 1) / TS;
constexpr int SCAN_LDS = 2 * BUF_F * 4;
typedef _Float16 h8 __attribute__((ext_vector_type(8)));
typedef _Float16 h2 __attribute__((ext_vector_type(2)));
template <int CTRL> __device__ __forceinline__ float dppf(float x) { return __builtin_bit_cast(float, __builtin_amdgcn_update_dpp(0, __builtin_bit_cast(int, x), CTRL, 0xF, 0xF, true)); }
__device__ __forceinline__ float row_sum16(float x) { x += dppf<0xB1>(x); x += dppf<0x4E>(x); x += dppf<0x141>(x); x += dppf<0x140>(x); return x; }

__device__ __forceinline__ void scan_unit(const Params& p, SC_LAS float* lds, int unit) {
    unsigned char* ws = p.ws;
    const int tid = threadIdx.x, lane = tid & 63; const int wave = __builtin_amdgcn_readfirstlane(tid >> 6);
    const int bh = unit >> 2, quarter = unit & 3, b = bh >> 3, h = bh & 7;
    const size_t ebase = ((size_t)b * LP + LPAD) * 512 + h * 64;
    __syncthreads();
    if (wave >= 4) {
        const f16_t* src[5] = {(const f16_t*)(ws + O_EW), (const f16_t*)(ws + O_KK), (const f16_t*)(ws + O_B), (const f16_t*)(ws + O_KMOD), (const f16_t*)(ws + O_R)};
        const f16_t* VV = (const f16_t*)(ws + O_VV);
        const int t2 = tid - 256, tt = t2 >> 3, c8 = (t2 & 7) * 8, pr = t2 & 7;
#pragma nounroll
        for (int ch = 0; ch <= NCH; ++ch) {
            if (ch < NCH) {
                const int t = ch * TS + tt;
                if (t < L) {
                    SC_LAS float* dst = lds + (ch & 1) * BUF_F + tt * STEP_F;
                    const size_t e = ebase + (size_t)t * 512;
#pragma unroll
                    for (int a = 0; a < 5; ++a) {
                        const h8 v = *(const h8*)(src[a] + e + c8);
                        f32x4 lo, hi;
#pragma unroll
                        for (int j = 0; j < 4; ++j) { lo[j] = (float)v[j]; hi[j] = (float)v[4 + j]; }
                        if (a == 0) {
#pragma unroll
                            for (int j = 0; j < 4; ++j) { lo[j] = __expf(-lo[j]); hi[j] = __expf(-hi[j]); }
                        }
                        *(SC_LAS f32x4*)(dst + a * 64 + c8) = lo; *(SC_LAS f32x4*)(dst + a * 64 + c8 + 4) = hi;
                    }
                    const h2 vv = *(const h2*)(VV + e + 16 * quarter + 2 * pr);
                    dst[320 + 2 * pr] = (float)vv[0]; dst[320 + 2 * pr + 1] = (float)vv[1];
                }
            }
            __syncthreads();
        }
    } else {
        const int g = lane >> 4, c = lane & 15, i = 16 * quarter + 4 * wave + g;
        float* yout = p.out + ebase + i;
        float S0 = 0.f, S1 = 0.f, S2 = 0.f, S3 = 0.f;
        __syncthreads();
#pragma nounroll
        for (int ch = 0; ch < NCH; ++ch) {
            const SC_LAS float* st = lds + (ch & 1) * BUF_F + 4 * c;
            const int n = (L - ch * TS) < TS ? (L - ch * TS) : TS;
            float* yo = yout + (size_t)(ch * TS) * 512;
#pragma unroll 4
            for (int t = 0; t < n; ++t) {
                const f32x4 w4 = *(const SC_LAS f32x4*)(st), kk4 = *(const SC_LAS f32x4*)(st + 64), b4 = *(const SC_LAS f32x4*)(st + 128), k4 = *(const SC_LAS f32x4*)(st + 192), r4 = *(const SC_LAS f32x4*)(st + 256);
                const float v = st[320 - 4 * c + 4 * wave + g];
                float sa = (S0 * kk4[0] + S1 * kk4[1]) + (S2 * kk4[2] + S3 * kk4[3]);
                sa = -row_sum16(sa);
                S0 = S0 * w4[0] + (sa * b4[0] + v * k4[0]); S1 = S1 * w4[1] + (sa * b4[1] + v * k4[1]);
                S2 = S2 * w4[2] + (sa * b4[2] + v * k4[2]); S3 = S3 * w4[3] + (sa * b4[3] + v * k4[3]);
                float y = (S0 * r4[0] + S1 * r4[1]) + (S2 * r4[2] + S3 * r4[3]);
                y = row_sum16(y);
                if (c == 0) yo[(size_t)t * 512] = y;
                st += STEP_F;
            }
            __syncthreads();
        }
    }
}
}

namespace att {
#define ATT_LAS __attribute__((address_space(3)))
typedef float f32x16 __attribute__((ext_vector_type(16)));
typedef short bf16x8 __attribute__((ext_vector_type(8)));
typedef short s16x4 __attribute__((ext_vector_type(4)));
typedef float f32x2_t __attribute__((ext_vector_type(2)));
typedef __bf16 bf16x2_t __attribute__((ext_vector_type(2)));
constexpr int KROW = 400, VROW = 320, KBUF = 64 * KROW, VBUF = 64 * VROW;
constexpr int L_K = 0, L_V = 2 * KBUF, L_SCR = 2 * KBUF + 2 * VBUF, ATT_LDS = L_SCR + 8 * 256;
__device__ __forceinline__ int crow(int i, int hi) { return (i & 3) + 8 * (i >> 2) + 4 * hi; }
__device__ __forceinline__ unsigned cvtpk(float lo, float hi) { f32x2_t v = {lo, hi}; bf16x2_t b = __builtin_convertvector(v, bf16x2_t); return __builtin_bit_cast(unsigned, b); }
template <int K> __device__ __forceinline__ float swz_xor(float x) { return __builtin_bit_cast(float, __builtin_amdgcn_ds_swizzle(__builtin_bit_cast(int, x), 0x1F | (K << 10))); }
__device__ __forceinline__ float x32_max(float x) { auto r = __builtin_amdgcn_permlane32_swap(__builtin_bit_cast(unsigned, x), __builtin_bit_cast(unsigned, x), false, false); return fmaxf(__builtin_bit_cast(float, r[0]), __builtin_bit_cast(float, r[1])); }
__device__ __forceinline__ float x32_sum(float x) { auto r = __builtin_amdgcn_permlane32_swap(__builtin_bit_cast(unsigned, x), __builtin_bit_cast(unsigned, x), false, false); return __builtin_bit_cast(float, r[0]) + __builtin_bit_cast(float, r[1]); }
__device__ __forceinline__ s16x4 vtr(const ATT_LAS unsigned char* p) { return __builtin_bit_cast(s16x4, __builtin_amdgcn_ds_read_tr16_b64_v4i16((ATT_LAS s16x4*)p)); }

__device__ __forceinline__ void attn_unit(const Params& p, ATT_LAS unsigned char* lds, int b, int h, int qblk) {
    const int tid = threadIdx.x, lane = tid & 63, r32 = lane & 31, hi = lane >> 5; const int w = __builtin_amdgcn_readfirstlane(tid >> 6);
    unsigned char* ws = p.ws;
    const bf16_t* Q = (const bf16_t*)(ws + O_Q); const bf16_t* Kg = (const bf16_t*)(ws + O_K); const bf16_t* Vg = (const bf16_t*)(ws + O_V);
    const size_t rowbase = (size_t)b * LP;
    const int qrow = 64 + 256 * qblk + 32 * w + r32;
    const int NT = 4 * qblk + 5, jband = 4 * qblk + 1, jdiag = jband + (w >> 1);
    bf16x8 qf[12];
    { const bf16_t* qp = Q + (rowbase + qrow) * 768 + h * DQK + 8 * hi;
#pragma unroll
      for (int s = 0; s < 12; ++s) qf[s] = *(const bf16x8*)(qp + 16 * s); }
    const unsigned char* kbase = (const unsigned char*)(Kg + rowbase * 768 + h * DQK);
    const unsigned char* vbase = (const unsigned char*)(Vg + rowbase * 512 + h * DV);
    const unsigned sr = (unsigned)tid >> 3, sc8 = ((unsigned)tid & 7u) * 16u;
    const unsigned ko = sr * 1536u + sc8, vo = sr * 1024u + sc8, kl = (unsigned)L_K + sr * KROW + sc8, vl = (unsigned)L_V + sr * VROW + sc8;
    u32x4 sk[3], sv[2];
#define ATT_LOAD(j) do { const unsigned char* kb_ = kbase + (size_t)(j) * (64 * 768 * 2) + ko; const unsigned char* vb_ = vbase + (size_t)(j) * (64 * 512 * 2) + vo; \
                         _Pragma("unroll") for (int i_ = 0; i_ < 3; ++i_) sk[i_] = *(const u32x4*)(kb_ + 128 * i_); \
                         _Pragma("unroll") for (int i_ = 0; i_ < 2; ++i_) sv[i_] = *(const u32x4*)(vb_ + 128 * i_); } while (0)
#define ATT_WRITE(buf) do { _Pragma("unroll") for (int i_ = 0; i_ < 3; ++i_) *(ATT_LAS u32x4*)(lds + kl + (buf) * KBUF + 128 * i_) = sk[i_]; \
                            _Pragma("unroll") for (int i_ = 0; i_ < 2; ++i_) *(ATT_LAS u32x4*)(lds + vl + (buf) * VBUF + 128 * i_) = sv[i_]; } while (0)
    ATT_LAS float* scr = (ATT_LAS float*)(lds + L_SCR + w * 256);
    f32x16 o[4];
#pragma unroll
    for (int d = 0; d < 4; ++d)
#pragma unroll
        for (int i = 0; i < 16; ++i) o[d][i] = 0.f;
    float m = -1e30f, lsum = 0.f;
    const ATT_LAS unsigned char* kp0 = lds + L_K + r32 * KROW + hi * 16;
    const ATT_LAS unsigned char* vp0 = lds + L_V + (4 * hi + ((lane & 15) >> 2)) * VROW + (((lane >> 4) & 1) * 16 + (lane & 3) * 4) * 2;
    ATT_LOAD(0); ATT_WRITE(0);
    __syncthreads();
#pragma nounroll
    for (int j = 0; j < NT; ++j) {
        const int buf = j & 1;
        if (j + 1 < NT) ATT_LOAD(j + 1);
        if (j <= jdiag) {
            const ATT_LAS unsigned char* kp = kp0 + buf * KBUF;
            f32x16 p0, p1;
#pragma unroll
            for (int i = 0; i < 16; ++i) { p0[i] = 0.f; p1[i] = 0.f; }
#pragma unroll
            for (int s = 0; s < 12; ++s) {
                const bf16x8 k0 = *(const ATT_LAS bf16x8*)(kp + s * 32), k1 = *(const ATT_LAS bf16x8*)(kp + 32 * KROW + s * 32);
                p0 = __builtin_amdgcn_mfma_f32_32x32x16_bf16(k0, qf[s], p0, 0, 0, 0);
                p1 = __builtin_amdgcn_mfma_f32_32x32x16_bf16(k1, qf[s], p1, 0, 0, 0);
                if ((s & 3) == 3) __builtin_amdgcn_sched_barrier(0);
            }
            if (j == 0 || j >= jband) {
#pragma unroll
                for (int i = 0; i < 16; ++i) { const int kr = 64 * j + crow(i, hi);
                    if (kr < LPAD || kr > qrow) p0[i] = -1e30f;
                    if (kr + 32 < LPAD || kr + 32 > qrow) p1[i] = -1e30f; }
            }
            float mx = fmaxf(p0[0], p1[0]);
#pragma unroll
            for (int i = 1; i < 16; ++i) mx = fmaxf(mx, fmaxf(p0[i], p1[i]));
            mx = x32_max(mx);
            const float mn = fmaxf(m, mx);
            const bool grew = mn > m;
            const float alpha = __builtin_amdgcn_exp2f(m - mn);
            m = mn;
            float rs = 0.f;
#pragma unroll
            for (int i = 0; i < 16; ++i) { p0[i] = __builtin_amdgcn_exp2f(p0[i] - mn); p1[i] = __builtin_amdgcn_exp2f(p1[i] - mn); rs += p0[i] + p1[i]; }
            lsum = lsum * alpha + rs;
            if (__any(grew)) {
                if (hi == 0) scr[r32] = alpha;
#pragma unroll
                for (int g = 0; g < 4; ++g) { const f32x4 a4 = *(const ATT_LAS f32x4*)(scr + 8 * g + 4 * hi);
#pragma unroll
                    for (int d = 0; d < 4; ++d) { o[d][4 * g + 0] *= a4[0]; o[d][4 * g + 1] *= a4[1]; o[d][4 * g + 2] *= a4[2]; o[d][4 * g + 3] *= a4[3]; } }
            }
            u32x4 pw[4];
#pragma unroll
            for (int s = 0; s < 2; ++s) {
                pw[s] = (u32x4){cvtpk(p0[8 * s], p0[8 * s + 1]), cvtpk(p0[8 * s + 2], p0[8 * s + 3]), cvtpk(p0[8 * s + 4], p0[8 * s + 5]), cvtpk(p0[8 * s + 6], p0[8 * s + 7])};
                pw[2 + s] = (u32x4){cvtpk(p1[8 * s], p1[8 * s + 1]), cvtpk(p1[8 * s + 2], p1[8 * s + 3]), cvtpk(p1[8 * s + 4], p1[8 * s + 5]), cvtpk(p1[8 * s + 6], p1[8 * s + 7])};
            }
            const ATT_LAS unsigned char* vp = vp0 + buf * VBUF;
            __builtin_amdgcn_sched_barrier(0);
#pragma unroll
            for (int ks = 0; ks < 4; ++ks) {
                const bf16x8 pa = __builtin_bit_cast(bf16x8, pw[ks]);
#pragma unroll
                for (int d = 0; d < 4; ++d) {
                    const s16x4 lo = vtr(vp + (16 * ks) * VROW + 64 * d), hh = vtr(vp + (16 * ks + 8) * VROW + 64 * d);
                    const bf16x8 vb = (bf16x8){lo[0], lo[1], lo[2], lo[3], hh[0], hh[1], hh[2], hh[3]};
                    o[d] = __builtin_amdgcn_mfma_f32_32x32x16_bf16(pa, vb, o[d], 0, 0, 0);
                }
                __builtin_amdgcn_sched_barrier(0);
            }
        }
        if (j + 1 < NT) ATT_WRITE(buf ^ 1);
        __syncthreads();
    }
#undef ATT_LOAD
#undef ATT_WRITE
    const float ltot = x32_sum(lsum);
    if (hi == 0) scr[32 + r32] = ltot;
    const float* og = p.in[19] + h * DV;
    float gl[4];
#pragma unroll
    for (int d = 0; d < 4; ++d) gl[d] = og[32 * d + r32];
    bf16_t* Y = (bf16_t*)(ws + O_Y) + ((size_t)b * SEQ + 256 * qblk + 32 * w) * DM + 512 + h * DV + r32;
#pragma unroll
    for (int g = 0; g < 4; ++g) {
        const f32x4 l4 = *(const ATT_LAS f32x4*)(scr + 32 + 8 * g + 4 * hi);
#pragma unroll
        for (int e = 0; e < 4; ++e) {
            const int i = 4 * g + e;
            float ss = o[0][i] * o[0][i] + o[1][i] * o[1][i] + o[2][i] * o[2][i] + o[3][i] * o[3][i];
            ss += swz_xor<1>(ss); ss += swz_xor<2>(ss); ss += swz_xor<4>(ss); ss += swz_xor<8>(ss); ss += swz_xor<16>(ss);
            const float inv = 1.f / l4[e];
            const float sc = inv / sqrtf(ss * inv * inv * (1.f / DV) + RMS_EPS);
            bf16_t* yr = Y + (size_t)crow(i, hi) * DM;
#pragma unroll
            for (int d = 0; d < 4; ++d) yr[32 * d] = (bf16_t)f2bf(o[d][i] * sc * gl[d]);
        }
    }
}
}

__device__ __forceinline__ void p5_phase(const Params& p, int gw, int ngw, int lane) {
    unsigned char* ws = p.ws;
    const float* YRAW = p.out;
    const f16_t* R = (const f16_t*)(ws + O_R); const f16_t* VV = (const f16_t*)(ws + O_VV); const f16_t* KM = (const f16_t*)(ws + O_KMOD); const bf16_t* G = (const bf16_t*)(ws + O_G);
    bf16_t* Y = (bf16_t*)(ws + O_Y);
    const float* r_k = p.in[12]; const float* ln_w = p.in[13]; const float* ln_b = p.in[14];
    for (int it = gw; it < TR * RH; it += ngw) {
        const int rr = it >> 3, h = it & 7, b = rr / SEQ, s = rr % SEQ;
        const size_t idx = ((size_t)b * LP + 64 + s) * 512 + h * 64 + lane;
        const float y = YRAW[idx];
        const float mean = wave_sum(y) * (1.f / 64.f); const float d = y - mean; const float var = wave_sum(d * d) * (1.f / 64.f);
        const float r = (float)R[idx], k = (float)KM[idx], v = (float)VV[idx];
        const float bonus = wave_sum(r * k * r_k[h * 64 + lane]);
        float yo = d * (1.0f / sqrtf(var + GN_EPS)) * ln_w[h * 64 + lane] + ln_b[h * 64 + lane] + bonus * v;
        yo *= bf2f(G[idx]);
        Y[(size_t)rr * DM + h * 64 + lane] = (bf16_t)f2bf(yo);
    }
}
__device__ __forceinline__ void p9_phase(const Params& p, int gw, int ngw, int lane) {
    const float* ssq = (const float*)(p.ws + O_SSQ3); const float* g = p.in[25];
    for (int row = gw; row < TR; row += ngw) {
        const float rs = 1.0f / sqrtf(ssq[row] * (1.f / DM) + RMS_EPS);
        f32x4* o = (f32x4*)(p.out + (size_t)row * DM) + lane;
#pragma unroll
        for (int j = 0; j < 4; ++j) { const f32x4 gv = ((const f32x4*)g)[lane + 64 * j]; f32x4 v = o[64 * j]; v = v * rs * gv; o[64 * j] = v; }
    }
}

#ifndef PH_MASK
#define PH_MASK 0xFFFF
#endif
#define PH(k) ((PH_MASK >> (k)) & 1)
constexpr int LDS_BYTES = 153600;
constexpr int LDS_MISC = LDS_BYTES - 256;
__global__ void __launch_bounds__(512, 2) mega_fwd(Params p) {
    extern __shared__ __attribute__((aligned(16))) unsigned char lds[];
    cg::grid_group grid = cg::this_grid();
    const int tid = threadIdx.x, lane = tid & 63, wave = tid >> 6;
    const int G = gridDim.x, gw = blockIdx.x * 8 + wave, ngw = G * 8;
    unsigned char* ws = p.ws;
    PG8_LAS unsigned char* ldsg = (PG8_LAS unsigned char*)lds;
    unsigned* ctl = (unsigned*)(ws + O_CTL);
    if (PH(0)) p0_phase(p, (float*)lds, gw, ngw, lane, wave);
    if (blockIdx.x == 0 && tid < 64) ctl[tid] = 0u;
    grid.sync();
    if (PH(1)) { pg8::Gemm g{(const bf16_t*)(ws + O_U1), (const bf16_t*)(ws + O_WIN), DM, DM, DM}; pg8::StaticOrder S; S.init(TP, NINP, G, blockIdx.x);
      pg8::Epi8<FP> E{FP{(bf16_t*)(ws + O_P)}}; pg8::gemm_phase<pg8::Epi8<FP>, true>(ldsg, g, S, E); }
    grid.sync();
    if (PH(2)) for (int row = gw; row < TP; row += ngw) p2_row(p, row, lane);
    grid.sync();
    if (PH(3)) { pg8::Gemm g{(const bf16_t*)(ws + O_CQKV), (const bf16_t*)(ws + O_WUQ), 640, QL, QL}; pg8::StaticOrder S; S.init(TP, 768, G, blockIdx.x);
      pg8::Epi8<FQ> E{FQ{(bf16_t*)(ws + O_Q), (const float*)(ws + O_RSTDQ), (const float*)(ws + O_ROPE)}}; pg8::gemm_phase<pg8::Epi8<FQ>, true>(ldsg, g, S, E); }
    if (PH(4)) { pg8::Gemm g{(const bf16_t*)(ws + O_CQKV) + 384, (const bf16_t*)(ws + O_WUKV), 640, KVL, KVL}; pg8::StaticOrder S; S.init(TP, 1024, G, blockIdx.x);
      pg8::Epi8<FKV> E{FKV{(bf16_t*)(ws + O_K), (bf16_t*)(ws + O_V), (const float*)(ws + O_RSTDKV)}}; pg8::gemm_phase<pg8::Epi8<FKV>, true>(ldsg, g, S, E); }
    if (PH(5)) { pg8::Gemm g{(const bf16_t*)(ws + O_LIN), (const bf16_t*)(ws + O_LWA), 384, 256, 256}; pg8::StaticOrder S; S.init(TP, 1024, G, blockIdx.x);
      pg8::Epi8<FLwa> E{FLwa{(f16_t*)(ws + O_EW), (f16_t*)(ws + O_KMOD), (const f16_t*)(ws + O_KK), (f16_t*)(ws + O_B), p.in[5], p.in[7], p.in[11]}}; pg8::gemm_phase<pg8::Epi8<FLwa>, true>(ldsg, g, S, E); }
    if (PH(6)) { pg8::Gemm g{(const bf16_t*)(ws + O_LIN) + 128, (const bf16_t*)(ws + O_LG), 384, 256, 256}; pg8::StaticOrder S; S.init(TP, 512, G, blockIdx.x);
      pg8::Epi8<FG> E{FG{(bf16_t*)(ws + O_G)}}; pg8::gemm_phase<pg8::Epi8<FG>, true>(ldsg, g, S, E); }
    grid.sync();
    if (PH(7)) for (int u = blockIdx.x; u < NB * RH * 4; u += G) scan::scan_unit(p, (SC_LAS float*)lds, u);
    if (PH(8)) {
        const int vcu = (G % 8 == 0) ? (int)(blockIdx.x % 8) * (G / 8) + (int)(blockIdx.x / 8) : (int)blockIdx.x;
        for (int pr = vcu; pr < NB * NH * 8; pr += G) {
            const int bh = pr >> 3, q0 = pr & 7;
#pragma nounroll
            for (int u2 = 0; u2 < 2; ++u2) att::attn_unit(p, ldsg, bh >> 2, bh & 3, u2 ? q0 : 15 - q0);
        }
    }
    grid.sync();
    if (PH(9)) p5_phase(p, gw, ngw, lane);
    grid.sync();
    if (PH(10)) { pg8::Gemm g{(const bf16_t*)(ws + O_Y), (const bf16_t*)(ws + O_WOUT), DM, DM, DM}; pg8::StaticOrder S; S.init(TR, DM, G, blockIdx.x);
      pg8::Epi8<FOut> E{FOut{p.in[0], p.out, (bf16_t*)(ws + O_H2B), (float*)(ws + O_SSQ2)}}; pg8::gemm_phase<pg8::Epi8<FOut>, true>(ldsg, g, S, E); }
    grid.sync();
    if (PH(11)) { pg8::Gemm g{(const bf16_t*)(ws + O_H2B), (const bf16_t*)(ws + O_WGU), DM, DM, DM}; pg8::StaticOrder S; S.init(TR, 2 * DFF, G, blockIdx.x);
      pg8::Epi8<FAct> E{FAct{(bf16_t*)(ws + O_ACT), (const float*)(ws + O_SSQ2)}}; pg8::gemm_phase<pg8::Epi8<FAct>, true>(ldsg, g, S, E); }
    grid.sync();
    if (PH(12)) { pg8::Gemm g{(const bf16_t*)(ws + O_ACT), (const bf16_t*)(ws + O_WDN), DFF, DFF, DFF}; pg8::StaticOrder S; S.init(TR, DM, G, blockIdx.x);
      pg8::Epi8<FDown> E{FDown{p.out, (float*)(ws + O_SSQ3)}}; pg8::gemm_phase<pg8::Epi8<FDown>, true>(ldsg, g, S, E); }
    grid.sync();
    if (PH(13)) p9_phase(p, gw, ngw, lane);
}

extern "C" void kernel_launch(void* const* d_in, const int* in_sizes, int n_in, void* d_out, int out_size, void* d_ws, size_t ws_size, hipStream_t stream) {
    static int grid_blocks = 0;
    if (grid_blocks == 0) {
        if (n_in != 26 || out_size != TR * DM || ws_size < 512 * MiB) { fprintf(stderr, "kernel_launch: unexpected sizes n_in=%d out=%d ws=%zu\n", n_in, out_size, ws_size); grid_blocks = -1; return; }
        int dev = 0, cus = 0, per_cu = 0;
        (void)hipGetDevice(&dev); (void)hipDeviceGetAttribute(&cus, hipDeviceAttributeMultiprocessorCount, dev);
        (void)hipFuncSetAttribute((const void*)mega_fwd, hipFuncAttributeMaxDynamicSharedMemorySize, LDS_BYTES);
        (void)hipOccupancyMaxActiveBlocksPerMultiprocessor(&per_cu, (const void*)mega_fwd, 512, LDS_BYTES);
        if (per_cu < 1) { fprintf(stderr, "kernel_launch: occupancy query says %d blocks per CU\n", per_cu); per_cu = 1; }
        if (per_cu > 1) per_cu = 1;
        grid_blocks = cus * per_cu;
    }
    if (grid_blocks < 0) return;
    Params p{};
    for (int i = 0; i < 26; ++i) p.in[i] = (const float*)d_in[i];
    p.out = (float*)d_out; p.ws = (unsigned char*)d_ws;
    void* args[] = {&p};
    hipError_t e = hipLaunchCooperativeKernel((const void*)mega_fwd, dim3(grid_blocks), dim3(512), args, LDS_BYTES, stream);
    if (e != hipSuccess) fprintf(stderr, "cooperative launch failed: %s (grid %d)\n", hipGetErrorString(e), grid_blocks);
}
```

```cpp
#include <hip/hip_runtime.h>
#include <hip/hip_cooperative_groups.h>
namespace cg = cooperative_groups;
#include <cstdio>
#include <cstdint>

typedef unsigned short bf16_t;
typedef _Float16 f16_t;
typedef float f32x4 __attribute__((ext_vector_type(4)));
typedef unsigned u32x4 __attribute__((ext_vector_type(4)));
typedef unsigned u32x2 __attribute__((ext_vector_type(2)));

constexpr int NB = 8, SEQ = 4096, DM = 1024, NMETA = 16, L = SEQ + NMETA;
constexpr int LPAD = 48, LP = L + LPAD;
constexpr int TP = NB * LP;
constexpr int TR = NB * SEQ;
constexpr int NIN = 2528, NINP = 2560, RW = 512, RCOLS = 1824;
constexpr int QL = 384, KVL = 256, DQK = 192, DV = 128, NH = 4, RH = 8, RN = 64;
constexpr int DFF = 2816;
constexpr float RMS_EPS = 1e-6f, GN_EPS = 64e-5f;
constexpr float QSCALE = 0.07216878364870323f * 1.4426950408889634f;

constexpr size_t MiB = 1u << 20;
constexpr size_t al256(size_t x) { return (x + 255) & ~(size_t)255; }
constexpr size_t O_WIN = 0;
constexpr size_t O_WUQ = O_WIN + al256((size_t)NINP * DM * 2);
constexpr size_t O_WUKV = O_WUQ + al256((size_t)768 * QL * 2);
constexpr size_t O_LWA = O_WUKV + al256((size_t)1024 * KVL * 2);
constexpr size_t O_LG = O_LWA + al256((size_t)1024 * 256 * 2);
constexpr size_t O_WOUT = O_LG + al256((size_t)512 * 256 * 2);
constexpr size_t O_WGU = O_WOUT + al256((size_t)DM * DM * 2);
constexpr size_t O_WDN = O_WGU + al256((size_t)2 * DFF * DM * 2);
constexpr size_t O_ROPE = O_WDN + al256((size_t)DM * DFF * 2);
constexpr size_t O_RSTDQ = O_ROPE + al256((size_t)L * 32 * 8);
constexpr size_t O_RSTDKV = O_RSTDQ + al256((size_t)TP * 4);
constexpr size_t O_SSQ2 = O_RSTDKV + al256((size_t)TP * 4);
constexpr size_t O_SSQ3 = O_SSQ2 + al256((size_t)TR * 4);
constexpr size_t O_CTL = O_SSQ3 + al256((size_t)TR * 4);
constexpr size_t O_WEND = O_CTL + 65536;
static_assert(O_WEND <= 32 * MiB, "weight region");
constexpr size_t ROWB = (size_t)TP * 512 * 2;
constexpr size_t O_P = 32 * MiB;
constexpr size_t O_Q = O_P;
constexpr size_t O_V = O_Q + al256((size_t)TP * 768 * 2);
constexpr size_t O_EW = O_V + ROWB;
constexpr size_t O_B = O_EW + ROWB;
static_assert(O_B + ROWB <= O_P + al256((size_t)TP * NIN * 2), "aliases inside P");
constexpr size_t O_U1 = 193 * MiB;
constexpr size_t O_R = O_U1;
constexpr size_t O_VV = O_R + ROWB;
static_assert(O_P + al256((size_t)TP * NIN * 2) <= O_U1 && O_VV + ROWB <= 258 * MiB, "U1 region");
constexpr size_t O_KK = 258 * MiB;
constexpr size_t O_KMOD = O_KK + ROWB;
constexpr size_t O_LIN = O_KMOD + ROWB;
constexpr size_t O_CQKV = O_LIN + al256((size_t)TP * 384 * 2);
constexpr size_t O_K = O_CQKV + al256((size_t)TP * 640 * 2);
constexpr size_t O_G = O_K + al256((size_t)TP * 768 * 2);
constexpr size_t O_END1 = O_G + ROWB;
static_assert(O_END1 <= 512 * MiB, "ws");
constexpr size_t O_Y = O_LIN;
static_assert(O_Y + (size_t)TR * DM * 2 <= O_K, "Y alias");
constexpr size_t O_H2B = O_P;
constexpr size_t O_ACT = O_P + 64 * MiB;
static_assert(O_ACT + (size_t)TR * DFF * 2 <= O_Y, "ACT alias");
static_assert((size_t)TP * 512 * 4 <= (size_t)TR * DM * 4, "YRAW in d_out");

struct Params {
    const float* in[26];
    float* out;
    unsigned char* ws;
};

__device__ __forceinline__ unsigned f2bf(float f) { unsigned u = __builtin_bit_cast(unsigned, f); return (u + 0x7fffu + ((u >> 16) & 1u)) >> 16; }
__device__ __forceinline__ float bf2f(unsigned h) { return __builtin_bit_cast(float, h << 16); }
__device__ __forceinline__ unsigned pk2(float lo, float hi) { return f2bf(lo) | (f2bf(hi) << 16); }
__device__ __forceinline__ float wave_sum(float v) {
#pragma unroll
    for (int o = 1; o < 64; o <<= 1) v += __shfl_xor(v, o);
    return v;
}
__device__ __forceinline__ float sigmoidf_(float x) { return 1.f / (1.f + __expf(-x)); }
__device__ __forceinline__ int row_pos(int row) { int p = row % LP - LPAD; return p < 0 ? 0 : p; }

__constant__ double c_inv_freq[32] = {
    1.0, 0.7498942093324559, 0.5623413251903491, 0.4216965034285822, 0.31622776601683794, 0.23713737056616552, 0.1778279410038923, 0.1333521432163324,
    0.1, 0.07498942093324558, 0.05623413251903491, 0.04216965034285822, 0.03162277660168379, 0.023713737056616554, 0.01778279410038923, 0.01333521432163324,
    0.01, 0.007498942093324559, 0.005623413251903491, 0.004216965034285823, 0.0031622776601683794, 0.0023713737056616554, 0.0017782794100389228, 0.001333521432163324,
    0.001, 0.0007498942093324559, 0.0005623413251903491, 0.0004216965034285822, 0.00031622776601683794, 0.00023713737056616554, 0.00017782794100389227, 0.0001333521432163324};

__device__ __forceinline__ void sincos_d(double a, float& s, float& c) {
    const double q = __builtin_rint(a * 0.6366197723675814);
    double r = __builtin_fma(-q, 1.5707963267948966, a);
    r = __builtin_fma(-q, 6.123233995736766e-17, r);
    const double r2 = r * r;
    double sp = -1.0 / 1307674368000.0;
    sp = sp * r2 + 1.0 / 6227020800.0; sp = sp * r2 - 1.0 / 39916800.0; sp = sp * r2 + 1.0 / 362880.0; sp = sp * r2 - 1.0 / 5040.0; sp = sp * r2 + 1.0 / 120.0; sp = sp * r2 - 1.0 / 6.0;
    const double sn = r + r * r2 * sp;
    double cp = 1.0 / 87178291200.0;
    cp = cp * r2 - 1.0 / 479001600.0; cp = cp * r2 + 1.0 / 3628800.0; cp = cp * r2 - 1.0 / 40320.0; cp = cp * r2 + 1.0 / 720.0; cp = cp * r2 - 1.0 / 24.0; cp = cp * r2 + 0.5;
    const double cs = 1.0 - r2 * cp;
    const int qi = ((int)q) & 3;
    const double ss = (qi == 0) ? sn : (qi == 1) ? cs : (qi == 2) ? -sn : -cs;
    const double cc = (qi == 0) ? cs : (qi == 1) ? -sn : (qi == 2) ? -cs : sn;
    s = (float)ss; c = (float)cc;
}

struct SrcWin { const float* w; __device__ float operator()(int k, int n) const {
        if (n >= NIN) return 0.f; int ns = n;
        if (n >= 2464) { const int j = n - 2464; ns = 2464 + (j >> 1) + 32 * (j & 1); }
        return w[(size_t)k * NIN + ns]; } };
struct SrcWuq { const float* w; const float* g; __device__ float operator()(int k, int n) const {
        const int h = n / DQK, c = n % DQK; int cs = c; if (c >= 128) { const int j = c - 128; cs = 128 + (j >> 1) + 32 * (j & 1); }
        return w[(size_t)k * 768 + h * DQK + cs] * g[k]; } };
struct SrcWukv { const float* w; const float* g; __device__ float operator()(int k, int n) const { return w[(size_t)k * 1024 + n] * g[k]; } };
struct SrcLwa { const float* w2; const float* a2; __device__ float operator()(int k, int n) const {
        if (n < 512) return k < 64 ? w2[(size_t)k * 512 + n] : 0.f;
        return (k >= 64 && k < 128) ? a2[(size_t)(k - 64) * 512 + (n - 512)] : 0.f; } };
struct SrcLg { const float* g2; __device__ float operator()(int k, int n) const { return k < 160 ? g2[(size_t)k * 512 + n] : 0.f; } };
struct SrcWout { const float* w; __device__ float operator()(int k, int n) const { return w[(size_t)k * DM + n]; } };
struct SrcWgu { const float* wg; const float* wu; const float* g; __device__ float operator()(int k, int n) const {
        const int j = n >> 8, c = n & 255; const float v = c < 128 ? wg[(size_t)k * DFF + 128 * j + c] : wu[(size_t)k * DFF + 128 * j + (c - 128)];
        return v * g[k]; } };
struct SrcWdn { const float* w; __device__ float operator()(int k, int n) const { return w[(size_t)k * DM + n]; } };

template <class F>
__device__ __forceinline__ void wconv_item(const F& f, bf16_t* WT, int K, int nblk, int item, float* scr, int lane) {
    const int kb = item / nblk, nb = item % nblk, k0 = 64 * kb, n0 = 32 * nb;
#pragma unroll 8
    for (int i = 0; i < 32; ++i) { const int kk = 2 * i + (lane >> 5); scr[kk * 33 + (lane & 31)] = f(k0 + kk, n0 + (lane & 31)); }
    asm volatile("s_waitcnt lgkmcnt(0)" ::: "memory");
    const int c = lane & 7;
#pragma unroll
    for (int j = 0; j < 4; ++j) { const int n = (lane >> 3) + 8 * j; const float* s = scr + (8 * c) * 33 + n;
        u32x4 o; o.x = pk2(s[0 * 33], s[1 * 33]); o.y = pk2(s[2 * 33], s[3 * 33]); o.z = pk2(s[4 * 33], s[5 * 33]); o.w = pk2(s[6 * 33], s[7 * 33]);
        *(u32x4*)(WT + (size_t)(n0 + n) * K + k0 + 8 * c) = o; }
    asm volatile("s_waitcnt lgkmcnt(0)" ::: "memory");
}

__device__ __forceinline__ void p0_phase(const Params& p, float* scr_all, int gw, int ngw, int lane, int wave_in_block) {
    float* scr = scr_all + wave_in_block * (64 * 33);
    unsigned char* ws = p.ws;
    constexpr int I0 = (DM / 64) * (NINP / 32), I1 = (QL / 64) * (768 / 32), I2 = (KVL / 64) * (1024 / 32), I3 = (256 / 64) * (1024 / 32), I4 = (256 / 64) * (512 / 32),
                  I5 = (DM / 64) * (DM / 32), I6 = (DM / 64) * (2 * DFF / 32), I7 = (DFF / 64) * (DM / 32);
    constexpr int NIT = I0 + I1 + I2 + I3 + I4 + I5 + I6 + I7;
    for (int it = gw; it < NIT; it += ngw) {
        int r = it;
        if (r < I0) { wconv_item(SrcWin{p.in[3]}, (bf16_t*)(ws + O_WIN), DM, NINP / 32, r, scr, lane); continue; } r -= I0;
        if (r < I1) { wconv_item(SrcWuq{p.in[16], p.in[15]}, (bf16_t*)(ws + O_WUQ), QL, 768 / 32, r, scr, lane); continue; } r -= I1;
        if (r < I2) { wconv_item(SrcWukv{p.in[18], p.in[17]}, (bf16_t*)(ws + O_WUKV), KVL, 1024 / 32, r, scr, lane); continue; } r -= I2;
        if (r < I3) { wconv_item(SrcLwa{p.in[6], p.in[8]}, (bf16_t*)(ws + O_LWA), 256, 1024 / 32, r, scr, lane); continue; } r -= I3;
        if (r < I4) { wconv_item(SrcLg{p.in[9]}, (bf16_t*)(ws + O_LG), 256, 512 / 32, r, scr, lane); continue; } r -= I4;
        if (r < I5) { wconv_item(SrcWout{p.in[20]}, (bf16_t*)(ws + O_WOUT), DM, DM / 32, r, scr, lane); continue; } r -= I5;
        if (r < I6) { wconv_item(SrcWgu{p.in[22], p.in[23], p.in[21]}, (bf16_t*)(ws + O_WGU), DM, 2 * DFF / 32, r, scr, lane); continue; } r -= I6;
        wconv_item(SrcWdn{p.in[24]}, (bf16_t*)(ws + O_WDN), DFF, DM / 32, r, scr, lane);
    }
    const float* x = p.in[0]; const float* meta = p.in[1]; const float* g1 = p.in[2];
    bf16_t* U1 = (bf16_t*)(ws + O_U1);
    for (int row = gw; row < TP; row += ngw) {
        const int b = row / LP, pr = row % LP - LPAD;
        u32x2* o = (u32x2*)(U1 + (size_t)row * DM) + lane;
        if (pr < 0) {
#pragma unroll
            for (int j = 0; j < 4; ++j) o[64 * j] = (u32x2){0u, 0u};
            continue;
        }
        const float* src = pr < NMETA ? meta + (size_t)pr * DM : x + ((size_t)b * SEQ + (pr - NMETA)) * DM;
        const f32x4* xr = (const f32x4*)src + lane;
        f32x4 v[4]; float s = 0.f;
#pragma unroll
        for (int j = 0; j < 4; ++j) { v[j] = xr[64 * j]; s += (v[j].x * v[j].x + v[j].y * v[j].y) + (v[j].z * v[j].z + v[j].w * v[j].w); }
        const float rstd = 1.0f / sqrtf(wave_sum(s) * (1.f / DM) + RMS_EPS);
#pragma unroll
        for (int j = 0; j < 4; ++j) { const f32x4 g = ((const f32x4*)g1)[lane + 64 * j];
            o[64 * j] = (u32x2){pk2(v[j].x * rstd * g.x, v[j].y * rstd * g.y), pk2(v[j].z * rstd * g.z, v[j].w * rstd * g.w)}; }
    }
    float* rope = (float*)(ws + O_ROPE);
    for (int i = gw * 64 + lane; i < L * 32; i += ngw * 64) {
        const int pos = i >> 5, f = i & 31; float s, c; sincos_d((double)pos * c_inv_freq[f], s, c);
        rope[2 * i] = c; rope[2 * i + 1] = s;
    }
    float* ssq = (float*)(ws + O_SSQ2);
    for (int i = gw * 64 + lane; i < (int)((O_CTL - O_SSQ2) / 4); i += ngw * 64) ssq[i] = 0.f;
}

__device__ __forceinline__ void p2_row(const Params& p, int row, int lane) {
    unsigned char* ws = p.ws;
    const bf16_t* P = (const bf16_t*)(ws + O_P);
    const bf16_t* cur = P + (size_t)row * NIN; const bf16_t* prv = cur - NIN;
    const bool has_prev = row > 0;
    const float* mu = p.in[4]; const float* k_k = p.in[10];
    f16_t* R = (f16_t*)(ws + O_R); f16_t* VV = (f16_t*)(ws + O_VV); f16_t* KK = (f16_t*)(ws + O_KK); f16_t* KM = (f16_t*)(ws + O_KMOD);
    bf16_t* LIN = (bf16_t*)(ws + O_LIN); bf16_t* CQKV = (bf16_t*)(ws + O_CQKV); bf16_t* Kb = (bf16_t*)(ws + O_K);
    float ssq_q = 0.f, ssq_kv = 0.f;
    for (int ch = lane; ch < 320; ch += 64) {
        const bool act = ch < 316; const int c0 = 8 * ch;
        float v[8];
        {
            u32x4 a = (u32x4){0u, 0u, 0u, 0u};
            if (act) a = *(const u32x4*)(cur + c0);
            v[0] = bf2f(a.x & 0xffffu); v[1] = bf2f(a.x >> 16); v[2] = bf2f(a.y & 0xffffu); v[3] = bf2f(a.y >> 16);
            v[4] = bf2f(a.z & 0xffffu); v[5] = bf2f(a.z >> 16); v[6] = bf2f(a.w & 0xffffu); v[7] = bf2f(a.w >> 16);
        }
        if (c0 < RCOLS) {
            u32x4 b = (u32x4){0u, 0u, 0u, 0u};
            if (act && has_prev) b = *(const u32x4*)(prv + c0);
            float q[8];
            q[0] = bf2f(b.x & 0xffffu); q[1] = bf2f(b.x >> 16); q[2] = bf2f(b.y & 0xffffu); q[3] = bf2f(b.y >> 16);
            q[4] = bf2f(b.z & 0xffffu); q[5] = bf2f(b.z >> 16); q[6] = bf2f(b.w & 0xffffu); q[7] = bf2f(b.w >> 16);
#pragma unroll
            for (int j = 0; j < 8; ++j) v[j] = v[j] + (q[j] - v[j]) * mu[c0 + j];
        }
        const bool isk = (c0 >= 512 && c0 < 1024);
        float ss = 0.f; float kkv[8];
        if (isk) {
#pragma unroll
            for (int j = 0; j < 8; ++j) { kkv[j] = v[j] * k_k[c0 - 512 + j]; ss += kkv[j] * kkv[j]; }
        }
        ss += __shfl_xor(ss, 1); ss += __shfl_xor(ss, 2); ss += __shfl_xor(ss, 4);
        if (!act) continue;
        if (c0 < 512) {
#pragma unroll
            for (int j = 0; j < 8; ++j) R[(size_t)row * 512 + c0 + j] = (f16_t)v[j];
        } else if (c0 < 1024) {
            const float inv = 1.f / fmaxf(sqrtf(ss), 1e-12f);
#pragma unroll
            for (int j = 0; j < 8; ++j) { KM[(size_t)row * 512 + c0 - 512 + j] = (f16_t)v[j]; KK[(size_t)row * 512 + c0 - 512 + j] = (f16_t)(kkv[j] * inv); }
        } else if (c0 < 1536) {
#pragma unroll
            for (int j = 0; j < 8; ++j) VV[(size_t)row * 512 + c0 - 1024 + j] = (f16_t)v[j];
        } else if (c0 < 1600) {
#pragma unroll
            for (int j = 0; j < 8; ++j) LIN[(size_t)row * 384 + c0 - 1536 + j] = (bf16_t)f2bf(tanhf(v[j]));
        } else if (c0 < 1664) {
#pragma unroll
            for (int j = 0; j < 8; ++j) LIN[(size_t)row * 384 + c0 - 1536 + j] = (bf16_t)f2bf(v[j]);
        } else if (c0 < 1824) {
#pragma unroll
            for (int j = 0; j < 8; ++j) LIN[(size_t)row * 384 + c0 - 1536 + j] = (bf16_t)f2bf(sigmoidf_(v[j]));
        } else if (c0 < 2208) {
#pragma unroll
            for (int j = 0; j < 8; ++j) { CQKV[(size_t)row * 640 + c0 - 1824 + j] = (bf16_t)f2bf(v[j]); ssq_q += v[j] * v[j]; }
        } else if (c0 < 2464) {
#pragma unroll
            for (int j = 0; j < 8; ++j) { CQKV[(size_t)row * 640 + c0 - 1824 + j] = (bf16_t)f2bf(v[j]); ssq_kv += v[j] * v[j]; }
        } else {
            const float* t = (const float*)(ws + O_ROPE) + ((size_t)row_pos(row) * 32 + ((c0 - 2464) >> 1)) * 2;
            float o[8];
#pragma unroll
            for (int j = 0; j < 4; ++j) { const float cs = t[2 * j], sn = t[2 * j + 1]; o[2 * j] = v[2 * j] * cs - v[2 * j + 1] * sn; o[2 * j + 1] = v[2 * j + 1] * cs + v[2 * j] * sn; }
            u32x4 w; w.x = pk2(o[0], o[1]); w.y = pk2(o[2], o[3]); w.z = pk2(o[4], o[5]); w.w = pk2(o[6], o[7]);
#pragma unroll
            for (int h = 0; h < NH; ++h) *(u32x4*)(Kb + (size_t)row * 768 + h * DQK + 128 + (c0 - 2464)) = w;
        }
    }
    if (lane < 12) *(u32x4*)(LIN + (size_t)row * 384 + 288 + 8 * lane) = (u32x4){0u, 0u, 0u, 0u};
    ssq_q = wave_sum(ssq_q); ssq_kv = wave_sum(ssq_kv);
    if (lane == 0) { ((float*)(ws + O_RSTDQ))[row] = 1.0f / sqrtf(ssq_q * (1.f / QL) + RMS_EPS); ((float*)(ws + O_RSTDKV))[row] = 1.0f / sqrtf(ssq_kv * (1.f / KVL) + RMS_EPS); }
}
namespace pg8 {
#define PG8_LAS __attribute__((address_space(3)))
typedef short bf16x8 __attribute__((ext_vector_type(8)));
constexpr int BM = 256, BK = 64, HALF = 128, HTB = HALF * BK * 2, STAGE_BYTES = 8 * HTB, NXCD = 8, WGM = 8;
__host__ __device__ __forceinline__ int lds_byte(int r, int c) { const int st = (r >> 4) * 2 + (c >> 5), rr = r & 15, cc = c & 31, ob = rr * 64 + cc * 2; return st * 1024 + (ob ^ (((ob >> 9) & 1) << 5)); }
__host__ __device__ __forceinline__ void stage_rc(int b, int& R, int& C) { const int st = b / 1024, sb = b % 1024, swz = sb ^ (((sb >> 9) & 1) << 5); R = (st >> 1) * 16 + swz / 64; C = (st & 1) * 32 + (swz % 64) / 2; }
__host__ __device__ __forceinline__ int perm32(int rho) { const int n = rho >> 4, i = rho & 15; return 8 * (i >> 2) + 4 * n + (i & 3); }
struct Unit { int pm, pn; };
struct Gemm { const bf16_t* A; const bf16_t* Bt; int lda, ldb, K; };
struct StaticOrder {
    int nM, nN, nwg, G, c;
    __host__ __device__ void init(int M, int N, int G_, int c_) { nM = M / BM; nN = N / BM; nwg = nM * nN; G = G_; c = c_; }
    __host__ __device__ bool next(int i, Unit& u) const {
        const long L = (long)i * G + c; if (L >= nwg) return false;
        int wgid = (int)L; { const int q = nwg / NXCD, r = nwg % NXCD, xcd = wgid % NXCD, off = wgid / NXCD; wgid = (xcd < r ? xcd * (q + 1) : r * (q + 1) + (xcd - r) * q) + off; }
        const int nig = WGM * nN, gid = wgid / nig, fm = gid * WGM, gsz = (nM - fm) < WGM ? (nM - fm) : WGM;
        u.pm = fm + ((wgid % nig) % gsz); u.pn = (wgid % nig) / gsz; return true;
    }
};
template <class F> struct Epi8 {
    F f;
    __device__ __forceinline__ void operator()(const f32x4 (&acc)[2][2][4][2], const Unit& u, int wr, int wc, int fr, int fq) const {
        const int col = u.pn * BM + wc * 32 + 8 * fq;
#pragma unroll
        for (int ai = 0; ai < 2; ++ai)
#pragma unroll
            for (int m = 0; m < 4; ++m) f(u.pm * BM + ai * HALF + wr * 64 + m * 16 + fr, col, acc[ai][0][m][0], acc[ai][0][m][1], acc[ai][1][m][0], acc[ai][1][m][1]);
    }
};

template <class Epi, bool ALIGN_EPI>
__device__ __forceinline__ void gemm_phase(PG8_LAS unsigned char* lds, const Gemm g, const StaticOrder& S, const Epi& E) {
    const int tid = threadIdx.x, wid = __builtin_amdgcn_readfirstlane(tid >> 6), lane = tid & 63, wr = wid >> 2, wc = wid & 3, fr = lane & 15, fq = lane >> 4;
    const int K = g.K, nt = K / BK;
    unsigned voffA[2], voffB[2];
#pragma unroll
    for (int i = 0; i < 2; ++i) { int R, C; stage_rc(tid * 16 + i * 8192, R, C); const int Rb = (R & ~31) + perm32(R & 31);
        voffA[i] = (unsigned)(R * g.lda + C) * 2u; voffB[i] = (unsigned)(Rb * g.ldb + C) * 2u; }
    const size_t kstep = (size_t)(BK * 2);
    const size_t hstepA = (size_t)HALF * g.lda * 2, hstepB = (size_t)HALF * g.ldb * 2;
    const size_t tstepA = 2 * hstepA, tstepB = 2 * hstepB;
    const unsigned ldsw = (unsigned)wid * 1024u;
    const int aoff = lds_byte(wr * 64 + fr, fq * 8), boff = lds_byte(wc * 32 + fr, fq * 8);
#define PG8_SA(b, h) (((b) * 2 + (h)) * HTB)
#define PG8_SB(b, h) ((4 + (b) * 2 + (h)) * HTB)
#define PG8_STAGE(bufoff, gbase, voff) do { _Pragma("unroll") for (int _i = 0; _i < 2; ++_i) \
        __builtin_amdgcn_global_load_lds((const unsigned*)((const char*)(gbase) + (voff)[_i]), (PG8_LAS unsigned*)(lds + (bufoff) + ldsw + _i * 8192), 16, 0, 0); } while (0)
#define PG8_LDA(dst, b, h) do { _Pragma("unroll") for (int m = 0; m < 4; ++m) _Pragma("unroll") for (int k = 0; k < 2; ++k) dst[m][k] = *(const PG8_LAS bf16x8*)(lds + PG8_SA(b, h) + aoff + m * 2048 + k * 1024); } while (0)
#define PG8_LDB(dst, b, h) do { _Pragma("unroll") for (int n = 0; n < 2; ++n) _Pragma("unroll") for (int k = 0; k < 2; ++k) dst[n][k] = *(const PG8_LAS bf16x8*)(lds + PG8_SB(b, h) + boff + n * 2048 + k * 1024); } while (0)
#define PG8_MMA(ai, bj, At, Bt) do { __builtin_amdgcn_s_setprio(1); _Pragma("unroll") for (int m = 0; m < 4; ++m) _Pragma("unroll") for (int n = 0; n < 2; ++n) _Pragma("unroll") for (int k = 0; k < 2; ++k) \
        acc[ai][bj][m][n] = __builtin_amdgcn_mfma_f32_16x16x32_bf16(Bt[n][k], At[m][k], acc[ai][bj][m][n], 0, 0, 0); __builtin_amdgcn_s_setprio(0); } while (0)
#define PG8_WAIT_V(n) asm volatile("s_waitcnt vmcnt(" #n ")" ::: "memory")
#define PG8_WAIT_L(n) asm volatile("s_waitcnt lgkmcnt(" #n ")" ::: "memory")
#define PG8_BAR __builtin_amdgcn_s_barrier()
#define PG8_SCHED __builtin_amdgcn_sched_barrier(0)
    Unit cur, nxt; int ui = 0;
    if (!S.next(0, cur)) return;
    f32x4 acc[2][2][4][2];
#pragma unroll
    for (int a = 0; a < 2; ++a)
#pragma unroll
        for (int b = 0; b < 2; ++b)
#pragma unroll
            for (int m = 0; m < 4; ++m)
#pragma unroll
                for (int n = 0; n < 2; ++n) acc[a][b][m][n] = (f32x4){0.f, 0.f, 0.f, 0.f};
    bf16x8 At[4][2], B0[2][2], B1[2][2];
    const char* cA = (const char*)g.A + (size_t)cur.pm * tstepA; const char* cB = (const char*)g.Bt + (size_t)cur.pn * tstepB;
    PG8_STAGE(PG8_SB(0, 0), cB, voffB); PG8_STAGE(PG8_SB(0, 1), cB + hstepB, voffB); PG8_STAGE(PG8_SA(0, 0), cA, voffA); PG8_STAGE(PG8_SA(0, 1), cA + hstepA, voffA);
    if (wr == 1) PG8_BAR;
    PG8_WAIT_V(2); PG8_BAR;
    PG8_STAGE(PG8_SB(1, 0), cB + kstep, voffB); PG8_STAGE(PG8_SA(1, 0), cA + kstep, voffA); PG8_STAGE(PG8_SB(1, 1), cB + hstepB + kstep, voffB);
    PG8_WAIT_V(6); PG8_BAR;
#pragma nounroll
    for (;;) {
        const bool has_next = S.next(ui + 1, nxt);
        const char* nA = has_next ? (const char*)g.A + (size_t)nxt.pm * tstepA : cA; const char* nB = has_next ? (const char*)g.Bt + (size_t)nxt.pn * tstepB : cB;
#pragma nounroll
        for (int t = 0; t < nt; t += 2) {
            const bool last = (t == nt - 2);
            const char* a1 = cA + (size_t)(t + 1) * kstep;
            const char* a2 = last ? nA : cA + (size_t)(t + 2) * kstep; const char* b2 = last ? nB : cB + (size_t)(t + 2) * kstep;
            const char* a3 = a2 + kstep; const char* b3 = b2 + kstep;
            PG8_LDB(B0, 0, 0); PG8_LDB(B1, 0, 1); PG8_SCHED; PG8_LDA(At, 0, 0); PG8_STAGE(PG8_SA(1, 1), a1 + hstepA, voffA);
            PG8_WAIT_V(8); PG8_WAIT_L(0); PG8_BAR; PG8_MMA(0, 0, At, B0); PG8_MMA(0, 1, At, B1); PG8_BAR; PG8_SCHED;
            PG8_LDA(At, 0, 1); PG8_STAGE(PG8_SB(0, 0), b2, voffB); PG8_STAGE(PG8_SB(0, 1), b2 + hstepB, voffB); PG8_STAGE(PG8_SA(0, 0), a2, voffA);
            PG8_WAIT_V(8); PG8_WAIT_L(0); PG8_BAR; PG8_MMA(1, 0, At, B0); PG8_MMA(1, 1, At, B1); PG8_BAR; PG8_SCHED;
            PG8_LDB(B0, 1, 0); PG8_LDB(B1, 1, 1); PG8_SCHED; PG8_LDA(At, 1, 0); PG8_STAGE(PG8_SA(0, 1), a2 + hstepA, voffA);
            PG8_WAIT_V(8); PG8_WAIT_L(0); PG8_BAR; PG8_MMA(0, 0, At, B0); PG8_MMA(0, 1, At, B1); PG8_BAR; PG8_SCHED;
            PG8_LDA(At, 1, 1); PG8_STAGE(PG8_SB(1, 0), b3, voffB); PG8_STAGE(PG8_SB(1, 1), b3 + hstepB, voffB); PG8_STAGE(PG8_SA(1, 0), a3, voffA);
            PG8_WAIT_V(8); PG8_WAIT_L(0); PG8_BAR; PG8_MMA(1, 0, At, B0); PG8_MMA(1, 1, At, B1); PG8_BAR; PG8_SCHED;
        }
        if constexpr (ALIGN_EPI) { if (wr == 0) PG8_BAR; }
        E(acc, cur, wr, wc, fr, fq);
        if (!has_next) break;
#pragma unroll
        for (int a = 0; a < 2; ++a)
#pragma unroll
            for (int b = 0; b < 2; ++b)
#pragma unroll
                for (int m = 0; m < 4; ++m)
#pragma unroll
                    for (int n = 0; n < 2; ++n) acc[a][b][m][n] = (f32x4){0.f, 0.f, 0.f, 0.f};
        cur = nxt; cA = nA; cB = nB; ++ui;
        if constexpr (ALIGN_EPI) { if (wr == 1) PG8_BAR; }
    }
    PG8_WAIT_V(0);
    if constexpr (!ALIGN_EPI) { if (wr == 0) PG8_BAR; }
    PG8_BAR;
#undef PG8_SA
#undef PG8_SB
#undef PG8_STAGE
#undef PG8_LDA
#undef PG8_LDB
#undef PG8_MMA
#undef PG8_WAIT_V
#undef PG8_WAIT_L
#undef PG8_BAR
#undef PG8_SCHED
}
}

__device__ __forceinline__ u32x4 pack8(const f32x4& a0, const f32x4& a1) { u32x4 w; w.x = pk2(a0[0], a0[1]); w.y = pk2(a0[2], a0[3]); w.z = pk2(a1[0], a1[1]); w.w = pk2(a1[2], a1[3]); return w; }
typedef _Float16 f16x8 __attribute__((ext_vector_type(8)));
struct FP {
    bf16_t* P;
    __device__ __forceinline__ void operator()(int row, int col, const f32x4& a0, const f32x4& a1, const f32x4& b0, const f32x4& b1) const {
        if (col < NIN) *(u32x4*)(P + (size_t)row * NIN + col) = pack8(a0, a1);
        if (col + 128 < NIN) *(u32x4*)(P + (size_t)row * NIN + col + 128) = pack8(b0, b1);
    }
};
struct FQ {
    bf16_t* Q; const float* rstd; const float* rope;
    __device__ __forceinline__ void one(int row, int col, float rs, f32x4 a0, f32x4 a1) const {
        a0 = a0 * rs; a1 = a1 * rs;
        const int c = col % DQK;
        if (c >= 128) { const f32x4* t = (const f32x4*)(rope + ((size_t)row_pos(row) * 32 + ((c - 128) >> 1)) * 2); const f32x4 t0 = t[0], t1 = t[1];
            f32x4 o0, o1;
            o0[0] = a0[0] * t0[0] - a0[1] * t0[1]; o0[1] = a0[1] * t0[0] + a0[0] * t0[1]; o0[2] = a0[2] * t0[2] - a0[3] * t0[3]; o0[3] = a0[3] * t0[2] + a0[2] * t0[3];
            o1[0] = a1[0] * t1[0] - a1[1] * t1[1]; o1[1] = a1[1] * t1[0] + a1[0] * t1[1]; o1[2] = a1[2] * t1[2] - a1[3] * t1[3]; o1[3] = a1[3] * t1[2] + a1[2] * t1[3];
            a0 = o0; a1 = o1; }
        *(u32x4*)(Q + (size_t)row * 768 + col) = pack8(a0, a1);
    }
    __device__ __forceinline__ void operator()(int row, int col, const f32x4& a0, const f32x4& a1, const f32x4& b0, const f32x4& b1) const {
        const float rs = rstd[row] * QSCALE; one(row, col, rs, a0, a1); one(row, col + 128, rs, b0, b1); }
};
struct FKV {
    bf16_t* K; bf16_t* V; const float* rstd;
    __device__ __forceinline__ void one(int row, int col, float rs, const f32x4& a0, const f32x4& a1) const {
        const int h = col >> 8, c = col & 255; const u32x4 w = pack8(a0 * rs, a1 * rs);
        if (c < 128) *(u32x4*)(K + (size_t)row * 768 + h * DQK + c) = w; else *(u32x4*)(V + (size_t)row * 512 + h * DV + (c - 128)) = w; }
    __device__ __forceinline__ void operator()(int row, int col, const f32x4& a0, const f32x4& a1, const f32x4& b0, const f32x4& b1) const {
        const float rs = rstd[row]; one(row, col, rs, a0, a1); one(row, col + 128, rs, b0, b1); }
};
struct FLwa {
    f16_t* EW; f16_t* KMOD; const f16_t* KK; f16_t* Bv; const float* w0; const float* a0p; const float* k_a;
    __device__ __forceinline__ void one(int row, int col, const f32x4& a0, const f32x4& a1) const {
        float v[8] = {a0[0], a0[1], a0[2], a0[3], a1[0], a1[1], a1[2], a1[3]};
        if (col < 512) {
            f16x8 o;
#pragma unroll
            for (int j = 0; j < 8; ++j) { const float xx = w0[col + j] + v[j]; const float sp = (-xx > 20.f) ? -xx : __logf(1.f + __expf(-xx)); o[j] = (f16_t)__expf(-sp - 0.5f); }
            *(f16x8*)(EW + (size_t)row * 512 + col) = o;
        } else {
            const int c = col - 512; const size_t idx = (size_t)row * 512 + c;
            const f16x8 kv = *(const f16x8*)(KMOD + idx), kkv = *(const f16x8*)(KK + idx); f16x8 ko, bo;
#pragma unroll
            for (int j = 0; j < 8; ++j) { const float a = sigmoidf_(a0p[c + j] + v[j]); ko[j] = (f16_t)((float)kv[j] * (1.f + (a - 1.f) * k_a[c + j])); bo[j] = (f16_t)((float)kkv[j] * a); }
            *(f16x8*)(KMOD + idx) = ko; *(f16x8*)(Bv + idx) = bo;
        }
    }
    __device__ __forceinline__ void operator()(int row, int col, const f32x4& a0, const f32x4& a1, const f32x4& b0, const f32x4& b1) const { one(row, col, a0, a1); one(row, col + 128, b0, b1); }
};
struct FG { bf16_t* G;
    __device__ __forceinline__ void operator()(int row, int col, const f32x4& a0, const f32x4& a1, const f32x4& b0, const f32x4& b1) const {
        *(u32x4*)(G + (size_t)row * 512 + col) = pack8(a0, a1); *(u32x4*)(G + (size_t)row * 512 + col + 128) = pack8(b0, b1); } };
struct FOut {
    const float* x; float* H2; bf16_t* H2B; float* ssq;
    __device__ __forceinline__ float one(size_t idx, const f32x4& a0, const f32x4& a1) const {
        const f32x4 h0 = *(const f32x4*)(x + idx) + a0, h1 = *(const f32x4*)(x + idx + 4) + a1;
        *(f32x4*)(H2 + idx) = h0; *(f32x4*)(H2 + idx + 4) = h1; *(u32x4*)(H2B + idx) = pack8(h0, h1);
        return (h0[0] * h0[0] + h0[1] * h0[1]) + (h0[2] * h0[2] + h0[3] * h0[3]) + (h1[0] * h1[0] + h1[1] * h1[1]) + (h1[2] * h1[2] + h1[3] * h1[3]); }
    __device__ __forceinline__ void operator()(int row, int col, const f32x4& a0, const f32x4& a1, const f32x4& b0, const f32x4& b1) const {
        float s = one((size_t)row * DM + col, a0, a1) + one((size_t)row * DM + col + 128, b0, b1);
        s += __shfl_xor(s, 16); s += __shfl_xor(s, 32);
        if ((threadIdx.x & 63) < 16) atomicAdd(ssq + row, s); }
};
struct FAct {
    bf16_t* ACT; const float* ssq;
    __device__ __forceinline__ void operator()(int row, int col, const f32x4& a0, const f32x4& a1, const f32x4& b0, const f32x4& b1) const {
        const float rs = 1.0f / sqrtf(ssq[row] * (1.f / DM) + RMS_EPS);
        f32x4 o0, o1;
#pragma unroll
        for (int j = 0; j < 4; ++j) { const float g0 = a0[j] * rs, g1 = a1[j] * rs; o0[j] = g0 * sigmoidf_(g0) * (b0[j] * rs); o1[j] = g1 * sigmoidf_(g1) * (b1[j] * rs); }
        *(u32x4*)(ACT + (size_t)row * DFF + (col >> 8) * 128 + (col & 127)) = pack8(o0, o1); }
};
struct FDown {
    float* H; float* ssq;
    __device__ __forceinline__ float one(size_t idx, const f32x4& a0, const f32x4& a1) const {
        const f32x4 h0 = *(const f32x4*)(H + idx) + a0, h1 = *(const f32x4*)(H + idx + 4) + a1; *(f32x4*)(H + idx) = h0; *(f32x4*)(H + idx + 4) = h1;
        return (h0[0] * h0[0] + h0[1] * h0[1]) + (h0[2] * h0[2] + h0[3] * h0[3]) + (h1[0] * h1[0] + h1[1] * h1[1]) + (h1[2] * h1[2] + h1[3] * h1[3]); }
    __device__ __forceinline__ void operator()(int row, int col, const f32x4& a0, const f32x4& a1, const f32x4& b0, const f32x4& b1) const {
        float s = one((size_t)row * DM + col, a0, a1) + one((size_t)row * DM + col + 128, b0, b1);
        s += __shfl_xor(s, 16); s += __shfl_xor(s, 32);
        if ((threadIdx.x & 63) < 16) atomicAdd(ssq + row, s); }
};

__device__ __forceinline__ void scan_simple_unit(const Params& p, int unit, int t256) {
    unsigned char* ws = p.ws;
    const f16_t* R = (const f16_t*)(ws + O_R); const f16_t* VV = (const f16_t*)(ws + O_VV); const f16_t* KK = (const f16_t*)(ws + O_KK); const f16_t* KM = (const f16_t*)(ws + O_KMOD);
    const f16_t* EW = (const f16_t*)(ws + O_EW); const f16_t* Bv = (const f16_t*)(ws + O_B);
    float* YRAW = p.out;
    const int bh = unit >> 2, quarter = unit & 3, b = bh >> 3, h = bh & 7;
    const int il = t256 >> 4, c = t256 & 15, i = 16 * quarter + il;
    float S[4] = {0.f, 0.f, 0.f, 0.f};
    const size_t base = ((size_t)b * LP + LPAD) * 512 + h * 64;
    for (int t = 0; t < L; ++t) {
        const size_t o = base + (size_t)t * 512 + 4 * c;
        float w[4], kk[4], bb[4], k[4], r[4];
#pragma unroll
        for (int j = 0; j < 4; ++j) { w[j] = __expf(-(float)EW[o + j]); kk[j] = (float)KK[o + j]; bb[j] = (float)Bv[o + j]; k[j] = (float)KM[o + j]; r[j] = (float)R[o + j]; }
        const float v = (float)VV[base + (size_t)t * 512 + i];
        float sa = 0.f;
#pragma unroll
        for (int j = 0; j < 4; ++j) sa += S[j] * kk[j];
        sa += __shfl_xor(sa, 1); sa += __shfl_xor(sa, 2); sa += __shfl_xor(sa, 4); sa += __shfl_xor(sa, 8);
        sa = -sa;
        float y = 0.f;
#pragma unroll
        for (int j = 0; j < 4; ++j) { S[j] = S[j] * w[j] + sa * bb[j] + v * k[j]; y += S[j] * r[j]; }
        y += __shfl_xor(y, 1); y += __shfl_xor(y, 2); y += __shfl_xor(y, 4); y += __shfl_xor(y, 8);
        if (c == 0) YRAW[base + (size_t)t * 512 + i] = y;
    }
}

__device__ __forceinline__ void attn_simple_unit(const Params& p, float* sm, int unit, int tid) {
    float* Qs = sm;
    float* Ks = Qs + 64 * 192;
    float* Vs = Ks + 64 * 193;
    float* Ps = Vs + 64 * 128;
    unsigned char* ws = p.ws;
    const bf16_t* Q = (const bf16_t*)(ws + O_Q); const bf16_t* Kb = (const bf16_t*)(ws + O_K); const bf16_t* V = (const bf16_t*)(ws + O_V);
    bf16_t* Y = (bf16_t*)(ws + O_Y); const float* og = p.in[19];
    const int qt = unit & 63, h = (unit >> 6) & 3, b = unit >> 8;
    const size_t rb = (size_t)b * LP;
    const int qrow0 = 64 + 64 * qt;
    __syncthreads();
    for (int i = tid; i < 64 * 192; i += 512) { const int r = i / 192, d = i % 192; Qs[i] = bf2f(Q[(rb + qrow0 + r) * 768 + h * DQK + d]); }
    const int qi = (tid & 255) >> 2, sub = tid & 3; const bool act = tid < 256;
    float m = -1e30f, l = 0.f; float o[32];
#pragma unroll
    for (int j = 0; j < 32; ++j) o[j] = 0.f;
    const int nkt = qt + 2;
    for (int kt = 0; kt < nkt; ++kt) {
        __syncthreads();
        for (int i = tid; i < 64 * 192; i += 512) { const int r = i / 192, d = i % 192; Ks[r * 193 + d] = bf2f(Kb[(rb + 64 * kt + r) * 768 + h * DQK + d]); }
        for (int i = tid; i < 64 * 128; i += 512) { const int r = i >> 7, d = i & 127; Vs[i] = bf2f(V[(rb + 64 * kt + r) * 512 + h * DV + d]); }
        __syncthreads();
        float scale = 1.f;
        if (act) {
            float sc[16]; float mx = -1e30f;
#pragma unroll
            for (int kk = 0; kk < 16; ++kk) {
                const int key = sub + 4 * kk; float s = 0.f;
                for (int d = 0; d < 192; ++d) s += Qs[qi * 192 + d] * Ks[key * 193 + d];
                const int krow = 64 * kt + key;
                if (krow < LPAD || krow > qrow0 + qi) s = -1e30f;
                sc[kk] = s; mx = fmaxf(mx, s);
            }
            mx = fmaxf(mx, __shfl_xor(mx, 1)); mx = fmaxf(mx, __shfl_xor(mx, 2));
            const float mn = fmaxf(m, mx); scale = exp2f(m - mn);
            float ps = 0.f;
#pragma unroll
            for (int kk = 0; kk < 16; ++kk) { const float pv = (sc[kk] <= -1e29f) ? 0.f : exp2f(sc[kk] - mn); Ps[qi * 65 + sub + 4 * kk] = pv; ps += pv; }
            ps += __shfl_xor(ps, 1); ps += __shfl_xor(ps, 2);
            l = l * scale + ps; m = mn;
        }
        __syncthreads();
        if (act) {
#pragma unroll
            for (int j = 0; j < 32; ++j) o[j] *= scale;
            for (int key = 0; key < 64; ++key) { const float pv = Ps[qi * 65 + key];
#pragma unroll
                for (int j = 0; j < 32; ++j) o[j] += pv * Vs[key * 128 + sub * 32 + j]; }
        }
    }
    if (act) {
        const float il = 1.f / l; float ss = 0.f;
#pragma unroll
        for (int j = 0; j < 32; ++j) { o[j] *= il; ss += o[j] * o[j]; }
        ss += __shfl_xor(ss, 1); ss += __shfl_xor(ss, 2);
        const float rs = 1.0f / sqrtf(ss * (1.f / DV) + RMS_EPS);
        const size_t yrow = (size_t)b * SEQ + 64 * qt + qi;
#pragma unroll
        for (int j = 0; j < 32; ++j) Y[yrow * DM + 512 + h * DV + sub * 32 + j] = (bf16_t)f2bf(o[j] * rs * og[h * DV + sub * 32 + j]);
    }
}

namespace scan {
#define SC_LAS __attribute__((address_space(3)))
constexpr int TS = 32, STEP_F = 5 * 64 + 16, BUF_F = TS * STEP_F, NCH = (L + TS - 1) / TS;
constexpr int SCAN_LDS = 2 * BUF_F * 4;
typedef _Float16 h8 __attribute__((ext_vector_type(8)));
typedef _Float16 h2 __attribute__((ext_vector_type(2)));
template <int CTRL> __device__ __forceinline__ float dppf(float x) { return __builtin_bit_cast(float, __builtin_amdgcn_update_dpp(0, __builtin_bit_cast(int, x), CTRL, 0xF, 0xF, true)); }
__device__ __forceinline__ float row_sum16(float x) { x += dppf<0xB1>(x); x += dppf<0x4E>(x); x += dppf<0x141>(x); x += dppf<0x140>(x); return x; }

__device__ __forceinline__ void scan_unit(const Params& p, SC_LAS float* lds, int unit) {
    unsigned char* ws = p.ws;
    const int tid = threadIdx.x, lane = tid & 63; const int wave = __builtin_amdgcn_readfirstlane(tid >> 6);
    const int bh = unit >> 2, quarter = unit & 3, b = bh >> 3, h = bh & 7;
    const size_t ebase = ((size_t)b * LP + LPAD) * 512 + h * 64;
    __syncthreads();
    if (wave >= 4) {
        const f16_t* src[5] = {(const f16_t*)(ws + O_EW), (const f16_t*)(ws + O_KK), (const f16_t*)(ws + O_B), (const f16_t*)(ws + O_KMOD), (const f16_t*)(ws + O_R)};
        const f16_t* VV = (const f16_t*)(ws + O_VV);
        const int t2 = tid - 256, tt = t2 >> 3, c8 = (t2 & 7) * 8, pr = t2 & 7;
#pragma nounroll
        for (int ch = 0; ch <= NCH; ++ch) {
            if (ch < NCH) {
                const int t = ch * TS + tt;
                if (t < L) {
                    SC_LAS float* dst = lds + (ch & 1) * BUF_F + tt * STEP_F;
                    const size_t e = ebase + (size_t)t * 512;
#pragma unroll
                    for (int a = 0; a < 5; ++a) {
                        const h8 v = *(const h8*)(src[a] + e + c8);
                        f32x4 lo, hi;
#pragma unroll
                        for (int j = 0; j < 4; ++j) { lo[j] = (float)v[j]; hi[j] = (float)v[4 + j]; }
                        if (a == 0) {
#pragma unroll
                            for (int j = 0; j < 4; ++j) { lo[j] = __expf(-lo[j]); hi[j] = __expf(-hi[j]); }
                        }
                        *(SC_LAS f32x4*)(dst + a * 64 + c8) = lo; *(SC_LAS f32x4*)(dst + a * 64 + c8 + 4) = hi;
                    }
                    const h2 vv = *(const h2*)(VV + e + 16 * quarter + 2 * pr);
                    dst[320 + 2 * pr] = (float)vv[0]; dst[320 + 2 * pr + 1] = (float)vv[1];
                }
            }
            __syncthreads();
        }
    } else {
        const int g = lane >> 4, c = lane & 15, i = 16 * quarter + 4 * wave + g;
        float* yout = p.out + ebase + i;
        typedef float f2 __attribute__((ext_vector_type(2)));
        f2 S01 = {0.f, 0.f}, S23 = {0.f, 0.f};
        __syncthreads();
#pragma nounroll
        for (int ch = 0; ch < NCH; ++ch) {
            const SC_LAS float* st = lds + (ch & 1) * BUF_F + 4 * c;
            const SC_LAS float* sv = lds + (ch & 1) * BUF_F + 320 + 4 * wave + g;
            const int n = (L - ch * TS) < TS ? (L - ch * TS) : TS;
            float* yo = yout + (size_t)(ch * TS + c) * 512;
#pragma nounroll
            for (int tb = 0; tb < n; tb += 16) {
                float ykeep = 0.f;
#pragma unroll
                for (int tt = 0; tt < 16; ++tt) {
                    const f32x4 w4 = *(const SC_LAS f32x4*)(st + tt * STEP_F), kk4 = *(const SC_LAS f32x4*)(st + tt * STEP_F + 64), b4 = *(const SC_LAS f32x4*)(st + tt * STEP_F + 128),
                                k4 = *(const SC_LAS f32x4*)(st + tt * STEP_F + 192), r4 = *(const SC_LAS f32x4*)(st + tt * STEP_F + 256);
                    const float v = sv[tt * STEP_F];
                    f2 pa = S01 * (f2){kk4[0], kk4[1]}; pa = S23 * (f2){kk4[2], kk4[3]} + pa;
                    const float sa = -row_sum16(pa.x + pa.y);
                    const f2 sa2 = {sa, sa}, v2 = {v, v};
                    f2 t01 = v2 * (f2){k4[0], k4[1]}, t23 = v2 * (f2){k4[2], k4[3]};
                    t01 = sa2 * (f2){b4[0], b4[1]} + t01; t23 = sa2 * (f2){b4[2], b4[3]} + t23;
                    S01 = S01 * (f2){w4[0], w4[1]} + t01; S23 = S23 * (f2){w4[2], w4[3]} + t23;
                    f2 py = S01 * (f2){r4[0], r4[1]}; py = S23 * (f2){r4[2], r4[3]} + py;
                    const float y = row_sum16(py.x + py.y);
                    ykeep = (c == tt) ? y : ykeep;
                }
                yo[(size_t)tb * 512] = ykeep;
                st += 16 * STEP_F; sv += 16 * STEP_F;
            }
            __syncthreads();
        }
    }
}
}

namespace att {
#define ATT_LAS __attribute__((address_space(3)))
typedef float f32x16 __attribute__((ext_vector_type(16)));
typedef short bf16x8 __attribute__((ext_vector_type(8)));
typedef short s16x4 __attribute__((ext_vector_type(4)));
typedef float f32x2_t __attribute__((ext_vector_type(2)));
typedef __bf16 bf16x2_t __attribute__((ext_vector_type(2)));
constexpr int KROW = 400, VROW = 320, KBUF = 64 * KROW, VBUF = 64 * VROW;
constexpr int L_K = 0, L_V = 2 * KBUF, L_SCR = 2 * KBUF + 2 * VBUF, ATT_LDS = L_SCR + 8 * 256;
__device__ __forceinline__ int crow(int i, int hi) { return (i & 3) + 8 * (i >> 2) + 4 * hi; }
__device__ __forceinline__ unsigned cvtpk(float lo, float hi) { f32x2_t v = {lo, hi}; bf16x2_t b = __builtin_convertvector(v, bf16x2_t); return __builtin_bit_cast(unsigned, b); }
template <int K> __device__ __forceinline__ float swz_xor(float x) { return __builtin_bit_cast(float, __builtin_amdgcn_ds_swizzle(__builtin_bit_cast(int, x), 0x1F | (K << 10))); }
__device__ __forceinline__ float x32_max(float x) { auto r = __builtin_amdgcn_permlane32_swap(__builtin_bit_cast(unsigned, x), __builtin_bit_cast(unsigned, x), false, false); return fmaxf(__builtin_bit_cast(float, r[0]), __builtin_bit_cast(float, r[1])); }
__device__ __forceinline__ float x32_sum(float x) { auto r = __builtin_amdgcn_permlane32_swap(__builtin_bit_cast(unsigned, x), __builtin_bit_cast(unsigned, x), false, false); return __builtin_bit_cast(float, r[0]) + __builtin_bit_cast(float, r[1]); }
__device__ __forceinline__ s16x4 vtr(const ATT_LAS unsigned char* p) { return __builtin_bit_cast(s16x4, __builtin_amdgcn_ds_read_tr16_b64_v4i16((ATT_LAS s16x4*)p)); }

__device__ __forceinline__ void attn_unit(const Params& p, ATT_LAS unsigned char* lds, int b, int h, int qblk) {
    const int tid = threadIdx.x, lane = tid & 63, r32 = lane & 31, hi = lane >> 5; const int w = __builtin_amdgcn_readfirstlane(tid >> 6);
    unsigned char* ws = p.ws;
    const bf16_t* Q = (const bf16_t*)(ws + O_Q); const bf16_t* Kg = (const bf16_t*)(ws + O_K); const bf16_t* Vg = (const bf16_t*)(ws + O_V);
    const size_t rowbase = (size_t)b * LP;
    const int qrow = 64 + 256 * qblk + 32 * w + r32;
    const int NT = 4 * qblk + 5, jband = 4 * qblk + 1, jdiag = jband + (w >> 1);
    bf16x8 qf[12];
    { const bf16_t* qp = Q + (rowbase + qrow) * 768 + h * DQK + 8 * hi;
#pragma unroll
      for (int s = 0; s < 12; ++s) qf[s] = *(const bf16x8*)(qp + 16 * s); }
    const unsigned char* kbase = (const unsigned char*)(Kg + rowbase * 768 + h * DQK);
    const unsigned char* vbase = (const unsigned char*)(Vg + rowbase * 512 + h * DV);
    const unsigned sr = (unsigned)tid >> 3, sc8 = ((unsigned)tid & 7u) * 16u;
    const unsigned ko = sr * 1536u + sc8, vo = sr * 1024u + sc8, kl = (unsigned)L_K + sr * KROW + sc8, vl = (unsigned)L_V + sr * VROW + sc8;
    u32x4 sk[3], sv[2];
#define ATT_LOAD(j) do { const unsigned char* kb_ = kbase + (size_t)(j) * (64 * 768 * 2) + ko; const unsigned char* vb_ = vbase + (size_t)(j) * (64 * 512 * 2) + vo; \
                         _Pragma("unroll") for (int i_ = 0; i_ < 3; ++i_) sk[i_] = *(const u32x4*)(kb_ + 128 * i_); \
                         _Pragma("unroll") for (int i_ = 0; i_ < 2; ++i_) sv[i_] = *(const u32x4*)(vb_ + 128 * i_); } while (0)
#define ATT_WRITE(buf) do { _Pragma("unroll") for (int i_ = 0; i_ < 3; ++i_) *(ATT_LAS u32x4*)(lds + kl + (buf) * KBUF + 128 * i_) = sk[i_]; \
                            _Pragma("unroll") for (int i_ = 0; i_ < 2; ++i_) *(ATT_LAS u32x4*)(lds + vl + (buf) * VBUF + 128 * i_) = sv[i_]; } while (0)
    ATT_LAS float* scr = (ATT_LAS float*)(lds + L_SCR + w * 256);
    f32x16 o[4];
#pragma unroll
    for (int d = 0; d < 4; ++d)
#pragma unroll
        for (int i = 0; i < 16; ++i) o[d][i] = 0.f;
    float m = -1e30f, lsum = 0.f;
    const ATT_LAS unsigned char* kp0 = lds + L_K + r32 * KROW + hi * 16;
    const ATT_LAS unsigned char* vp0 = lds + L_V + (4 * hi + ((lane & 15) >> 2)) * VROW + (((lane >> 4) & 1) * 16 + (lane & 3) * 4) * 2;
    ATT_LOAD(0); ATT_WRITE(0);
    __syncthreads();
#pragma nounroll
    for (int j = 0; j < NT; ++j) {
        const int buf = j & 1;
        if (j + 1 < NT) ATT_LOAD(j + 1);
        if (j <= jdiag) {
            const ATT_LAS unsigned char* kp = kp0 + buf * KBUF;
            f32x16 p0, p1;
#pragma unroll
            for (int i = 0; i < 16; ++i) { p0[i] = 0.f; p1[i] = 0.f; }
#pragma unroll
            for (int s = 0; s < 12; ++s) {
                const bf16x8 k0 = *(const ATT_LAS bf16x8*)(kp + s * 32), k1 = *(const ATT_LAS bf16x8*)(kp + 32 * KROW + s * 32);
                p0 = __builtin_amdgcn_mfma_f32_32x32x16_bf16(k0, qf[s], p0, 0, 0, 0);
                p1 = __builtin_amdgcn_mfma_f32_32x32x16_bf16(k1, qf[s], p1, 0, 0, 0);
                if ((s & 3) == 3) __builtin_amdgcn_sched_barrier(0);
            }
            if (j == 0 || j >= jband) {
#pragma unroll
                for (int i = 0; i < 16; ++i) { const int kr = 64 * j + crow(i, hi);
                    if (kr < LPAD || kr > qrow) p0[i] = -1e30f;
                    if (kr + 32 < LPAD || kr + 32 > qrow) p1[i] = -1e30f; }
            }
            float mx = fmaxf(p0[0], p1[0]);
#pragma unroll
            for (int i = 1; i < 16; ++i) mx = fmaxf(mx, fmaxf(p0[i], p1[i]));
            mx = x32_max(mx);
            const float mn = fmaxf(m, mx);
            const bool grew = mn > m;
            const float alpha = __builtin_amdgcn_exp2f(m - mn);
            m = mn;
            float rs = 0.f;
#pragma unroll
            for (int i = 0; i < 16; ++i) { p0[i] = __builtin_amdgcn_exp2f(p0[i] - mn); p1[i] = __builtin_amdgcn_exp2f(p1[i] - mn); rs += p0[i] + p1[i]; }
            lsum = lsum * alpha + rs;
            if (__any(grew)) {
                if (hi == 0) scr[r32] = alpha;
#pragma unroll
                for (int g = 0; g < 4; ++g) { const f32x4 a4 = *(const ATT_LAS f32x4*)(scr + 8 * g + 4 * hi);
#pragma unroll
                    for (int d = 0; d < 4; ++d) { o[d][4 * g + 0] *= a4[0]; o[d][4 * g + 1] *= a4[1]; o[d][4 * g + 2] *= a4[2]; o[d][4 * g + 3] *= a4[3]; } }
            }
            u32x4 pw[4];
#pragma unroll
            for (int s = 0; s < 2; ++s) {
                pw[s] = (u32x4){cvtpk(p0[8 * s], p0[8 * s + 1]), cvtpk(p0[8 * s + 2], p0[8 * s + 3]), cvtpk(p0[8 * s + 4], p0[8 * s + 5]), cvtpk(p0[8 * s + 6], p0[8 * s + 7])};
                pw[2 + s] = (u32x4){cvtpk(p1[8 * s], p1[8 * s + 1]), cvtpk(p1[8 * s + 2], p1[8 * s + 3]), cvtpk(p1[8 * s + 4], p1[8 * s + 5]), cvtpk(p1[8 * s + 6], p1[8 * s + 7])};
            }
            const ATT_LAS unsigned char* vp = vp0 + buf * VBUF;
            __builtin_amdgcn_sched_barrier(0);
#pragma unroll
            for (int ks = 0; ks < 4; ++ks) {
                const bf16x8 pa = __builtin_bit_cast(bf16x8, pw[ks]);
#pragma unroll
                for (int d = 0; d < 4; ++d) {
                    const s16x4 lo = vtr(vp + (16 * ks) * VROW + 64 * d), hh = vtr(vp + (16 * ks + 8) * VROW + 64 * d);
                    const bf16x8 vb = (bf16x8){lo[0], lo[1], lo[2], lo[3], hh[0], hh[1], hh[2], hh[3]};
                    o[d] = __builtin_amdgcn_mfma_f32_32x32x16_bf16(pa, vb, o[d], 0, 0, 0);
                }
                __builtin_amdgcn_sched_barrier(0);
            }
        }
        if (j + 1 < NT) ATT_WRITE(buf ^ 1);
        __syncthreads();
    }
#undef ATT_LOAD
#undef ATT_WRITE
    const float ltot = x32_sum(lsum);
    if (hi == 0) scr[32 + r32] = ltot;
    const float* og = p.in[19] + h * DV;
    float gl[4];
#pragma unroll
    for (int d = 0; d < 4; ++d) gl[d] = og[32 * d + r32];
    bf16_t* Y = (bf16_t*)(ws + O_Y) + ((size_t)b * SEQ + 256 * qblk + 32 * w) * DM + 512 + h * DV + r32;
#pragma unroll
    for (int g = 0; g < 4; ++g) {
        const f32x4 l4 = *(const ATT_LAS f32x4*)(scr + 32 + 8 * g + 4 * hi);
#pragma unroll
        for (int e = 0; e < 4; ++e) {
            const int i = 4 * g + e;
            float ss = o[0][i] * o[0][i] + o[1][i] * o[1][i] + o[2][i] * o[2][i] + o[3][i] * o[3][i];
            ss += swz_xor<1>(ss); ss += swz_xor<2>(ss); ss += swz_xor<4>(ss); ss += swz_xor<8>(ss); ss += swz_xor<16>(ss);
            const float inv = 1.f / l4[e];
            const float sc = inv / sqrtf(ss * inv * inv * (1.f / DV) + RMS_EPS);
            bf16_t* yr = Y + (size_t)crow(i, hi) * DM;
#pragma unroll
            for (int d = 0; d < 4; ++d) yr[32 * d] = (bf16_t)f2bf(o[d][i] * sc * gl[d]);
        }
    }
}
}

__device__ __forceinline__ void p5_phase(const Params& p, int gw, int ngw, int lane) {
    unsigned char* ws = p.ws;
    const float* YRAW = p.out;
    const f16_t* R = (const f16_t*)(ws + O_R); const f16_t* VV = (const f16_t*)(ws + O_VV); const f16_t* KM = (const f16_t*)(ws + O_KMOD); const bf16_t* G = (const bf16_t*)(ws + O_G);
    bf16_t* Y = (bf16_t*)(ws + O_Y);
    const float* r_k = p.in[12]; const float* ln_w = p.in[13]; const float* ln_b = p.in[14];
    for (int it = gw; it < TR * RH; it += ngw) {
        const int rr = it >> 3, h = it & 7, b = rr / SEQ, s = rr % SEQ;
        const size_t idx = ((size_t)b * LP + 64 + s) * 512 + h * 64 + lane;
        const float y = YRAW[idx];
        const float mean = wave_sum(y) * (1.f / 64.f); const float d = y - mean; const float var = wave_sum(d * d) * (1.f / 64.f);
        const float r = (float)R[idx], k = (float)KM[idx], v = (float)VV[idx];
        const float bonus = wave_sum(r * k * r_k[h * 64 + lane]);
        float yo = d * (1.0f / sqrtf(var + GN_EPS)) * ln_w[h * 64 + lane] + ln_b[h * 64 + lane] + bonus * v;
        yo *= bf2f(G[idx]);
        Y[(size_t)rr * DM + h * 64 + lane] = (bf16_t)f2bf(yo);
    }
}
__device__ __forceinline__ void p9_phase(const Params& p, int gw, int ngw, int lane) {
    const float* ssq = (const float*)(p.ws + O_SSQ3); const float* g = p.in[25];
    for (int row = gw; row < TR; row += ngw) {
        const float rs = 1.0f / sqrtf(ssq[row] * (1.f / DM) + RMS_EPS);
        f32x4* o = (f32x4*)(p.out + (size_t)row * DM) + lane;
#pragma unroll
        for (int j = 0; j < 4; ++j) { const f32x4 gv = ((const f32x4*)g)[lane + 64 * j]; f32x4 v = o[64 * j]; v = v * rs * gv; o[64 * j] = v; }
    }
}

#ifndef PH_MASK
#define PH_MASK 0xFFFF
#endif
#define PH(k) ((PH_MASK >> (k)) & 1)
#ifndef PROBE_PHASE
#define PROBE_PHASE -1
#endif
#define PROBE_EXTRA 4
#define NREP(k) ((PH(k) ? 1 : 0) + ((PROBE_PHASE == (k)) ? PROBE_EXTRA : 0))
constexpr int LDS_BYTES = 153600;
constexpr int LDS_MISC = LDS_BYTES - 256;
__global__ void __launch_bounds__(512, 2) mega_fwd(Params p) {
    extern __shared__ __attribute__((aligned(16))) unsigned char lds[];
    cg::grid_group grid = cg::this_grid();
    const int tid = threadIdx.x, lane = tid & 63, wave = tid >> 6;
    const int G = gridDim.x, gw = blockIdx.x * 8 + wave, ngw = G * 8;
    unsigned char* ws = p.ws;
    PG8_LAS unsigned char* ldsg = (PG8_LAS unsigned char*)lds;
    unsigned* ctl = (unsigned*)(ws + O_CTL);
    for (int rep_ = 0; rep_ < NREP(0); ++rep_) p0_phase(p, (float*)lds, gw, ngw, lane, wave);
    if (blockIdx.x == 0 && tid < 64) ctl[tid] = 0u;
    grid.sync();
    for (int rep_ = 0; rep_ < NREP(1); ++rep_) { pg8::Gemm g{(const bf16_t*)(ws + O_U1), (const bf16_t*)(ws + O_WIN), DM, DM, DM}; pg8::StaticOrder S; S.init(TP, NINP, G, blockIdx.x);
      pg8::Epi8<FP> E{FP{(bf16_t*)(ws + O_P)}}; pg8::gemm_phase<pg8::Epi8<FP>, true>(ldsg, g, S, E); }
    grid.sync();
    for (int rep_ = 0; rep_ < NREP(2); ++rep_) for (int row = gw; row < TP; row += ngw) p2_row(p, row, lane);
    grid.sync();
    for (int rep_ = 0; rep_ < NREP(3); ++rep_) { pg8::Gemm g{(const bf16_t*)(ws + O_CQKV), (const bf16_t*)(ws + O_WUQ), 640, QL, QL}; pg8::StaticOrder S; S.init(TP, 768, G, blockIdx.x);
      pg8::Epi8<FQ> E{FQ{(bf16_t*)(ws + O_Q), (const float*)(ws + O_RSTDQ), (const float*)(ws + O_ROPE)}}; pg8::gemm_phase<pg8::Epi8<FQ>, true>(ldsg, g, S, E); }
    for (int rep_ = 0; rep_ < NREP(4); ++rep_) { pg8::Gemm g{(const bf16_t*)(ws + O_CQKV) + 384, (const bf16_t*)(ws + O_WUKV), 640, KVL, KVL}; pg8::StaticOrder S; S.init(TP, 1024, G, blockIdx.x);
      pg8::Epi8<FKV> E{FKV{(bf16_t*)(ws + O_K), (bf16_t*)(ws + O_V), (const float*)(ws + O_RSTDKV)}}; pg8::gemm_phase<pg8::Epi8<FKV>, true>(ldsg, g, S, E); }
    if (PH(5)) { pg8::Gemm g{(const bf16_t*)(ws + O_LIN), (const bf16_t*)(ws + O_LWA), 384, 256, 256}; pg8::StaticOrder S; S.init(TP, 1024, G, blockIdx.x);
      pg8::Epi8<FLwa> E{FLwa{(f16_t*)(ws + O_EW), (f16_t*)(ws + O_KMOD), (const f16_t*)(ws + O_KK), (f16_t*)(ws + O_B), p.in[5], p.in[7], p.in[11]}}; pg8::gemm_phase<pg8::Epi8<FLwa>, true>(ldsg, g, S, E); }
    for (int rep_ = 0; rep_ < NREP(6); ++rep_) { pg8::Gemm g{(const bf16_t*)(ws + O_LIN) + 128, (const bf16_t*)(ws + O_LG), 384, 256, 256}; pg8::StaticOrder S; S.init(TP, 512, G, blockIdx.x);
      pg8::Epi8<FG> E{FG{(bf16_t*)(ws + O_G)}}; pg8::gemm_phase<pg8::Epi8<FG>, true>(ldsg, g, S, E); }
    grid.sync();
    for (int rep_ = 0; rep_ < NREP(7); ++rep_) for (int u = blockIdx.x; u < NB * RH * 4; u += G) scan::scan_unit(p, (SC_LAS float*)lds, u);
    for (int rep_ = 0; rep_ < NREP(8); ++rep_) {
        const int vcu = (G % 8 == 0) ? (int)(blockIdx.x % 8) * (G / 8) + (int)(blockIdx.x / 8) : (int)blockIdx.x;
        for (int pr = vcu; pr < NB * NH * 8; pr += G) {
            const int bh = pr >> 3, q0 = pr & 7;
#pragma nounroll
            for (int u2 = 0; u2 < 2; ++u2) att::attn_unit(p, ldsg, bh >> 2, bh & 3, u2 ? q0 : 15 - q0);
        }
    }
    grid.sync();
    for (int rep_ = 0; rep_ < NREP(9); ++rep_) p5_phase(p, gw, ngw, lane);
    grid.sync();
    if (PH(10)) { pg8::Gemm g{(const bf16_t*)(ws + O_Y), (const bf16_t*)(ws + O_WOUT), DM, DM, DM}; pg8::StaticOrder S; S.init(TR, DM, G, blockIdx.x);
      pg8::Epi8<FOut> E{FOut{p.in[0], p.out, (bf16_t*)(ws + O_H2B), (float*)(ws + O_SSQ2)}}; pg8::gemm_phase<pg8::Epi8<FOut>, true>(ldsg, g, S, E); }
    grid.sync();
    for (int rep_ = 0; rep_ < NREP(11); ++rep_) { pg8::Gemm g{(const bf16_t*)(ws + O_H2B), (const bf16_t*)(ws + O_WGU), DM, DM, DM}; pg8::StaticOrder S; S.init(TR, 2 * DFF, G, blockIdx.x);
      pg8::Epi8<FAct> E{FAct{(bf16_t*)(ws + O_ACT), (const float*)(ws + O_SSQ2)}}; pg8::gemm_phase<pg8::Epi8<FAct>, true>(ldsg, g, S, E); }
    grid.sync();
    if (PH(12)) { pg8::Gemm g{(const bf16_t*)(ws + O_ACT), (const bf16_t*)(ws + O_WDN), DFF, DFF, DFF}; pg8::StaticOrder S; S.init(TR, DM, G, blockIdx.x);
      pg8::Epi8<FDown> E{FDown{p.out, (float*)(ws + O_SSQ3)}}; pg8::gemm_phase<pg8::Epi8<FDown>, true>(ldsg, g, S, E); }
    grid.sync();
    if (PH(13)) p9_phase(p, gw, ngw, lane);
}

extern "C" void kernel_launch(void* const* d_in, const int* in_sizes, int n_in, void* d_out, int out_size, void* d_ws, size_t ws_size, hipStream_t stream) {
    static int grid_blocks = 0;
    if (grid_blocks == 0) {
        if (n_in != 26 || out_size != TR * DM || ws_size < 512 * MiB) { fprintf(stderr, "kernel_launch: unexpected sizes n_in=%d out=%d ws=%zu\n", n_in, out_size, ws_size); grid_blocks = -1; return; }
        int dev = 0, cus = 0, per_cu = 0;
        (void)hipGetDevice(&dev); (void)hipDeviceGetAttribute(&cus, hipDeviceAttributeMultiprocessorCount, dev);
        (void)hipFuncSetAttribute((const void*)mega_fwd, hipFuncAttributeMaxDynamicSharedMemorySize, LDS_BYTES);
        (void)hipOccupancyMaxActiveBlocksPerMultiprocessor(&per_cu, (const void*)mega_fwd, 512, LDS_BYTES);
        if (per_cu < 1) { fprintf(stderr, "kernel_launch: occupancy query says %d blocks per CU\n", per_cu); per_cu = 1; }
        if (per_cu > 1) per_cu = 1;
        grid_blocks = cus * per_cu;
    }
    if (grid_blocks < 0) return;
    Params p{};
    for (int i = 0; i < 26; ++i) p.in[i] = (const float*)d_in[i];
    p.out = (float*)d_out; p.ws = (unsigned char*)d_ws;
    void* args[] = {&p};
    hipError_t e = hipLaunchCooperativeKernel((const void*)mega_fwd, dim3(grid_blocks), dim3(512), args, LDS_BYTES, stream);
    if (e != hipSuccess) fprintf(stderr, "cooperative launch failed: %s (grid %d)\n", hipGetErrorString(e), grid_blocks);
}
```

```cpp
#include <hip/hip_runtime.h>
#include <hip/hip_cooperative_groups.h>
namespace cg = cooperative_groups;
#include <cstdio>
#include <cstdint>

typedef unsigned short bf16_t;
typedef _Float16 f16_t;
typedef float f32x4 __attribute__((ext_vector_type(4)));
typedef unsigned u32x4 __attribute__((ext_vector_type(4)));
typedef unsigned u32x2 __attribute__((ext_vector_type(2)));

constexpr int NB = 8, SEQ = 4096, DM = 1024, NMETA = 16, L = SEQ + NMETA;
constexpr int LPAD = 48, LP = L + LPAD;
constexpr int TP = NB * LP;
constexpr int TR = NB * SEQ;
constexpr int NIN = 2528, NINP = 2560, RW = 512, RCOLS = 1824;
constexpr int QL = 384, KVL = 256, DQK = 192, DV = 128, NH = 4, RH = 8, RN = 64;
constexpr int DFF = 2816;
constexpr float RMS_EPS = 1e-6f, GN_EPS = 64e-5f;
constexpr float QSCALE = 0.07216878364870323f * 1.4426950408889634f;

constexpr size_t MiB = 1u << 20;
constexpr size_t al256(size_t x) { return (x + 255) & ~(size_t)255; }
constexpr size_t O_WIN = 0;
constexpr size_t O_WUQ = O_WIN + al256((size_t)NINP * DM * 2);
constexpr size_t O_WUKV = O_WUQ + al256((size_t)768 * QL * 2);
constexpr size_t O_LWA = O_WUKV + al256((size_t)1024 * KVL * 2);
constexpr size_t O_LG = O_LWA + al256((size_t)1024 * 256 * 2);
constexpr size_t O_WOUT = O_LG + al256((size_t)512 * 256 * 2);
constexpr size_t O_WGU = O_WOUT + al256((size_t)DM * DM * 2);
constexpr size_t O_WDN = O_WGU + al256((size_t)2 * DFF * DM * 2);
constexpr size_t O_ROPE = O_WDN + al256((size_t)DM * DFF * 2);
constexpr size_t O_RSTDQ = O_ROPE + al256((size_t)L * 32 * 8);
constexpr size_t O_RSTDKV = O_RSTDQ + al256((size_t)TP * 4);
constexpr size_t O_SSQ2 = O_RSTDKV + al256((size_t)TP * 4);
constexpr size_t O_SSQ3 = O_SSQ2 + al256((size_t)TR * 4);
constexpr size_t O_CTL = O_SSQ3 + al256((size_t)TR * 4);
constexpr size_t O_WEND = O_CTL + 65536;
static_assert(O_WEND <= 32 * MiB, "weight region");
constexpr size_t ROWB = (size_t)TP * 512 * 2;
constexpr size_t O_P = 32 * MiB;
constexpr size_t O_Q = O_P;
constexpr size_t O_V = O_Q + al256((size_t)TP * 768 * 2);
constexpr size_t O_EW = O_V + ROWB;
constexpr size_t O_B = O_EW + ROWB;
static_assert(O_B + ROWB <= O_P + al256((size_t)TP * NIN * 2), "aliases inside P");
constexpr size_t O_U1 = 193 * MiB;
constexpr size_t O_R = O_U1;
constexpr size_t O_VV = O_R + ROWB;
static_assert(O_P + al256((size_t)TP * NIN * 2) <= O_U1 && O_VV + ROWB <= 258 * MiB, "U1 region");
constexpr size_t O_KK = 258 * MiB;
constexpr size_t O_KMOD = O_KK + ROWB;
constexpr size_t O_LIN = O_KMOD + ROWB;
constexpr size_t O_CQKV = O_LIN + al256((size_t)TP * 384 * 2);
constexpr size_t O_K = O_CQKV + al256((size_t)TP * 640 * 2);
constexpr size_t O_G = O_K + al256((size_t)TP * 768 * 2);
constexpr size_t O_END1 = O_G + ROWB;
static_assert(O_END1 <= 512 * MiB, "ws");
constexpr size_t O_Y = O_LIN;
static_assert(O_Y + (size_t)TR * DM * 2 <= O_K, "Y alias");
constexpr size_t O_H2B = O_P;
constexpr size_t O_ACT = O_P + 64 * MiB;
static_assert(O_ACT + (size_t)TR * DFF * 2 <= O_Y, "ACT alias");
static_assert((size_t)TP * 512 * 4 <= (size_t)TR * DM * 4, "YRAW in d_out");

struct Params {
    const float* in[26];
    float* out;
    unsigned char* ws;
};

__device__ __forceinline__ unsigned f2bf(float f) { unsigned u = __builtin_bit_cast(unsigned, f); return (u + 0x7fffu + ((u >> 16) & 1u)) >> 16; }
__device__ __forceinline__ float bf2f(unsigned h) { return __builtin_bit_cast(float, h << 16); }
__device__ __forceinline__ unsigned pk2(float lo, float hi) { return f2bf(lo) | (f2bf(hi) << 16); }
__device__ __forceinline__ float wave_sum(float v) {
#pragma unroll
    for (int o = 1; o < 64; o <<= 1) v += __shfl_xor(v, o);
    return v;
}
__device__ __forceinline__ float sigmoidf_(float x) { return 1.f / (1.f + __expf(-x)); }
__device__ __forceinline__ int row_pos(int row) { int p = row % LP - LPAD; return p < 0 ? 0 : p; }

__constant__ double c_inv_freq[32] = {
    1.0, 0.7498942093324559, 0.5623413251903491, 0.4216965034285822, 0.31622776601683794, 0.23713737056616552, 0.1778279410038923, 0.1333521432163324,
    0.1, 0.07498942093324558, 0.05623413251903491, 0.04216965034285822, 0.03162277660168379, 0.023713737056616554, 0.01778279410038923, 0.01333521432163324,
    0.01, 0.007498942093324559, 0.005623413251903491, 0.004216965034285823, 0.0031622776601683794, 0.0023713737056616554, 0.0017782794100389228, 0.001333521432163324,
    0.001, 0.0007498942093324559, 0.0005623413251903491, 0.0004216965034285822, 0.00031622776601683794, 0.00023713737056616554, 0.00017782794100389227, 0.0001333521432163324};

__device__ __forceinline__ void sincos_d(double a, float& s, float& c) {
    const double q = __builtin_rint(a * 0.6366197723675814);
    double r = __builtin_fma(-q, 1.5707963267948966, a);
    r = __builtin_fma(-q, 6.123233995736766e-17, r);
    const double r2 = r * r;
    double sp = -1.0 / 1307674368000.0;
    sp = sp * r2 + 1.0 / 6227020800.0; sp = sp * r2 - 1.0 / 39916800.0; sp = sp * r2 + 1.0 / 362880.0; sp = sp * r2 - 1.0 / 5040.0; sp = sp * r2 + 1.0 / 120.0; sp = sp * r2 - 1.0 / 6.0;
    const double sn = r + r * r2 * sp;
    double cp = 1.0 / 87178291200.0;
    cp = cp * r2 - 1.0 / 479001600.0; cp = cp * r2 + 1.0 / 3628800.0; cp = cp * r2 - 1.0 / 40320.0; cp = cp * r2 + 1.0 / 720.0; cp = cp * r2 - 1.0 / 24.0; cp = cp * r2 + 0.5;
    const double cs = 1.0 - r2 * cp;
    const int qi = ((int)q) & 3;
    const double ss = (qi == 0) ? sn : (qi == 1) ? cs : (qi == 2) ? -sn : -cs;
    const double cc = (qi == 0) ? cs : (qi == 1) ? -sn : (qi == 2) ? -cs : sn;
    s = (float)ss; c = (float)cc;
}

struct SrcWin { const float* w; __device__ float operator()(int k, int n) const {
        if (n >= NIN) return 0.f; int ns = n;
        if (n >= 2464) { const int j = n - 2464; ns = 2464 + (j >> 1) + 32 * (j & 1); }
        return w[(size_t)k * NIN + ns]; } };
struct SrcWuq { const float* w; const float* g; __device__ float operator()(int k, int n) const {
        const int h = n / DQK, c = n % DQK; int cs = c; if (c >= 128) { const int j = c - 128; cs = 128 + (j >> 1) + 32 * (j & 1); }
        return w[(size_t)k * 768 + h * DQK + cs] * g[k]; } };
struct SrcWukv { const float* w; const float* g; __device__ float operator()(int k, int n) const { return w[(size_t)k * 1024 + n] * g[k]; } };
struct SrcLwa { const float* w2; const float* a2; __device__ float operator()(int k, int n) const {
        if (n < 512) return k < 64 ? w2[(size_t)k * 512 + n] : 0.f;
        return (k >= 64 && k < 128) ? a2[(size_t)(k - 64) * 512 + (n - 512)] : 0.f; } };
struct SrcLg { const float* g2; __device__ float operator()(int k, int n) const { return k < 160 ? g2[(size_t)k * 512 + n] : 0.f; } };
struct SrcWout { const float* w; __device__ float operator()(int k, int n) const { return w[(size_t)k * DM + n]; } };
struct SrcWgu { const float* wg; const float* wu; const float* g; __device__ float operator()(int k, int n) const {
        const int j = n >> 8, c = n & 255; const float v = c < 128 ? wg[(size_t)k * DFF + 128 * j + c] : wu[(size_t)k * DFF + 128 * j + (c - 128)];
        return v * g[k]; } };
struct SrcWdn { const float* w; __device__ float operator()(int k, int n) const { return w[(size_t)k * DM + n]; } };

template <class F>
__device__ __forceinline__ void wconv_item(const F& f, bf16_t* WT, int K, int nblk, int item, float* scr, int lane) {
    const int kb = item / nblk, nb = item % nblk, k0 = 64 * kb, n0 = 32 * nb;
#pragma unroll 8
    for (int i = 0; i < 32; ++i) { const int kk = 2 * i + (lane >> 5); scr[kk * 33 + (lane & 31)] = f(k0 + kk, n0 + (lane & 31)); }
    asm volatile("s_waitcnt lgkmcnt(0)" ::: "memory");
    const int c = lane & 7;
#pragma unroll
    for (int j = 0; j < 4; ++j) { const int n = (lane >> 3) + 8 * j; const float* s = scr + (8 * c) * 33 + n;
        u32x4 o; o.x = pk2(s[0 * 33], s[1 * 33]); o.y = pk2(s[2 * 33], s[3 * 33]); o.z = pk2(s[4 * 33], s[5 * 33]); o.w = pk2(s[6 * 33], s[7 * 33]);
        *(u32x4*)(WT + (size_t)(n0 + n) * K + k0 + 8 * c) = o; }
    asm volatile("s_waitcnt lgkmcnt(0)" ::: "memory");
}

__device__ __forceinline__ void p0_phase(const Params& p, float* scr_all, int gw, int ngw, int lane, int wave_in_block) {
    float* scr = scr_all + wave_in_block * (64 * 33);
    unsigned char* ws = p.ws;
    constexpr int I0 = (DM / 64) * (NINP / 32), I1 = (QL / 64) * (768 / 32), I2 = (KVL / 64) * (1024 / 32), I3 = (256 / 64) * (1024 / 32), I4 = (256 / 64) * (512 / 32),
                  I5 = (DM / 64) * (DM / 32), I6 = (DM / 64) * (2 * DFF / 32), I7 = (DFF / 64) * (DM / 32);
    constexpr int NIT = I0 + I1 + I2 + I3 + I4 + I5 + I6 + I7;
    for (int it = gw; it < NIT; it += ngw) {
        int r = it;
        if (r < I0) { wconv_item(SrcWin{p.in[3]}, (bf16_t*)(ws + O_WIN), DM, NINP / 32, r, scr, lane); continue; } r -= I0;
        if (r < I1) { wconv_item(SrcWuq{p.in[16], p.in[15]}, (bf16_t*)(ws + O_WUQ), QL, 768 / 32, r, scr, lane); continue; } r -= I1;
        if (r < I2) { wconv_item(SrcWukv{p.in[18], p.in[17]}, (bf16_t*)(ws + O_WUKV), KVL, 1024 / 32, r, scr, lane); continue; } r -= I2;
        if (r < I3) { wconv_item(SrcLwa{p.in[6], p.in[8]}, (bf16_t*)(ws + O_LWA), 256, 1024 / 32, r, scr, lane); continue; } r -= I3;
        if (r < I4) { wconv_item(SrcLg{p.in[9]}, (bf16_t*)(ws + O_LG), 256, 512 / 32, r, scr, lane); continue; } r -= I4;
        if (r < I5) { wconv_item(SrcWout{p.in[20]}, (bf16_t*)(ws + O_WOUT), DM, DM / 32, r, scr, lane); continue; } r -= I5;
        if (r < I6) { wconv_item(SrcWgu{p.in[22], p.in[23], p.in[21]}, (bf16_t*)(ws + O_WGU), DM, 2 * DFF / 32, r, scr, lane); continue; } r -= I6;
        wconv_item(SrcWdn{p.in[24]}, (bf16_t*)(ws + O_WDN), DFF, DM / 32, r, scr, lane);
    }
    const float* x = p.in[0]; const float* meta = p.in[1]; const float* g1 = p.in[2];
    bf16_t* U1 = (bf16_t*)(ws + O_U1);
    for (int row = gw; row < TP; row += ngw) {
        const int b = row / LP, pr = row % LP - LPAD;
        u32x2* o = (u32x2*)(U1 + (size_t)row * DM) + lane;
        if (pr < 0) {
#pragma unroll
            for (int j = 0; j < 4; ++j) o[64 * j] = (u32x2){0u, 0u};
            continue;
        }
        const float* src = pr < NMETA ? meta + (size_t)pr * DM : x + ((size_t)b * SEQ + (pr - NMETA)) * DM;
        const f32x4* xr = (const f32x4*)src + lane;
        f32x4 v[4]; float s = 0.f;
#pragma unroll
        for (int j = 0; j < 4; ++j) { v[j] = xr[64 * j]; s += (v[j].x * v[j].x + v[j].y * v[j].y) + (v[j].z * v[j].z + v[j].w * v[j].w); }
        const float rstd = 1.0f / sqrtf(wave_sum(s) * (1.f / DM) + RMS_EPS);
#pragma unroll
        for (int j = 0; j < 4; ++j) { const f32x4 g = ((const f32x4*)g1)[lane + 64 * j];
            o[64 * j] = (u32x2){pk2(v[j].x * rstd * g.x, v[j].y * rstd * g.y), pk2(v[j].z * rstd * g.z, v[j].w * rstd * g.w)}; }
    }
    float* rope = (float*)(ws + O_ROPE);
    for (int i = gw * 64 + lane; i < L * 32; i += ngw * 64) {
        const int pos = i >> 5, f = i & 31; float s, c; sincos_d((double)pos * c_inv_freq[f], s, c);
        rope[2 * i] = c; rope[2 * i + 1] = s;
    }
    float* ssq = (float*)(ws + O_SSQ2);
    for (int i = gw * 64 + lane; i < (int)((O_CTL - O_SSQ2) / 4); i += ngw * 64) ssq[i] = 0.f;
}

__device__ __forceinline__ void p2_row(const Params& p, int row, int lane) {
    unsigned char* ws = p.ws;
    const bf16_t* P = (const bf16_t*)(ws + O_P);
    const bf16_t* cur = P + (size_t)row * NIN; const bf16_t* prv = cur - NIN;
    const bool has_prev = row > 0;
    const float* mu = p.in[4]; const float* k_k = p.in[10];
    f16_t* R = (f16_t*)(ws + O_R); f16_t* VV = (f16_t*)(ws + O_VV); f16_t* KK = (f16_t*)(ws + O_KK); f16_t* KM = (f16_t*)(ws + O_KMOD);
    bf16_t* LIN = (bf16_t*)(ws + O_LIN); bf16_t* CQKV = (bf16_t*)(ws + O_CQKV); bf16_t* Kb = (bf16_t*)(ws + O_K);
    float ssq_q = 0.f, ssq_kv = 0.f;
    for (int ch = lane; ch < 320; ch += 64) {
        const bool act = ch < 316; const int c0 = 8 * ch;
        float v[8];
        {
            u32x4 a = (u32x4){0u, 0u, 0u, 0u};
            if (act) a = *(const u32x4*)(cur + c0);
            v[0] = bf2f(a.x & 0xffffu); v[1] = bf2f(a.x >> 16); v[2] = bf2f(a.y & 0xffffu); v[3] = bf2f(a.y >> 16);
            v[4] = bf2f(a.z & 0xffffu); v[5] = bf2f(a.z >> 16); v[6] = bf2f(a.w & 0xffffu); v[7] = bf2f(a.w >> 16);
        }
        if (c0 < RCOLS) {
            u32x4 b = (u32x4){0u, 0u, 0u, 0u};
            if (act && has_prev) b = *(const u32x4*)(prv + c0);
            float q[8];
            q[0] = bf2f(b.x & 0xffffu); q[1] = bf2f(b.x >> 16); q[2] = bf2f(b.y & 0xffffu); q[3] = bf2f(b.y >> 16);
            q[4] = bf2f(b.z & 0xffffu); q[5] = bf2f(b.z >> 16); q[6] = bf2f(b.w & 0xffffu); q[7] = bf2f(b.w >> 16);
#pragma unroll
            for (int j = 0; j < 8; ++j) v[j] = v[j] + (q[j] - v[j]) * mu[c0 + j];
        }
        const bool isk = (c0 >= 512 && c0 < 1024);
        float ss = 0.f; float kkv[8];
        if (isk) {
#pragma unroll
            for (int j = 0; j < 8; ++j) { kkv[j] = v[j] * k_k[c0 - 512 + j]; ss += kkv[j] * kkv[j]; }
        }
        ss += __shfl_xor(ss, 1); ss += __shfl_xor(ss, 2); ss += __shfl_xor(ss, 4);
        if (!act) continue;
        if (c0 < 512) {
#pragma unroll
            for (int j = 0; j < 8; ++j) R[(size_t)row * 512 + c0 + j] = (f16_t)v[j];
        } else if (c0 < 1024) {
            const float inv = 1.f / fmaxf(sqrtf(ss), 1e-12f);
#pragma unroll
            for (int j = 0; j < 8; ++j) { KM[(size_t)row * 512 + c0 - 512 + j] = (f16_t)v[j]; KK[(size_t)row * 512 + c0 - 512 + j] = (f16_t)(kkv[j] * inv); }
        } else if (c0 < 1536) {
#pragma unroll
            for (int j = 0; j < 8; ++j) VV[(size_t)row * 512 + c0 - 1024 + j] = (f16_t)v[j];
        } else if (c0 < 1600) {
#pragma unroll
            for (int j = 0; j < 8; ++j) LIN[(size_t)row * 384 + c0 - 1536 + j] = (bf16_t)f2bf(tanhf(v[j]));
        } else if (c0 < 1664) {
#pragma unroll
            for (int j = 0; j < 8; ++j) LIN[(size_t)row * 384 + c0 - 1536 + j] = (bf16_t)f2bf(v[j]);
        } else if (c0 < 1824) {
#pragma unroll
            for (int j = 0; j < 8; ++j) LIN[(size_t)row * 384 + c0 - 1536 + j] = (bf16_t)f2bf(sigmoidf_(v[j]));
        } else if (c0 < 2208) {
#pragma unroll
            for (int j = 0; j < 8; ++j) { CQKV[(size_t)row * 640 + c0 - 1824 + j] = (bf16_t)f2bf(v[j]); ssq_q += v[j] * v[j]; }
        } else if (c0 < 2464) {
#pragma unroll
            for (int j = 0; j < 8; ++j) { CQKV[(size_t)row * 640 + c0 - 1824 + j] = (bf16_t)f2bf(v[j]); ssq_kv += v[j] * v[j]; }
        } else {
            const float* t = (const float*)(ws + O_ROPE) + ((size_t)row_pos(row) * 32 + ((c0 - 2464) >> 1)) * 2;
            float o[8];
#pragma unroll
            for (int j = 0; j < 4; ++j) { const float cs = t[2 * j], sn = t[2 * j + 1]; o[2 * j] = v[2 * j] * cs - v[2 * j + 1] * sn; o[2 * j + 1] = v[2 * j + 1] * cs + v[2 * j] * sn; }
            u32x4 w; w.x = pk2(o[0], o[1]); w.y = pk2(o[2], o[3]); w.z = pk2(o[4], o[5]); w.w = pk2(o[6], o[7]);
#pragma unroll
            for (int h = 0; h < NH; ++h) *(u32x4*)(Kb + (size_t)row * 768 + h * DQK + 128 + (c0 - 2464)) = w;
        }
    }
    if (lane < 12) *(u32x4*)(LIN + (size_t)row * 384 + 288 + 8 * lane) = (u32x4){0u, 0u, 0u, 0u};
    ssq_q = wave_sum(ssq_q); ssq_kv = wave_sum(ssq_kv);
    if (lane == 0) { ((float*)(ws + O_RSTDQ))[row] = 1.0f / sqrtf(ssq_q * (1.f / QL) + RMS_EPS); ((float*)(ws + O_RSTDKV))[row] = 1.0f / sqrtf(ssq_kv * (1.f / KVL) + RMS_EPS); }
}
namespace pg8 {
#define PG8_LAS __attribute__((address_space(3)))
typedef short bf16x8 __attribute__((ext_vector_type(8)));
constexpr int BM = 256, BK = 64, HALF = 128, HTB = HALF * BK * 2, STAGE_BYTES = 8 * HTB, NXCD = 8, WGM = 8;
__host__ __device__ __forceinline__ int lds_byte(int r, int c) { const int st = (r >> 4) * 2 + (c >> 5), rr = r & 15, cc = c & 31, ob = rr * 64 + cc * 2; return st * 1024 + (ob ^ (((ob >> 9) & 1) << 5)); }
__host__ __device__ __forceinline__ void stage_rc(int b, int& R, int& C) { const int st = b / 1024, sb = b % 1024, swz = sb ^ (((sb >> 9) & 1) << 5); R = (st >> 1) * 16 + swz / 64; C = (st & 1) * 32 + (swz % 64) / 2; }
__host__ __device__ __forceinline__ int perm32(int rho) { const int n = rho >> 4, i = rho & 15; return 8 * (i >> 2) + 4 * n + (i & 3); }
struct Unit { int pm, pn; };
struct Gemm { const bf16_t* A; const bf16_t* Bt; int lda, ldb, K; };
struct StaticOrder {
    int nM, nN, nwg, G, c;
    __host__ __device__ void init(int M, int N, int G_, int c_) { nM = M / BM; nN = N / BM; nwg = nM * nN; G = G_; c = c_; }
    __host__ __device__ bool next(int i, Unit& u) const {
        const long L = (long)i * G + c; if (L >= nwg) return false;
        int wgid = (int)L; { const int q = nwg / NXCD, r = nwg % NXCD, xcd = wgid % NXCD, off = wgid / NXCD; wgid = (xcd < r ? xcd * (q + 1) : r * (q + 1) + (xcd - r) * q) + off; }
        const int nig = WGM * nN, gid = wgid / nig, fm = gid * WGM, gsz = (nM - fm) < WGM ? (nM - fm) : WGM;
        u.pm = fm + ((wgid % nig) % gsz); u.pn = (wgid % nig) / gsz; return true;
    }
};
template <class F> struct Epi8 {
    F f;
    __device__ __forceinline__ void operator()(const f32x4 (&acc)[2][2][4][2], const Unit& u, int wr, int wc, int fr, int fq) const {
        const int col = u.pn * BM + wc * 32 + 8 * fq;
#pragma unroll
        for (int ai = 0; ai < 2; ++ai)
#pragma unroll
            for (int m = 0; m < 4; ++m) f(u.pm * BM + ai * HALF + wr * 64 + m * 16 + fr, col, acc[ai][0][m][0], acc[ai][0][m][1], acc[ai][1][m][0], acc[ai][1][m][1]);
    }
};

template <class Epi, bool ALIGN_EPI>
__device__ __forceinline__ void gemm_phase(PG8_LAS unsigned char* lds, const Gemm g, const StaticOrder& S, const Epi& E) {
    const int tid = threadIdx.x, wid = __builtin_amdgcn_readfirstlane(tid >> 6), lane = tid & 63, wr = wid >> 2, wc = wid & 3, fr = lane & 15, fq = lane >> 4;
    const int K = g.K, nt = K / BK;
    unsigned voffA[2], voffB[2];
#pragma unroll
    for (int i = 0; i < 2; ++i) { int R, C; stage_rc(tid * 16 + i * 8192, R, C); const int Rb = (R & ~31) + perm32(R & 31);
        voffA[i] = (unsigned)(R * g.lda + C) * 2u; voffB[i] = (unsigned)(Rb * g.ldb + C) * 2u; }
    const size_t kstep = (size_t)(BK * 2);
    const size_t hstepA = (size_t)HALF * g.lda * 2, hstepB = (size_t)HALF * g.ldb * 2;
    const size_t tstepA = 2 * hstepA, tstepB = 2 * hstepB;
    const unsigned ldsw = (unsigned)wid * 1024u;
    const int aoff = lds_byte(wr * 64 + fr, fq * 8), boff = lds_byte(wc * 32 + fr, fq * 8);
#define PG8_SA(b, h) (((b) * 2 + (h)) * HTB)
#define PG8_SB(b, h) ((4 + (b) * 2 + (h)) * HTB)
#define PG8_STAGE(bufoff, gbase, voff) do { _Pragma("unroll") for (int _i = 0; _i < 2; ++_i) \
        __builtin_amdgcn_global_load_lds((const unsigned*)((const char*)(gbase) + (voff)[_i]), (PG8_LAS unsigned*)(lds + (bufoff) + ldsw + _i * 8192), 16, 0, 0); } while (0)
#define PG8_LDA(dst, b, h) do { _Pragma("unroll") for (int m = 0; m < 4; ++m) _Pragma("unroll") for (int k = 0; k < 2; ++k) dst[m][k] = *(const PG8_LAS bf16x8*)(lds + PG8_SA(b, h) + aoff + m * 2048 + k * 1024); } while (0)
#define PG8_LDB(dst, b, h) do { _Pragma("unroll") for (int n = 0; n < 2; ++n) _Pragma("unroll") for (int k = 0; k < 2; ++k) dst[n][k] = *(const PG8_LAS bf16x8*)(lds + PG8_SB(b, h) + boff + n * 2048 + k * 1024); } while (0)
#define PG8_MMA(ai, bj, At, Bt) do { __builtin_amdgcn_s_setprio(1); _Pragma("unroll") for (int m = 0; m < 4; ++m) _Pragma("unroll") for (int n = 0; n < 2; ++n) _Pragma("unroll") for (int k = 0; k < 2; ++k) \
        acc[ai][bj][m][n] = __builtin_amdgcn_mfma_f32_16x16x32_bf16(Bt[n][k], At[m][k], acc[ai][bj][m][n], 0, 0, 0); __builtin_amdgcn_s_setprio(0); } while (0)
#define PG8_WAIT_V(n) asm volatile("s_waitcnt vmcnt(" #n ")" ::: "memory")
#define PG8_WAIT_L(n) asm volatile("s_waitcnt lgkmcnt(" #n ")" ::: "memory")
#define PG8_BAR __builtin_amdgcn_s_barrier()
#define PG8_SCHED __builtin_amdgcn_sched_barrier(0)
    Unit cur, nxt; int ui = 0;
    if (!S.next(0, cur)) return;
    f32x4 acc[2][2][4][2];
#pragma unroll
    for (int a = 0; a < 2; ++a)
#pragma unroll
        for (int b = 0; b < 2; ++b)
#pragma unroll
            for (int m = 0; m < 4; ++m)
#pragma unroll
                for (int n = 0; n < 2; ++n) acc[a][b][m][n] = (f32x4){0.f, 0.f, 0.f, 0.f};
    bf16x8 At[4][2], B0[2][2], B1[2][2];
    const char* cA = (const char*)g.A + (size_t)cur.pm * tstepA; const char* cB = (const char*)g.Bt + (size_t)cur.pn * tstepB;
    PG8_STAGE(PG8_SB(0, 0), cB, voffB); PG8_STAGE(PG8_SB(0, 1), cB + hstepB, voffB); PG8_STAGE(PG8_SA(0, 0), cA, voffA); PG8_STAGE(PG8_SA(0, 1), cA + hstepA, voffA);
    if (wr == 1) PG8_BAR;
    PG8_WAIT_V(2); PG8_BAR;
    PG8_STAGE(PG8_SB(1, 0), cB + kstep, voffB); PG8_STAGE(PG8_SA(1, 0), cA + kstep, voffA); PG8_STAGE(PG8_SB(1, 1), cB + hstepB + kstep, voffB);
    PG8_WAIT_V(6); PG8_BAR;
#pragma nounroll
    for (;;) {
        const bool has_next = S.next(ui + 1, nxt);
        const char* nA = has_next ? (const char*)g.A + (size_t)nxt.pm * tstepA : cA; const char* nB = has_next ? (const char*)g.Bt + (size_t)nxt.pn * tstepB : cB;
#pragma nounroll
        for (int t = 0; t < nt; t += 2) {
            const bool last = (t == nt - 2);
            const char* a1 = cA + (size_t)(t + 1) * kstep;
            const char* a2 = last ? nA : cA + (size_t)(t + 2) * kstep; const char* b2 = last ? nB : cB + (size_t)(t + 2) * kstep;
            const char* a3 = a2 + kstep; const char* b3 = b2 + kstep;
            PG8_LDB(B0, 0, 0); PG8_LDB(B1, 0, 1); PG8_SCHED; PG8_LDA(At, 0, 0); PG8_STAGE(PG8_SA(1, 1), a1 + hstepA, voffA);
            PG8_WAIT_V(8); PG8_WAIT_L(0); PG8_BAR; PG8_MMA(0, 0, At, B0); PG8_MMA(0, 1, At, B1); PG8_BAR; PG8_SCHED;
            PG8_LDA(At, 0, 1); PG8_STAGE(PG8_SB(0, 0), b2, voffB); PG8_STAGE(PG8_SB(0, 1), b2 + hstepB, voffB); PG8_STAGE(PG8_SA(0, 0), a2, voffA);
            PG8_WAIT_V(8); PG8_WAIT_L(0); PG8_BAR; PG8_MMA(1, 0, At, B0); PG8_MMA(1, 1, At, B1); PG8_BAR; PG8_SCHED;
            PG8_LDB(B0, 1, 0); PG8_LDB(B1, 1, 1); PG8_SCHED; PG8_LDA(At, 1, 0); PG8_STAGE(PG8_SA(0, 1), a2 + hstepA, voffA);
            PG8_WAIT_V(8); PG8_WAIT_L(0); PG8_BAR; PG8_MMA(0, 0, At, B0); PG8_MMA(0, 1, At, B1); PG8_BAR; PG8_SCHED;
            PG8_LDA(At, 1, 1); PG8_STAGE(PG8_SB(1, 0), b3, voffB); PG8_STAGE(PG8_SB(1, 1), b3 + hstepB, voffB); PG8_STAGE(PG8_SA(1, 0), a3, voffA);
            PG8_WAIT_V(8); PG8_WAIT_L(0); PG8_BAR; PG8_MMA(1, 0, At, B0); PG8_MMA(1, 1, At, B1); PG8_BAR; PG8_SCHED;
        }
        if constexpr (ALIGN_EPI) { if (wr == 0) PG8_BAR; }
        E(acc, cur, wr, wc, fr, fq);
        if (!has_next) break;
#pragma unroll
        for (int a = 0; a < 2; ++a)
#pragma unroll
            for (int b = 0; b < 2; ++b)
#pragma unroll
                for (int m = 0; m < 4; ++m)
#pragma unroll
                    for (int n = 0; n < 2; ++n) acc[a][b][m][n] = (f32x4){0.f, 0.f, 0.f, 0.f};
        cur = nxt; cA = nA; cB = nB; ++ui;
        if constexpr (ALIGN_EPI) { if (wr == 1) PG8_BAR; }
    }
    PG8_WAIT_V(0);
    if constexpr (!ALIGN_EPI) { if (wr == 0) PG8_BAR; }
    PG8_BAR;
#undef PG8_SA
#undef PG8_SB
#undef PG8_STAGE
#undef PG8_LDA
#undef PG8_LDB
#undef PG8_MMA
#undef PG8_WAIT_V
#undef PG8_WAIT_L
#undef PG8_BAR
#undef PG8_SCHED
}
}

__device__ __forceinline__ u32x4 pack8(const f32x4& a0, const f32x4& a1) { u32x4 w; w.x = pk2(a0[0], a0[1]); w.y = pk2(a0[2], a0[3]); w.z = pk2(a1[0], a1[1]); w.w = pk2(a1[2], a1[3]); return w; }
typedef _Float16 f16x8 __attribute__((ext_vector_type(8)));
struct FP {
    bf16_t* P;
    __device__ __forceinline__ void operator()(int row, int col, const f32x4& a0, const f32x4& a1, const f32x4& b0, const f32x4& b1) const {
        if (col < NIN) *(u32x4*)(P + (size_t)row * NIN + col) = pack8(a0, a1);
        if (col + 128 < NIN) *(u32x4*)(P + (size_t)row * NIN + col + 128) = pack8(b0, b1);
    }
};
struct FQ {
    bf16_t* Q; const float* rstd; const float* rope;
    __device__ __forceinline__ void one(int row, int col, float rs, f32x4 a0, f32x4 a1) const {
        a0 = a0 * rs; a1 = a1 * rs;
        const int c = col % DQK;
        if (c >= 128) { const f32x4* t = (const f32x4*)(rope + ((size_t)row_pos(row) * 32 + ((c - 128) >> 1)) * 2); const f32x4 t0 = t[0], t1 = t[1];
            f32x4 o0, o1;
            o0[0] = a0[0] * t0[0] - a0[1] * t0[1]; o0[1] = a0[1] * t0[0] + a0[0] * t0[1]; o0[2] = a0[2] * t0[2] - a0[3] * t0[3]; o0[3] = a0[3] * t0[2] + a0[2] * t0[3];
            o1[0] = a1[0] * t1[0] - a1[1] * t1[1]; o1[1] = a1[1] * t1[0] + a1[0] * t1[1]; o1[2] = a1[2] * t1[2] - a1[3] * t1[3]; o1[3] = a1[3] * t1[2] + a1[2] * t1[3];
            a0 = o0; a1 = o1; }
        *(u32x4*)(Q + (size_t)row * 768 + col) = pack8(a0, a1);
    }
    __device__ __forceinline__ void operator()(int row, int col, const f32x4& a0, const f32x4& a1, const f32x4& b0, const f32x4& b1) const {
        const float rs = rstd[row] * QSCALE; one(row, col, rs, a0, a1); one(row, col + 128, rs, b0, b1); }
};
struct FKV {
    bf16_t* K; bf16_t* V; const float* rstd;
    __device__ __forceinline__ void one(int row, int col, float rs, const f32x4& a0, const f32x4& a1) const {
        const int h = col >> 8, c = col & 255; const u32x4 w = pack8(a0 * rs, a1 * rs);
        if (c < 128) *(u32x4*)(K + (size_t)row * 768 + h * DQK + c) = w; else *(u32x4*)(V + (size_t)row * 512 + h * DV + (c - 128)) = w; }
    __device__ __forceinline__ void operator()(int row, int col, const f32x4& a0, const f32x4& a1, const f32x4& b0, const f32x4& b1) const {
        const float rs = rstd[row]; one(row, col, rs, a0, a1); one(row, col + 128, rs, b0, b1); }
};
struct FLwa {
    f16_t* EW; f16_t* KMOD; const f16_t* KK; f16_t* Bv; const float* w0; const float* a0p; const float* k_a;
    __device__ __forceinline__ void one(int row, int col, const f32x4& a0, const f32x4& a1) const {
        float v[8] = {a0[0], a0[1], a0[2], a0[3], a1[0], a1[1], a1[2], a1[3]};
        if (col < 512) {
            f16x8 o;
#pragma unroll
            for (int j = 0; j < 8; ++j) { const float xx = w0[col + j] + v[j]; const float sp = (-xx > 20.f) ? -xx : __logf(1.f + __expf(-xx)); o[j] = (f16_t)__expf(-sp - 0.5f); }
            *(f16x8*)(EW + (size_t)row * 512 + col) = o;
        } else {
            const int c = col - 512; const size_t idx = (size_t)row * 512 + c;
            const f16x8 kv = *(const f16x8*)(KMOD + idx), kkv = *(const f16x8*)(KK + idx); f16x8 ko, bo;
#pragma unroll
            for (int j = 0; j < 8; ++j) { const float a = sigmoidf_(a0p[c + j] + v[j]); ko[j] = (f16_t)((float)kv[j] * (1.f + (a - 1.f) * k_a[c + j])); bo[j] = (f16_t)((float)kkv[j] * a); }
            *(f16x8*)(KMOD + idx) = ko; *(f16x8*)(Bv + idx) = bo;
        }
    }
    __device__ __forceinline__ void operator()(int row, int col, const f32x4& a0, const f32x4& a1, const f32x4& b0, const f32x4& b1) const { one(row, col, a0, a1); one(row, col + 128, b0, b1); }
};
struct FG { bf16_t* G;
    __device__ __forceinline__ void operator()(int row, int col, const f32x4& a0, const f32x4& a1, const f32x4& b0, const f32x4& b1) const {
        *(u32x4*)(G + (size_t)row * 512 + col) = pack8(a0, a1); *(u32x4*)(G + (size_t)row * 512 + col + 128) = pack8(b0, b1); } };
struct FOut {
    const float* x; float* H2; bf16_t* H2B; float* ssq;
    __device__ __forceinline__ float one(size_t idx, const f32x4& a0, const f32x4& a1) const {
        const f32x4 h0 = *(const f32x4*)(x + idx) + a0, h1 = *(const f32x4*)(x + idx + 4) + a1;
        *(f32x4*)(H2 + idx) = h0; *(f32x4*)(H2 + idx + 4) = h1; *(u32x4*)(H2B + idx) = pack8(h0, h1);
        return (h0[0] * h0[0] + h0[1] * h0[1]) + (h0[2] * h0[2] + h0[3] * h0[3]) + (h1[0] * h1[0] + h1[1] * h1[1]) + (h1[2] * h1[2] + h1[3] * h1[3]); }
    __device__ __forceinline__ void operator()(int row, int col, const f32x4& a0, const f32x4& a1, const f32x4& b0, const f32x4& b1) const {
        float s = one((size_t)row * DM + col, a0, a1) + one((size_t)row * DM + col + 128, b0, b1);
        s += __shfl_xor(s, 16); s += __shfl_xor(s, 32);
        if ((threadIdx.x & 63) < 16) atomicAdd(ssq + row, s); }
};
struct FAct {
    bf16_t* ACT; const float* ssq;
    __device__ __forceinline__ void operator()(int row, int col, const f32x4& a0, const f32x4& a1, const f32x4& b0, const f32x4& b1) const {
        const float rs = 1.0f / sqrtf(ssq[row] * (1.f / DM) + RMS_EPS);
        f32x4 o0, o1;
#pragma unroll
        for (int j = 0; j < 4; ++j) { const float g0 = a0[j] * rs, g1 = a1[j] * rs; o0[j] = g0 * sigmoidf_(g0) * (b0[j] * rs); o1[j] = g1 * sigmoidf_(g1) * (b1[j] * rs); }
        *(u32x4*)(ACT + (size_t)row * DFF + (col >> 8) * 128 + (col & 127)) = pack8(o0, o1); }
};
struct FDown {
    float* H; float* ssq;
    __device__ __forceinline__ float one(size_t idx, const f32x4& a0, const f32x4& a1) const {
        const f32x4 h0 = *(const f32x4*)(H + idx) + a0, h1 = *(const f32x4*)(H + idx + 4) + a1; *(f32x4*)(H + idx) = h0; *(f32x4*)(H + idx + 4) = h1;
        return (h0[0] * h0[0] + h0[1] * h0[1]) + (h0[2] * h0[2] + h0[3] * h0[3]) + (h1[0] * h1[0] + h1[1] * h1[1]) + (h1[2] * h1[2] + h1[3] * h1[3]); }
    __device__ __forceinline__ void operator()(int row, int col, const f32x4& a0, const f32x4& a1, const f32x4& b0, const f32x4& b1) const {
        float s = one((size_t)row * DM + col, a0, a1) + one((size_t)row * DM + col + 128, b0, b1);
        s += __shfl_xor(s, 16); s += __shfl_xor(s, 32);
        if ((threadIdx.x & 63) < 16) atomicAdd(ssq + row, s); }
};

__device__ __forceinline__ void scan_simple_unit(const Params& p, int unit, int t256) {
    unsigned char* ws = p.ws;
    const f16_t* R = (const f16_t*)(ws + O_R); const f16_t* VV = (const f16_t*)(ws + O_VV); const f16_t* KK = (const f16_t*)(ws + O_KK); const f16_t* KM = (const f16_t*)(ws + O_KMOD);
    const f16_t* EW = (const f16_t*)(ws + O_EW); const f16_t* Bv = (const f16_t*)(ws + O_B);
    float* YRAW = p.out;
    const int bh = unit >> 2, quarter = unit & 3, b = bh >> 3, h = bh & 7;
    const int il = t256 >> 4, c = t256 & 15, i = 16 * quarter + il;
    float S[4] = {0.f, 0.f, 0.f, 0.f};
    const size_t base = ((size_t)b * LP + LPAD) * 512 + h * 64;
    for (int t = 0; t < L; ++t) {
        const size_t o = base + (size_t)t * 512 + 4 * c;
        float w[4], kk[4], bb[4], k[4], r[4];
#pragma unroll
        for (int j = 0; j < 4; ++j) { w[j] = __expf(-(float)EW[o + j]); kk[j] = (float)KK[o + j]; bb[j] = (float)Bv[o + j]; k[j] = (float)KM[o + j]; r[j] = (float)R[o + j]; }
        const float v = (float)VV[base + (size_t)t * 512 + i];
        float sa = 0.f;
#pragma unroll
        for (int j = 0; j < 4; ++j) sa += S[j] * kk[j];
        sa += __shfl_xor(sa, 1); sa += __shfl_xor(sa, 2); sa += __shfl_xor(sa, 4); sa += __shfl_xor(sa, 8);
        sa = -sa;
        float y = 0.f;
#pragma unroll
        for (int j = 0; j < 4; ++j) { S[j] = S[j] * w[j] + sa * bb[j] + v * k[j]; y += S[j] * r[j]; }
        y += __shfl_xor(y, 1); y += __shfl_xor(y, 2); y += __shfl_xor(y, 4); y += __shfl_xor(y, 8);
        if (c == 0) YRAW[base + (size_t)t * 512 + i] = y;
    }
}

__device__ __forceinline__ void attn_simple_unit(const Params& p, float* sm, int unit, int tid) {
    float* Qs = sm;
    float* Ks = Qs + 64 * 192;
    float* Vs = Ks + 64 * 193;
    float* Ps = Vs + 64 * 128;
    unsigned char* ws = p.ws;
    const bf16_t* Q = (const bf16_t*)(ws + O_Q); const bf16_t* Kb = (const bf16_t*)(ws + O_K); const bf16_t* V = (const bf16_t*)(ws + O_V);
    bf16_t* Y = (bf16_t*)(ws + O_Y); const float* og = p.in[19];
    const int qt = unit & 63, h = (unit >> 6) & 3, b = unit >> 8;
    const size_t rb = (size_t)b * LP;
    const int qrow0 = 64 + 64 * qt;
    __syncthreads();
    for (int i = tid; i < 64 * 192; i += 512) { const int r = i / 192, d = i % 192; Qs[i] = bf2f(Q[(rb + qrow0 + r) * 768 + h * DQK + d]); }
    const int qi = (tid & 255) >> 2, sub = tid & 3; const bool act = tid < 256;
    float m = -1e30f, l = 0.f; float o[32];
#pragma unroll
    for (int j = 0; j < 32; ++j) o[j] = 0.f;
    const int nkt = qt + 2;
    for (int kt = 0; kt < nkt; ++kt) {
        __syncthreads();
        for (int i = tid; i < 64 * 192; i += 512) { const int r = i / 192, d = i % 192; Ks[r * 193 + d] = bf2f(Kb[(rb + 64 * kt + r) * 768 + h * DQK + d]); }
        for (int i = tid; i < 64 * 128; i += 512) { const int r = i >> 7, d = i & 127; Vs[i] = bf2f(V[(rb + 64 * kt + r) * 512 + h * DV + d]); }
        __syncthreads();
        float scale = 1.f;
        if (act) {
            float sc[16]; float mx = -1e30f;
#pragma unroll
            for (int kk = 0; kk < 16; ++kk) {
                const int key = sub + 4 * kk; float s = 0.f;
                for (int d = 0; d < 192; ++d) s += Qs[qi * 192 + d] * Ks[key * 193 + d];
                const int krow = 64 * kt + key;
                if (krow < LPAD || krow > qrow0 + qi) s = -1e30f;
                sc[kk] = s; mx = fmaxf(mx, s);
            }
            mx = fmaxf(mx, __shfl_xor(mx, 1)); mx = fmaxf(mx, __shfl_xor(mx, 2));
            const float mn = fmaxf(m, mx); scale = exp2f(m - mn);
            float ps = 0.f;
#pragma unroll
            for (int kk = 0; kk < 16; ++kk) { const float pv = (sc[kk] <= -1e29f) ? 0.f : exp2f(sc[kk] - mn); Ps[qi * 65 + sub + 4 * kk] = pv; ps += pv; }
            ps += __shfl_xor(ps, 1); ps += __shfl_xor(ps, 2);
            l = l * scale + ps; m = mn;
        }
        __syncthreads();
        if (act) {
#pragma unroll
            for (int j = 0; j < 32; ++j) o[j] *= scale;
            for (int key = 0; key < 64; ++key) { const float pv = Ps[qi * 65 + key];
#pragma unroll
                for (int j = 0; j < 32; ++j) o[j] += pv * Vs[key * 128 + sub * 32 + j]; }
        }
    }
    if (act) {
        const float il = 1.f / l; float ss = 0.f;
#pragma unroll
        for (int j = 0; j < 32; ++j) { o[j] *= il; ss += o[j] * o[j]; }
        ss += __shfl_xor(ss, 1); ss += __shfl_xor(ss, 2);
        const float rs = 1.0f / sqrtf(ss * (1.f / DV) + RMS_EPS);
        const size_t yrow = (size_t)b * SEQ + 64 * qt + qi;
#pragma unroll
        for (int j = 0; j < 32; ++j) Y[yrow * DM + 512 + h * DV + sub * 32 + j] = (bf16_t)f2bf(o[j] * rs * og[h * DV + sub * 32 + j]);
    }
}

namespace scan {
#define SC_LAS __attribute__((address_space(3)))
constexpr int TS = 32, STEP_F = 5 * 64 + 16, BUF_F = TS * STEP_F, NCH = (L + TS - 1) / TS;
constexpr int SCAN_LDS = 2 * BUF_F * 4;
typedef _Float16 h8 __attribute__((ext_vector_type(8)));
typedef _Float16 h2 __attribute__((ext_vector_type(2)));
template <int CTRL> __device__ __forceinline__ float dppf(float x) { return __builtin_bit_cast(float, __builtin_amdgcn_update_dpp(0, __builtin_bit_cast(int, x), CTRL, 0xF, 0xF, true)); }
__device__ __forceinline__ float row_sum16(float x) { x += dppf<0xB1>(x); x += dppf<0x4E>(x); x += dppf<0x141>(x); x += dppf<0x140>(x); return x; }

__device__ __forceinline__ void scan_unit(const Params& p, SC_LAS float* lds, int unit) {
    unsigned char* ws = p.ws;
    const int tid = threadIdx.x, lane = tid & 63; const int wave = __builtin_amdgcn_readfirstlane(tid >> 6);
    const int bh = unit >> 2, quarter = unit & 3, b = bh >> 3, h = bh & 7;
    const size_t ebase = ((size_t)b * LP + LPAD) * 512 + h * 64;
    __syncthreads();
    if (wave >= 4) {
        const f16_t* src[5] = {(const f16_t*)(ws + O_EW), (const f16_t*)(ws + O_KK), (const f16_t*)(ws + O_B), (const f16_t*)(ws + O_KMOD), (const f16_t*)(ws + O_R)};
        const f16_t* VV = (const f16_t*)(ws + O_VV);
        const int t2 = tid - 256, tt = t2 >> 3, c8 = (t2 & 7) * 8, pr = t2 & 7;
#pragma nounroll
        for (int ch = 0; ch <= NCH; ++ch) {
            if (ch < NCH) {
                const int t = ch * TS + tt;
                if (t < L) {
                    SC_LAS float* dst = lds + (ch & 1) * BUF_F + tt * STEP_F;
                    const size_t e = ebase + (size_t)t * 512;
#pragma unroll
                    for (int a = 0; a < 5; ++a) {
                        const h8 v = *(const h8*)(src[a] + e + c8);
                        f32x4 lo, hi;
#pragma unroll
                        for (int j = 0; j < 4; ++j) { lo[j] = (float)v[j]; hi[j] = (float)v[4 + j]; }
                        if (a == 0) {
#pragma unroll
                            for (int j = 0; j < 4; ++j) { lo[j] = __expf(-lo[j]); hi[j] = __expf(-hi[j]); }
                        }
                        *(SC_LAS f32x4*)(dst + a * 64 + c8) = lo; *(SC_LAS f32x4*)(dst + a * 64 + c8 + 4) = hi;
                    }
                    const h2 vv = *(const h2*)(VV + e + 16 * quarter + 2 * pr);
                    dst[320 + 2 * pr] = (float)vv[0]; dst[320 + 2 * pr + 1] = (float)vv[1];
                }
            }
            __syncthreads();
        }
    } else {
        const int g = lane >> 4, c = lane & 15, i = 16 * quarter + 4 * wave + g;
        float* yout = p.out + ebase + i;
        typedef float f2 __attribute__((ext_vector_type(2)));
        f2 S01 = {0.f, 0.f}, S23 = {0.f, 0.f};
        __syncthreads();
#pragma nounroll
        for (int ch = 0; ch < NCH; ++ch) {
            const SC_LAS float* st = lds + (ch & 1) * BUF_F + 4 * c;
            const SC_LAS float* sv = lds + (ch & 1) * BUF_F + 320 + 4 * wave + g;
            const int n = (L - ch * TS) < TS ? (L - ch * TS) : TS;
            float* yo = yout + (size_t)(ch * TS + c) * 512;
#pragma nounroll
            for (int tb = 0; tb < n; tb += 16) {
                float ykeep = 0.f;
#pragma unroll
                for (int tt = 0; tt < 16; ++tt) {
                    const f32x4 w4 = *(const SC_LAS f32x4*)(st + tt * STEP_F), kk4 = *(const SC_LAS f32x4*)(st + tt * STEP_F + 64), b4 = *(const SC_LAS f32x4*)(st + tt * STEP_F + 128),
                                k4 = *(const SC_LAS f32x4*)(st + tt * STEP_F + 192), r4 = *(const SC_LAS f32x4*)(st + tt * STEP_F + 256);
                    const float v = sv[tt * STEP_F];
                    f2 pa = S01 * (f2){kk4[0], kk4[1]}; pa = S23 * (f2){kk4[2], kk4[3]} + pa;
                    const float sa = -row_sum16(pa.x + pa.y);
                    const f2 sa2 = {sa, sa}, v2 = {v, v};
                    f2 t01 = v2 * (f2){k4[0], k4[1]}, t23 = v2 * (f2){k4[2], k4[3]};
                    t01 = sa2 * (f2){b4[0], b4[1]} + t01; t23 = sa2 * (f2){b4[2], b4[3]} + t23;
                    S01 = S01 * (f2){w4[0], w4[1]} + t01; S23 = S23 * (f2){w4[2], w4[3]} + t23;
                    f2 py = S01 * (f2){r4[0], r4[1]}; py = S23 * (f2){r4[2], r4[3]} + py;
                    const float y = row_sum16(py.x + py.y);
                    ykeep = (c == tt) ? y : ykeep;
                }
                yo[(size_t)tb * 512] = ykeep;
                st += 16 * STEP_F; sv += 16 * STEP_F;
            }
            __syncthreads();
        }
    }
}
}

namespace att {
#define ATT_LAS __attribute__((address_space(3)))
typedef float f32x16 __attribute__((ext_vector_type(16)));
typedef short bf16x8 __attribute__((ext_vector_type(8)));
typedef short s16x4 __attribute__((ext_vector_type(4)));
typedef float f32x2_t __attribute__((ext_vector_type(2)));
typedef __bf16 bf16x2_t __attribute__((ext_vector_type(2)));
constexpr int KROW = 400, VROW = 320, KBUF = 64 * KROW, VBUF = 64 * VROW;
constexpr int L_K = 0, L_V = 2 * KBUF, L_SCR = 2 * KBUF + 2 * VBUF, ATT_LDS = L_SCR + 8 * 256;
__device__ __forceinline__ int crow(int i, int hi) { return (i & 3) + 8 * (i >> 2) + 4 * hi; }
__device__ __forceinline__ unsigned cvtpk(float lo, float hi) { f32x2_t v = {lo, hi}; bf16x2_t b = __builtin_convertvector(v, bf16x2_t); return __builtin_bit_cast(unsigned, b); }
template <int K> __device__ __forceinline__ float swz_xor(float x) { return __builtin_bit_cast(float, __builtin_amdgcn_ds_swizzle(__builtin_bit_cast(int, x), 0x1F | (K << 10))); }
__device__ __forceinline__ float x32_max(float x) { float a = x, b = x; asm volatile("s_nop 1\n\tv_permlane32_swap_b32 %0, %1" : "+v"(a), "+v"(b)); return fmaxf(a, b); }
__device__ __forceinline__ float x32_sum(float x) { float a = x, b = x; asm volatile("s_nop 1\n\tv_permlane32_swap_b32 %0, %1" : "+v"(a), "+v"(b)); return a + b; }
__device__ __forceinline__ s16x4 vtr(const ATT_LAS unsigned char* p) { return __builtin_bit_cast(s16x4, __builtin_amdgcn_ds_read_tr16_b64_v4i16((ATT_LAS s16x4*)p)); }

__device__ __forceinline__ void attn_unit(const Params& p, ATT_LAS unsigned char* lds, int b, int h, int qblk) {
    const int tid = threadIdx.x, lane = tid & 63, r32 = lane & 31, hi = lane >> 5; const int w = __builtin_amdgcn_readfirstlane(tid >> 6);
    unsigned char* ws = p.ws;
    const bf16_t* Q = (const bf16_t*)(ws + O_Q); const bf16_t* Kg = (const bf16_t*)(ws + O_K); const bf16_t* Vg = (const bf16_t*)(ws + O_V);
    const size_t rowbase = (size_t)b * LP;
    const int qrow = 64 + 256 * qblk + 32 * w + r32;
    const int NT = 4 * qblk + 5, jband = 4 * qblk + 1, jdiag = jband + (w >> 1);
    bf16x8 qf[12];
    { const bf16_t* qp = Q + (rowbase + qrow) * 768 + h * DQK + 8 * hi;
#pragma unroll
      for (int s = 0; s < 12; ++s) qf[s] = *(const bf16x8*)(qp + 16 * s); }
    const unsigned char* kbase = (const unsigned char*)(Kg + rowbase * 768 + h * DQK);
    const unsigned char* vbase = (const unsigned char*)(Vg + rowbase * 512 + h * DV);
    const unsigned sr = (unsigned)tid >> 3, sc8 = ((unsigned)tid & 7u) * 16u;
    const unsigned ko = sr * 1536u + sc8, vo = sr * 1024u + sc8, kl = (unsigned)L_K + sr * KROW + sc8, vl = (unsigned)L_V + sr * VROW + sc8;
    u32x4 sk[3], sv[2];
#define ATT_LOAD(j) do { const unsigned char* kb_ = kbase + (size_t)(j) * (64 * 768 * 2) + ko; const unsigned char* vb_ = vbase + (size_t)(j) * (64 * 512 * 2) + vo; \
                         _Pragma("unroll") for (int i_ = 0; i_ < 3; ++i_) sk[i_] = *(const u32x4*)(kb_ + 128 * i_); \
                         _Pragma("unroll") for (int i_ = 0; i_ < 2; ++i_) sv[i_] = *(const u32x4*)(vb_ + 128 * i_); } while (0)
#define ATT_WRITE(buf) do { _Pragma("unroll") for (int i_ = 0; i_ < 3; ++i_) *(ATT_LAS u32x4*)(lds + kl + (buf) * KBUF + 128 * i_) = sk[i_]; \
                            _Pragma("unroll") for (int i_ = 0; i_ < 2; ++i_) *(ATT_LAS u32x4*)(lds + vl + (buf) * VBUF + 128 * i_) = sv[i_]; } while (0)
    ATT_LAS float* scr = (ATT_LAS float*)(lds + L_SCR + w * 256);
    f32x16 o[4];
#pragma unroll
    for (int d = 0; d < 4; ++d)
#pragma unroll
        for (int i = 0; i < 16; ++i) o[d][i] = 0.f;
    float m = -1e30f, lsum = 0.f;
    const ATT_LAS unsigned char* kp0 = lds + L_K + r32 * KROW + hi * 16;
    const ATT_LAS unsigned char* vp0 = lds + L_V + (4 * hi + ((lane & 15) >> 2)) * VROW + (((lane >> 4) & 1) * 16 + (lane & 3) * 4) * 2;
    ATT_LOAD(0); ATT_WRITE(0);
    __syncthreads();
#pragma nounroll
    for (int j = 0; j < NT; ++j) {
        const int buf = j & 1;
        if (j + 1 < NT) ATT_LOAD(j + 1);
        if (j <= jdiag) {
            const ATT_LAS unsigned char* kp = kp0 + buf * KBUF;
            f32x16 p0, p1;
#pragma unroll
            for (int i = 0; i < 16; ++i) { p0[i] = 0.f; p1[i] = 0.f; }
#pragma unroll
            for (int s = 0; s < 12; ++s) {
                const bf16x8 k0 = *(const ATT_LAS bf16x8*)(kp + s * 32), k1 = *(const ATT_LAS bf16x8*)(kp + 32 * KROW + s * 32);
                p0 = __builtin_amdgcn_mfma_f32_32x32x16_bf16(k0, qf[s], p0, 0, 0, 0);
                p1 = __builtin_amdgcn_mfma_f32_32x32x16_bf16(k1, qf[s], p1, 0, 0, 0);
                if ((s & 3) == 3) __builtin_amdgcn_sched_barrier(0);
            }
            if (j == 0 || j >= jband) {
#pragma unroll
                for (int i = 0; i < 16; ++i) { const int kr = 64 * j + crow(i, hi);
                    if (kr < LPAD || kr > qrow) p0[i] = -1e30f;
                    if (kr + 32 < LPAD || kr + 32 > qrow) p1[i] = -1e30f; }
            }
            float mx = fmaxf(p0[0], p1[0]);
#pragma unroll
            for (int i = 1; i < 16; ++i) mx = fmaxf(mx, fmaxf(p0[i], p1[i]));
            mx = x32_max(mx);
            const float mn = fmaxf(m, mx);
            const bool grew = mn > m;
            const float alpha = __builtin_amdgcn_exp2f(m - mn);
            m = mn;
            float rs = 0.f;
#pragma unroll
            for (int i = 0; i < 16; ++i) { p0[i] = __builtin_amdgcn_exp2f(p0[i] - mn); p1[i] = __builtin_amdgcn_exp2f(p1[i] - mn); rs += p0[i] + p1[i]; }
            lsum = lsum * alpha + rs;
            if (__any(grew)) {
                if (hi == 0) scr[r32] = alpha;
#pragma unroll
                for (int g = 0; g < 4; ++g) { const f32x4 a4 = *(const ATT_LAS f32x4*)(scr + 8 * g + 4 * hi);
#pragma unroll
                    for (int d = 0; d < 4; ++d) { o[d][4 * g + 0] *= a4[0]; o[d][4 * g + 1] *= a4[1]; o[d][4 * g + 2] *= a4[2]; o[d][4 * g + 3] *= a4[3]; } }
            }
            u32x4 pw[4];
#pragma unroll
            for (int s = 0; s < 2; ++s) {
                pw[s] = (u32x4){cvtpk(p0[8 * s], p0[8 * s + 1]), cvtpk(p0[8 * s + 2], p0[8 * s + 3]), cvtpk(p0[8 * s + 4], p0[8 * s + 5]), cvtpk(p0[8 * s + 6], p0[8 * s + 7])};
                pw[2 + s] = (u32x4){cvtpk(p1[8 * s], p1[8 * s + 1]), cvtpk(p1[8 * s + 2], p1[8 * s + 3]), cvtpk(p1[8 * s + 4], p1[8 * s + 5]), cvtpk(p1[8 * s + 6], p1[8 * s + 7])};
            }
            const ATT_LAS unsigned char* vp = vp0 + buf * VBUF;
            __builtin_amdgcn_sched_barrier(0);
#pragma unroll
            for (int ks = 0; ks < 4; ++ks) {
                const bf16x8 pa = __builtin_bit_cast(bf16x8, pw[ks]);
#pragma unroll
                for (int d = 0; d < 4; ++d) {
                    const s16x4 lo = vtr(vp + (16 * ks) * VROW + 64 * d), hh = vtr(vp + (16 * ks + 8) * VROW + 64 * d);
                    const bf16x8 vb = (bf16x8){lo[0], lo[1], lo[2], lo[3], hh[0], hh[1], hh[2], hh[3]};
                    o[d] = __builtin_amdgcn_mfma_f32_32x32x16_bf16(pa, vb, o[d], 0, 0, 0);
                }
                __builtin_amdgcn_sched_barrier(0);
            }
        }
        if (j + 1 < NT) ATT_WRITE(buf ^ 1);
        __syncthreads();
    }
#undef ATT_LOAD
#undef ATT_WRITE
    const float ltot = x32_sum(lsum);
    if (hi == 0) scr[32 + r32] = ltot;
    const float* og = p.in[19] + h * DV;
    float gl[4];
#pragma unroll
    for (int d = 0; d < 4; ++d) gl[d] = og[32 * d + r32];
    bf16_t* Y = (bf16_t*)(ws + O_Y) + ((size_t)b * SEQ + 256 * qblk + 32 * w) * DM + 512 + h * DV + r32;
#pragma unroll
    for (int g = 0; g < 4; ++g) {
        const f32x4 l4 = *(const ATT_LAS f32x4*)(scr + 32 + 8 * g + 4 * hi);
#pragma unroll
        for (int e = 0; e < 4; ++e) {
            const int i = 4 * g + e;
            float ss = o[0][i] * o[0][i] + o[1][i] * o[1][i] + o[2][i] * o[2][i] + o[3][i] * o[3][i];
            ss += swz_xor<1>(ss); ss += swz_xor<2>(ss); ss += swz_xor<4>(ss); ss += swz_xor<8>(ss); ss += swz_xor<16>(ss);
            const float inv = 1.f / l4[e];
            const float sc = inv / sqrtf(ss * inv * inv * (1.f / DV) + RMS_EPS);
            bf16_t* yr = Y + (size_t)crow(i, hi) * DM;
#pragma unroll
            for (int d = 0; d < 4; ++d) yr[32 * d] = (bf16_t)f2bf(o[d][i] * sc * gl[d]);
        }
    }
}
}

__device__ __forceinline__ void p5_phase(const Params& p, int gw, int ngw, int lane) {
    unsigned char* ws = p.ws;
    const float* YRAW = p.out;
    const f16_t* R = (const f16_t*)(ws + O_R); const f16_t* VV = (const f16_t*)(ws + O_VV); const f16_t* KM = (const f16_t*)(ws + O_KMOD); const bf16_t* G = (const bf16_t*)(ws + O_G);
    bf16_t* Y = (bf16_t*)(ws + O_Y);
    const float* r_k = p.in[12]; const float* ln_w = p.in[13]; const float* ln_b = p.in[14];
    for (int it = gw; it < TR * RH; it += ngw) {
        const int rr = it >> 3, h = it & 7, b = rr / SEQ, s = rr % SEQ;
        const size_t idx = ((size_t)b * LP + 64 + s) * 512 + h * 64 + lane;
        const float y = YRAW[idx];
        const float mean = wave_sum(y) * (1.f / 64.f); const float d = y - mean; const float var = wave_sum(d * d) * (1.f / 64.f);
        const float r = (float)R[idx], k = (float)KM[idx], v = (float)VV[idx];
        const float bonus = wave_sum(r * k * r_k[h * 64 + lane]);
        float yo = d * (1.0f / sqrtf(var + GN_EPS)) * ln_w[h * 64 + lane] + ln_b[h * 64 + lane] + bonus * v;
        yo *= bf2f(G[idx]);
        Y[(size_t)rr * DM + h * 64 + lane] = (bf16_t)f2bf(yo);
    }
}
__device__ __forceinline__ void p9_phase(const Params& p, int gw, int ngw, int lane) {
    const float* ssq = (const float*)(p.ws + O_SSQ3); const float* g = p.in[25];
    for (int row = gw; row < TR; row += ngw) {
        const float rs = 1.0f / sqrtf(ssq[row] * (1.f / DM) + RMS_EPS);
        f32x4* o = (f32x4*)(p.out + (size_t)row * DM) + lane;
#pragma unroll
        for (int j = 0; j < 4; ++j) { const f32x4 gv = ((const f32x4*)g)[lane + 64 * j]; f32x4 v = o[64 * j]; v = v * rs * gv; o[64 * j] = v; }
    }
}

#ifndef PH_MASK
#define PH_MASK 0xFFFF
#endif
#define PH(k) ((PH_MASK >> (k)) & 1)
#ifndef PROBE_PHASE
#define PROBE_PHASE -1
#endif
#define PROBE_EXTRA 4
#define NREP(k) ((PH(k) ? 1 : 0) + ((PROBE_PHASE == (k)) ? PROBE_EXTRA : 0))
constexpr int LDS_BYTES = 153600;
constexpr int LDS_MISC = LDS_BYTES - 256;
__global__ void __launch_bounds__(512, 2) mega_fwd(Params p) {
    extern __shared__ __attribute__((aligned(16))) unsigned char lds[];
    cg::grid_group grid = cg::this_grid();
    const int tid = threadIdx.x, lane = tid & 63; const int wave = __builtin_amdgcn_readfirstlane(tid >> 6);
    const int G = gridDim.x, gw = blockIdx.x * 8 + wave, ngw = G * 8;
    unsigned char* ws = p.ws;
    PG8_LAS unsigned char* ldsg = (PG8_LAS unsigned char*)lds;
    unsigned* ctl = (unsigned*)(ws + O_CTL);
    for (int rep_ = 0; rep_ < NREP(0); ++rep_) p0_phase(p, (float*)lds, gw, ngw, lane, wave);
    if (blockIdx.x == 0 && tid < 64) ctl[tid] = 0u;
    grid.sync();
    for (int rep_ = 0; rep_ < NREP(1); ++rep_) { pg8::Gemm g{(const bf16_t*)(ws + O_U1), (const bf16_t*)(ws + O_WIN), DM, DM, DM}; pg8::StaticOrder S; S.init(TP, NINP, G, blockIdx.x);
      pg8::Epi8<FP> E{FP{(bf16_t*)(ws + O_P)}}; pg8::gemm_phase<pg8::Epi8<FP>, true>(ldsg, g, S, E); }
    grid.sync();
    for (int rep_ = 0; rep_ < NREP(2); ++rep_) for (int row = gw; row < TP; row += ngw) p2_row(p, row, lane);
    grid.sync();
    for (int rep_ = 0; rep_ < NREP(3); ++rep_) { pg8::Gemm g{(const bf16_t*)(ws + O_CQKV), (const bf16_t*)(ws + O_WUQ), 640, QL, QL}; pg8::StaticOrder S; S.init(TP, 768, G, blockIdx.x);
      pg8::Epi8<FQ> E{FQ{(bf16_t*)(ws + O_Q), (const float*)(ws + O_RSTDQ), (const float*)(ws + O_ROPE)}}; pg8::gemm_phase<pg8::Epi8<FQ>, true>(ldsg, g, S, E); }
    for (int rep_ = 0; rep_ < NREP(4); ++rep_) { pg8::Gemm g{(const bf16_t*)(ws + O_CQKV) + 384, (const bf16_t*)(ws + O_WUKV), 640, KVL, KVL}; pg8::StaticOrder S; S.init(TP, 1024, G, blockIdx.x);
      pg8::Epi8<FKV> E{FKV{(bf16_t*)(ws + O_K), (bf16_t*)(ws + O_V), (const float*)(ws + O_RSTDKV)}}; pg8::gemm_phase<pg8::Epi8<FKV>, true>(ldsg, g, S, E); }
    if (PH(5)) { pg8::Gemm g{(const bf16_t*)(ws + O_LIN), (const bf16_t*)(ws + O_LWA), 384, 256, 256}; pg8::StaticOrder S; S.init(TP, 1024, G, blockIdx.x);
      pg8::Epi8<FLwa> E{FLwa{(f16_t*)(ws + O_EW), (f16_t*)(ws + O_KMOD), (const f16_t*)(ws + O_KK), (f16_t*)(ws + O_B), p.in[5], p.in[7], p.in[11]}}; pg8::gemm_phase<pg8::Epi8<FLwa>, true>(ldsg, g, S, E); }
    for (int rep_ = 0; rep_ < NREP(6); ++rep_) { pg8::Gemm g{(const bf16_t*)(ws + O_LIN) + 128, (const bf16_t*)(ws + O_LG), 384, 256, 256}; pg8::StaticOrder S; S.init(TP, 512, G, blockIdx.x);
      pg8::Epi8<FG> E{FG{(bf16_t*)(ws + O_G)}}; pg8::gemm_phase<pg8::Epi8<FG>, true>(ldsg, g, S, E); }
    grid.sync();
    for (int rep_ = 0; rep_ < NREP(7); ++rep_) for (int u = blockIdx.x; u < NB * RH * 4; u += G) scan::scan_unit(p, (SC_LAS float*)lds, u);
    for (int rep_ = 0; rep_ < NREP(8); ++rep_) {
        const int vcu = (G % 8 == 0) ? (int)(blockIdx.x % 8) * (G / 8) + (int)(blockIdx.x / 8) : (int)blockIdx.x;
        for (int pr = vcu; pr < NB * NH * 8; pr += G) {
            const int bh = pr >> 3, q0 = pr & 7;
#pragma nounroll
            for (int u2 = 0; u2 < 2; ++u2) att::attn_unit(p, ldsg, bh >> 2, bh & 3, u2 ? q0 : 15 - q0);
        }
    }
    grid.sync();
    for (int rep_ = 0; rep_ < NREP(9); ++rep_) p5_phase(p, gw, ngw, lane);
    grid.sync();
    if (PH(10)) { pg8::Gemm g{(const bf16_t*)(ws + O_Y), (const bf16_t*)(ws + O_WOUT), DM, DM, DM}; pg8::StaticOrder S; S.init(TR, DM, G, blockIdx.x);
      pg8::Epi8<FOut> E{FOut{p.in[0], p.out, (bf16_t*)(ws + O_H2B), (float*)(ws + O_SSQ2)}}; pg8::gemm_phase<pg8::Epi8<FOut>, true>(ldsg, g, S, E); }
    grid.sync();
    for (int rep_ = 0; rep_ < NREP(11); ++rep_) { pg8::Gemm g{(const bf16_t*)(ws + O_H2B), (const bf16_t*)(ws + O_WGU), DM, DM, DM}; pg8::StaticOrder S; S.init(TR, 2 * DFF, G, blockIdx.x);
      pg8::Epi8<FAct> E{FAct{(bf16_t*)(ws + O_ACT), (const float*)(ws + O_SSQ2)}}; pg8::gemm_phase<pg8::Epi8<FAct>, true>(ldsg, g, S, E); }
    grid.sync();
    if (PH(12)) { pg8::Gemm g{(const bf16_t*)(ws + O_ACT), (const bf16_t*)(ws + O_WDN), DFF, DFF, DFF}; pg8::StaticOrder S; S.init(TR, DM, G, blockIdx.x);
      pg8::Epi8<FDown> E{FDown{p.out, (float*)(ws + O_SSQ3)}}; pg8::gemm_phase<pg8::Epi8<FDown>, true>(ldsg, g, S, E); }
    grid.sync();
    if (PH(13)) p9_phase(p, gw, ngw, lane);
}

extern "C" void kernel_launch(void* const* d_in, const int* in_sizes, int n_in, void* d_out, int out_size, void* d_ws, size_t ws_size, hipStream_t stream) {
    static int grid_blocks = 0;
    if (grid_blocks == 0) {
        if (n_in != 26 || out_size != TR * DM || ws_size < 512 * MiB) { fprintf(stderr, "kernel_launch: unexpected sizes n_in=%d out=%d ws=%zu\n", n_in, out_size, ws_size); grid_blocks = -1; return; }
        int dev = 0, cus = 0, per_cu = 0;
        (void)hipGetDevice(&dev); (void)hipDeviceGetAttribute(&cus, hipDeviceAttributeMultiprocessorCount, dev);
        (void)hipFuncSetAttribute((const void*)mega_fwd, hipFuncAttributeMaxDynamicSharedMemorySize, LDS_BYTES);
        (void)hipOccupancyMaxActiveBlocksPerMultiprocessor(&per_cu, (const void*)mega_fwd, 512, LDS_BYTES);
        if (per_cu < 1) { fprintf(stderr, "kernel_launch: occupancy query says %d blocks per CU\n", per_cu); per_cu = 1; }
        if (per_cu > 1) per_cu = 1;
        grid_blocks = cus * per_cu;
    }
    if (grid_blocks < 0) return;
    Params p{};
    for (int i = 0; i < 26; ++i) p.in[i] = (const float*)d_in[i];
    p.out = (float*)d_out; p.ws = (unsigned char*)d_ws;
    void* args[] = {&p};
    hipError_t e = hipLaunchCooperativeKernel((const void*)mega_fwd, dim3(grid_blocks), dim3(512), args, LDS_BYTES, stream);
    if (e != hipSuccess) fprintf(stderr, "cooperative launch failed: %s (grid %d)\n", hipGetErrorString(e), grid_blocks);
}
```

```cpp
#include <hip/hip_runtime.h>
#include <hip/hip_cooperative_groups.h>
namespace cg = cooperative_groups;
#include <cstdio>
#include <cstdint>

typedef unsigned short bf16_t;
typedef _Float16 f16_t;
typedef float f32x4 __attribute__((ext_vector_type(4)));
typedef unsigned u32x4 __attribute__((ext_vector_type(4)));
typedef unsigned u32x2 __attribute__((ext_vector_type(2)));

constexpr int NB = 8, SEQ = 4096, DM = 1024, NMETA = 16, L = SEQ + NMETA;
constexpr int LPAD = 48, LP = L + LPAD;
constexpr int TP = NB * LP;
constexpr int TR = NB * SEQ;
constexpr int NIN = 2528, NINP = 2560, RW = 512, RCOLS = 1824;
constexpr int QL = 384, KVL = 256, DQK = 192, DV = 128, NH = 4, RH = 8, RN = 64;
constexpr int DFF = 2816;
constexpr float RMS_EPS = 1e-6f, GN_EPS = 64e-5f;
constexpr float QSCALE = 0.07216878364870323f * 1.4426950408889634f;

constexpr size_t MiB = 1u << 20;
constexpr size_t al256(size_t x) { return (x + 255) & ~(size_t)255; }
constexpr size_t O_WIN = 0;
constexpr size_t O_WUQ = O_WIN + al256((size_t)NINP * DM * 2);
constexpr size_t O_WUKV = O_WUQ + al256((size_t)768 * QL * 2);
constexpr size_t O_LWA = O_WUKV + al256((size_t)1024 * KVL * 2);
constexpr size_t O_LG = O_LWA + al256((size_t)1024 * 256 * 2);
constexpr size_t O_WOUT = O_LG + al256((size_t)512 * 256 * 2);
constexpr size_t O_WGU = O_WOUT + al256((size_t)DM * DM * 2);
constexpr size_t O_WDN = O_WGU + al256((size_t)2 * DFF * DM * 2);
constexpr size_t O_ROPE = O_WDN + al256((size_t)DM * DFF * 2);
constexpr size_t O_RSTDQ = O_ROPE + al256((size_t)L * 32 * 8);
constexpr size_t O_RSTDKV = O_RSTDQ + al256((size_t)TP * 4);
constexpr size_t O_SSQ2 = O_RSTDKV + al256((size_t)TP * 4);
constexpr size_t O_SSQ3 = O_SSQ2 + al256((size_t)TR * 4);
constexpr size_t O_CTL = O_SSQ3 + al256((size_t)TR * 4);
constexpr size_t O_WEND = O_CTL + 65536;
static_assert(O_WEND <= 32 * MiB, "weight region");
constexpr size_t ROWB = (size_t)TP * 512 * 2;
constexpr size_t O_P = 32 * MiB;
constexpr size_t O_Q = O_P;
constexpr size_t O_V = O_Q + al256((size_t)TP * 768 * 2);
constexpr size_t O_EW = O_V + ROWB;
constexpr size_t O_B = O_EW + ROWB;
static_assert(O_B + ROWB <= O_P + al256((size_t)TP * NIN * 2), "aliases inside P");
constexpr size_t O_U1 = 193 * MiB;
constexpr size_t O_R = O_U1;
constexpr size_t O_VV = O_R + ROWB;
static_assert(O_P + al256((size_t)TP * NIN * 2) <= O_U1 && O_VV + ROWB <= 258 * MiB, "U1 region");
constexpr size_t O_KK = 258 * MiB;
constexpr size_t O_KMOD = O_KK + ROWB;
constexpr size_t O_LIN = O_KMOD + ROWB;
constexpr size_t O_CQKV = O_LIN + al256((size_t)TP * 384 * 2);
constexpr size_t O_K = O_CQKV + al256((size_t)TP * 640 * 2);
constexpr size_t O_G = O_K + al256((size_t)TP * 768 * 2);
constexpr size_t O_END1 = O_G + ROWB;
static_assert(O_END1 <= 512 * MiB, "ws");
constexpr size_t O_Y = O_LIN;
static_assert(O_Y + (size_t)TR * DM * 2 <= O_K, "Y alias");
constexpr size_t O_H2B = O_P;
constexpr size_t O_ACT = O_P + 64 * MiB;
static_assert(O_ACT + (size_t)TR * DFF * 2 <= O_Y, "ACT alias");
static_assert((size_t)TP * 512 * 4 <= (size_t)TR * DM * 4, "YRAW in d_out");

struct Params {
    const float* in[26];
    float* out;
    unsigned char* ws;
};

__device__ __forceinline__ unsigned f2bf(float f) { unsigned u = __builtin_bit_cast(unsigned, f); return (u + 0x7fffu + ((u >> 16) & 1u)) >> 16; }
__device__ __forceinline__ float bf2f(unsigned h) { return __builtin_bit_cast(float, h << 16); }
__device__ __forceinline__ unsigned pk2(float lo, float hi) { return f2bf(lo) | (f2bf(hi) << 16); }
__device__ __forceinline__ float wave_sum(float v) {
#pragma unroll
    for (int o = 1; o < 64; o <<= 1) v += __shfl_xor(v, o);
    return v;
}
__device__ __forceinline__ float sigmoidf_(float x) { return 1.f / (1.f + __expf(-x)); }
__device__ __forceinline__ int row_pos(int row) { int p = row % LP - LPAD; return p < 0 ? 0 : p; }

__constant__ double c_inv_freq[32] = {
    1.0, 0.7498942093324559, 0.5623413251903491, 0.4216965034285822, 0.31622776601683794, 0.23713737056616552, 0.1778279410038923, 0.1333521432163324,
    0.1, 0.07498942093324558, 0.05623413251903491, 0.04216965034285822, 0.03162277660168379, 0.023713737056616554, 0.01778279410038923, 0.01333521432163324,
    0.01, 0.007498942093324559, 0.005623413251903491, 0.004216965034285823, 0.0031622776601683794, 0.0023713737056616554, 0.0017782794100389228, 0.001333521432163324,
    0.001, 0.0007498942093324559, 0.0005623413251903491, 0.0004216965034285822, 0.00031622776601683794, 0.00023713737056616554, 0.00017782794100389227, 0.0001333521432163324};

__device__ __forceinline__ void sincos_d(double a, float& s, float& c) {
    const double q = __builtin_rint(a * 0.6366197723675814);
    double r = __builtin_fma(-q, 1.5707963267948966, a);
    r = __builtin_fma(-q, 6.123233995736766e-17, r);
    const double r2 = r * r;
    double sp = -1.0 / 1307674368000.0;
    sp = sp * r2 + 1.0 / 6227020800.0; sp = sp * r2 - 1.0 / 39916800.0; sp = sp * r2 + 1.0 / 362880.0; sp = sp * r2 - 1.0 / 5040.0; sp = sp * r2 + 1.0 / 120.0; sp = sp * r2 - 1.0 / 6.0;
    const double sn = r + r * r2 * sp;
    double cp = 1.0 / 87178291200.0;
    cp = cp * r2 - 1.0 / 479001600.0; cp = cp * r2 + 1.0 / 3628800.0; cp = cp * r2 - 1.0 / 40320.0; cp = cp * r2 + 1.0 / 720.0; cp = cp * r2 - 1.0 / 24.0; cp = cp * r2 + 0.5;
    const double cs = 1.0 - r2 * cp;
    const int qi = ((int)q) & 3;
    const double ss = (qi == 0) ? sn : (qi == 1) ? cs : (qi == 2) ? -sn : -cs;
    const double cc = (qi == 0) ? cs : (qi == 1) ? -sn : (qi == 2) ? -cs : sn;
    s = (float)ss; c = (float)cc;
}

struct SrcWin { const float* w; __device__ float operator()(int k, int n) const {
        if (n >= NIN) return 0.f; int ns = n;
        if (n >= 2464) { const int j = n - 2464; ns = 2464 + (j >> 1) + 32 * (j & 1); }
        return w[(size_t)k * NIN + ns]; } };
struct SrcWuq { const float* w; const float* g; __device__ float operator()(int k, int n) const {
        const int h = n / DQK, c = n % DQK; int cs = c; if (c >= 128) { const int j = c - 128; cs = 128 + (j >> 1) + 32 * (j & 1); }
        return w[(size_t)k * 768 + h * DQK + cs] * g[k]; } };
struct SrcWukv { const float* w; const float* g; __device__ float operator()(int k, int n) const { return w[(size_t)k * 1024 + n] * g[k]; } };
struct SrcLwa { const float* w2; const float* a2; __device__ float operator()(int k, int n) const {
        if (n < 512) return k < 64 ? w2[(size_t)k * 512 + n] : 0.f;
        return (k >= 64 && k < 128) ? a2[(size_t)(k - 64) * 512 + (n - 512)] : 0.f; } };
struct SrcLg { const float* g2; __device__ float operator()(int k, int n) const { return k < 160 ? g2[(size_t)k * 512 + n] : 0.f; } };
struct SrcWout { const float* w; __device__ float operator()(int k, int n) const { return w[(size_t)k * DM + n]; } };
struct SrcWgu { const float* wg; const float* wu; const float* g; __device__ float operator()(int k, int n) const {
        const int j = n >> 8, c = n & 255; const float v = c < 128 ? wg[(size_t)k * DFF + 128 * j + c] : wu[(size_t)k * DFF + 128 * j + (c - 128)];
        return v * g[k]; } };
struct SrcWdn { const float* w; __device__ float operator()(int k, int n) const { return w[(size_t)k * DM + n]; } };

template <class F>
__device__ __forceinline__ void wconv_item(const F& f, bf16_t* WT, int K, int nblk, int item, float* scr, int lane) {
    const int kb = item / nblk, nb = item % nblk, k0 = 64 * kb, n0 = 32 * nb;
#pragma unroll 8
    for (int i = 0; i < 32; ++i) { const int kk = 2 * i + (lane >> 5); scr[kk * 33 + (lane & 31)] = f(k0 + kk, n0 + (lane & 31)); }
    asm volatile("s_waitcnt lgkmcnt(0)" ::: "memory");
    const int c = lane & 7;
#pragma unroll
    for (int j = 0; j < 4; ++j) { const int n = (lane >> 3) + 8 * j; const float* s = scr + (8 * c) * 33 + n;
        u32x4 o; o.x = pk2(s[0 * 33], s[1 * 33]); o.y = pk2(s[2 * 33], s[3 * 33]); o.z = pk2(s[4 * 33], s[5 * 33]); o.w = pk2(s[6 * 33], s[7 * 33]);
        *(u32x4*)(WT + (size_t)(n0 + n) * K + k0 + 8 * c) = o; }
    asm volatile("s_waitcnt lgkmcnt(0)" ::: "memory");
}

__device__ __forceinline__ void p0_phase(const Params& p, float* scr_all, int gw, int ngw, int lane, int wave_in_block) {
    float* scr = scr_all + wave_in_block * (64 * 33);
    unsigned char* ws = p.ws;
    constexpr int I0 = (DM / 64) * (NINP / 32), I1 = (QL / 64) * (768 / 32), I2 = (KVL / 64) * (1024 / 32), I3 = (256 / 64) * (1024 / 32), I4 = (256 / 64) * (512 / 32),
                  I5 = (DM / 64) * (DM / 32), I6 = (DM / 64) * (2 * DFF / 32), I7 = (DFF / 64) * (DM / 32);
    constexpr int NIT = I0 + I1 + I2 + I3 + I4 + I5 + I6 + I7;
    for (int it = gw; it < NIT; it += ngw) {
        int r = it;
        if (r < I0) { wconv_item(SrcWin{p.in[3]}, (bf16_t*)(ws + O_WIN), DM, NINP / 32, r, scr, lane); continue; } r -= I0;
        if (r < I1) { wconv_item(SrcWuq{p.in[16], p.in[15]}, (bf16_t*)(ws + O_WUQ), QL, 768 / 32, r, scr, lane); continue; } r -= I1;
        if (r < I2) { wconv_item(SrcWukv{p.in[18], p.in[17]}, (bf16_t*)(ws + O_WUKV), KVL, 1024 / 32, r, scr, lane); continue; } r -= I2;
        if (r < I3) { wconv_item(SrcLwa{p.in[6], p.in[8]}, (bf16_t*)(ws + O_LWA), 256, 1024 / 32, r, scr, lane); continue; } r -= I3;
        if (r < I4) { wconv_item(SrcLg{p.in[9]}, (bf16_t*)(ws + O_LG), 256, 512 / 32, r, scr, lane); continue; } r -= I4;
        if (r < I5) { wconv_item(SrcWout{p.in[20]}, (bf16_t*)(ws + O_WOUT), DM, DM / 32, r, scr, lane); continue; } r -= I5;
        if (r < I6) { wconv_item(SrcWgu{p.in[22], p.in[23], p.in[21]}, (bf16_t*)(ws + O_WGU), DM, 2 * DFF / 32, r, scr, lane); continue; } r -= I6;
        wconv_item(SrcWdn{p.in[24]}, (bf16_t*)(ws + O_WDN), DFF, DM / 32, r, scr, lane);
    }
    const float* x = p.in[0]; const float* meta = p.in[1]; const float* g1 = p.in[2];
    bf16_t* U1 = (bf16_t*)(ws + O_U1);
    for (int row = gw; row < TP; row += ngw) {
        const int b = row / LP, pr = row % LP - LPAD;
        u32x2* o = (u32x2*)(U1 + (size_t)row * DM) + lane;
        if (pr < 0) {
#pragma unroll
            for (int j = 0; j < 4; ++j) o[64 * j] = (u32x2){0u, 0u};
            continue;
        }
        const float* src = pr < NMETA ? meta + (size_t)pr * DM : x + ((size_t)b * SEQ + (pr - NMETA)) * DM;
        const f32x4* xr = (const f32x4*)src + lane;
        f32x4 v[4]; float s = 0.f;
#pragma unroll
        for (int j = 0; j < 4; ++j) { v[j] = xr[64 * j]; s += (v[j].x * v[j].x + v[j].y * v[j].y) + (v[j].z * v[j].z + v[j].w * v[j].w); }
        const float rstd = 1.0f / sqrtf(wave_sum(s) * (1.f / DM) + RMS_EPS);
#pragma unroll
        for (int j = 0; j < 4; ++j) { const f32x4 g = ((const f32x4*)g1)[lane + 64 * j];
            o[64 * j] = (u32x2){pk2(v[j].x * rstd * g.x, v[j].y * rstd * g.y), pk2(v[j].z * rstd * g.z, v[j].w * rstd * g.w)}; }
    }
    float* rope = (float*)(ws + O_ROPE);
    for (int i = gw * 64 + lane; i < L * 32; i += ngw * 64) {
        const int pos = i >> 5, f = i & 31; float s, c; sincos_d((double)pos * c_inv_freq[f], s, c);
        rope[2 * i] = c; rope[2 * i + 1] = s;
    }
    float* ssq = (float*)(ws + O_SSQ2);
    for (int i = gw * 64 + lane; i < (int)((O_CTL - O_SSQ2) / 4); i += ngw * 64) ssq[i] = 0.f;
}

__device__ __forceinline__ void p2_row(const Params& p, int row, int lane) {
    unsigned char* ws = p.ws;
    const bf16_t* P = (const bf16_t*)(ws + O_P);
    const bf16_t* cur = P + (size_t)row * NIN; const bf16_t* prv = cur - NIN;
    const bool has_prev = row > 0;
    const float* mu = p.in[4]; const float* k_k = p.in[10];
    f16_t* R = (f16_t*)(ws + O_R); f16_t* VV = (f16_t*)(ws + O_VV); f16_t* KK = (f16_t*)(ws + O_KK); f16_t* KM = (f16_t*)(ws + O_KMOD);
    bf16_t* LIN = (bf16_t*)(ws + O_LIN); bf16_t* CQKV = (bf16_t*)(ws + O_CQKV); bf16_t* Kb = (bf16_t*)(ws + O_K);
    float ssq_q = 0.f, ssq_kv = 0.f;
    for (int ch = lane; ch < 320; ch += 64) {
        const bool act = ch < 316; const int c0 = 8 * ch;
        float v[8];
        {
            u32x4 a = (u32x4){0u, 0u, 0u, 0u};
            if (act) a = *(const u32x4*)(cur + c0);
            v[0] = bf2f(a.x & 0xffffu); v[1] = bf2f(a.x >> 16); v[2] = bf2f(a.y & 0xffffu); v[3] = bf2f(a.y >> 16);
            v[4] = bf2f(a.z & 0xffffu); v[5] = bf2f(a.z >> 16); v[6] = bf2f(a.w & 0xffffu); v[7] = bf2f(a.w >> 16);
        }
        if (c0 < RCOLS) {
            u32x4 b = (u32x4){0u, 0u, 0u, 0u};
            if (act && has_prev) b = *(const u32x4*)(prv + c0);
            float q[8];
            q[0] = bf2f(b.x & 0xffffu); q[1] = bf2f(b.x >> 16); q[2] = bf2f(b.y & 0xffffu); q[3] = bf2f(b.y >> 16);
            q[4] = bf2f(b.z & 0xffffu); q[5] = bf2f(b.z >> 16); q[6] = bf2f(b.w & 0xffffu); q[7] = bf2f(b.w >> 16);
#pragma unroll
            for (int j = 0; j < 8; ++j) v[j] = v[j] + (q[j] - v[j]) * mu[c0 + j];
        }
        const bool isk = (c0 >= 512 && c0 < 1024);
        float ss = 0.f; float kkv[8];
        if (isk) {
#pragma unroll
            for (int j = 0; j < 8; ++j) { kkv[j] = v[j] * k_k[c0 - 512 + j]; ss += kkv[j] * kkv[j]; }
        }
        ss += __shfl_xor(ss, 1); ss += __shfl_xor(ss, 2); ss += __shfl_xor(ss, 4);
        if (!act) continue;
        if (c0 < 512) {
#pragma unroll
            for (int j = 0; j < 8; ++j) R[(size_t)row * 512 + c0 + j] = (f16_t)v[j];
        } else if (c0 < 1024) {
            const float inv = 1.f / fmaxf(sqrtf(ss), 1e-12f);
#pragma unroll
            for (int j = 0; j < 8; ++j) { KM[(size_t)row * 512 + c0 - 512 + j] = (f16_t)v[j]; KK[(size_t)row * 512 + c0 - 512 + j] = (f16_t)(kkv[j] * inv); }
        } else if (c0 < 1536) {
#pragma unroll
            for (int j = 0; j < 8; ++j) VV[(size_t)row * 512 + c0 - 1024 + j] = (f16_t)v[j];
        } else if (c0 < 1600) {
#pragma unroll
            for (int j = 0; j < 8; ++j) LIN[(size_t)row * 384 + c0 - 1536 + j] = (bf16_t)f2bf(tanhf(v[j]));
        } else if (c0 < 1664) {
#pragma unroll
            for (int j = 0; j < 8; ++j) LIN[(size_t)row * 384 + c0 - 1536 + j] = (bf16_t)f2bf(v[j]);
        } else if (c0 < 1824) {
#pragma unroll
            for (int j = 0; j < 8; ++j) LIN[(size_t)row * 384 + c0 - 1536 + j] = (bf16_t)f2bf(sigmoidf_(v[j]));
        } else if (c0 < 2208) {
#pragma unroll
            for (int j = 0; j < 8; ++j) { CQKV[(size_t)row * 640 + c0 - 1824 + j] = (bf16_t)f2bf(v[j]); ssq_q += v[j] * v[j]; }
        } else if (c0 < 2464) {
#pragma unroll
            for (int j = 0; j < 8; ++j) { CQKV[(size_t)row * 640 + c0 - 1824 + j] = (bf16_t)f2bf(v[j]); ssq_kv += v[j] * v[j]; }
        } else {
            const float* t = (const float*)(ws + O_ROPE) + ((size_t)row_pos(row) * 32 + ((c0 - 2464) >> 1)) * 2;
            float o[8];
#pragma unroll
            for (int j = 0; j < 4; ++j) { const float cs = t[2 * j], sn = t[2 * j + 1]; o[2 * j] = v[2 * j] * cs - v[2 * j + 1] * sn; o[2 * j + 1] = v[2 * j + 1] * cs + v[2 * j] * sn; }
            u32x4 w; w.x = pk2(o[0], o[1]); w.y = pk2(o[2], o[3]); w.z = pk2(o[4], o[5]); w.w = pk2(o[6], o[7]);
#pragma unroll
            for (int h = 0; h < NH; ++h) *(u32x4*)(Kb + (size_t)row * 768 + h * DQK + 128 + (c0 - 2464)) = w;
        }
    }
    if (lane < 12) *(u32x4*)(LIN + (size_t)row * 384 + 288 + 8 * lane) = (u32x4){0u, 0u, 0u, 0u};
    ssq_q = wave_sum(ssq_q); ssq_kv = wave_sum(ssq_kv);
    if (lane == 0) { ((float*)(ws + O_RSTDQ))[row] = 1.0f / sqrtf(ssq_q * (1.f / QL) + RMS_EPS); ((float*)(ws + O_RSTDKV))[row] = 1.0f / sqrtf(ssq_kv * (1.f / KVL) + RMS_EPS); }
}
namespace pg8 {
#define PG8_LAS __attribute__((address_space(3)))
typedef short bf16x8 __attribute__((ext_vector_type(8)));
constexpr int BM = 256, BK = 64, HALF = 128, HTB = HALF * BK * 2, STAGE_BYTES = 8 * HTB, NXCD = 8, WGM = 8;
__host__ __device__ __forceinline__ int lds_byte(int r, int c) { const int st = (r >> 4) * 2 + (c >> 5), rr = r & 15, cc = c & 31, ob = rr * 64 + cc * 2; return st * 1024 + (ob ^ (((ob >> 9) & 1) << 5)); }
__host__ __device__ __forceinline__ void stage_rc(int b, int& R, int& C) { const int st = b / 1024, sb = b % 1024, swz = sb ^ (((sb >> 9) & 1) << 5); R = (st >> 1) * 16 + swz / 64; C = (st & 1) * 32 + (swz % 64) / 2; }
__host__ __device__ __forceinline__ int perm32(int rho) { const int n = rho >> 4, i = rho & 15; return 8 * (i >> 2) + 4 * n + (i & 3); }
struct Unit { int pm, pn; };
struct Gemm { const bf16_t* A; const bf16_t* Bt; int lda, ldb, K; };
struct StaticOrder {
    int nM, nN, nwg, G, c;
    __host__ __device__ void init(int M, int N, int G_, int c_) { nM = M / BM; nN = N / BM; nwg = nM * nN; G = G_; c = c_; }
    __host__ __device__ bool next(int i, Unit& u) const {
        const long L = (long)i * G + c; if (L >= nwg) return false;
        int wgid = (int)L; { const int q = nwg / NXCD, r = nwg % NXCD, xcd = wgid % NXCD, off = wgid / NXCD; wgid = (xcd < r ? xcd * (q + 1) : r * (q + 1) + (xcd - r) * q) + off; }
        const int nig = WGM * nN, gid = wgid / nig, fm = gid * WGM, gsz = (nM - fm) < WGM ? (nM - fm) : WGM;
        u.pm = fm + ((wgid % nig) % gsz); u.pn = (wgid % nig) / gsz; return true;
    }
};
template <class F> struct Epi8 {
    F f;
    __device__ __forceinline__ void operator()(const f32x4 (&acc)[2][2][4][2], const Unit& u, int wr, int wc, int fr, int fq) const {
        const int col = u.pn * BM + wc * 32 + 8 * fq;
#pragma unroll
        for (int ai = 0; ai < 2; ++ai)
#pragma unroll
            for (int m = 0; m < 4; ++m) f(u.pm * BM + ai * HALF + wr * 64 + m * 16 + fr, col, acc[ai][0][m][0], acc[ai][0][m][1], acc[ai][1][m][0], acc[ai][1][m][1]);
    }
};

template <class Epi, bool ALIGN_EPI>
__device__ __forceinline__ void gemm_phase(PG8_LAS unsigned char* lds, const Gemm g, const StaticOrder& S, const Epi& E) {
    const int tid = threadIdx.x, wid = __builtin_amdgcn_readfirstlane(tid >> 6), lane = tid & 63, wr = wid >> 2, wc = wid & 3, fr = lane & 15, fq = lane >> 4;
    const int K = g.K, nt = K / BK;
    unsigned voffA[2], voffB[2];
#pragma unroll
    for (int i = 0; i < 2; ++i) { int R, C; stage_rc(tid * 16 + i * 8192, R, C); const int Rb = (R & ~31) + perm32(R & 31);
        voffA[i] = (unsigned)(R * g.lda + C) * 2u; voffB[i] = (unsigned)(Rb * g.ldb + C) * 2u; }
    const size_t kstep = (size_t)(BK * 2);
    const size_t hstepA = (size_t)HALF * g.lda * 2, hstepB = (size_t)HALF * g.ldb * 2;
    const size_t tstepA = 2 * hstepA, tstepB = 2 * hstepB;
    const unsigned ldsw = (unsigned)wid * 1024u;
    const int aoff = lds_byte(wr * 64 + fr, fq * 8), boff = lds_byte(wc * 32 + fr, fq * 8);
#define PG8_SA(b, h) (((b) * 2 + (h)) * HTB)
#define PG8_SB(b, h) ((4 + (b) * 2 + (h)) * HTB)
#define PG8_STAGE(bufoff, gbase, voff) do { _Pragma("unroll") for (int _i = 0; _i < 2; ++_i) \
        __builtin_amdgcn_global_load_lds((const unsigned*)((const char*)(gbase) + (voff)[_i]), (PG8_LAS unsigned*)(lds + (bufoff) + ldsw + _i * 8192), 16, 0, 0); } while (0)
#define PG8_LDA(dst, b, h) do { _Pragma("unroll") for (int m = 0; m < 4; ++m) _Pragma("unroll") for (int k = 0; k < 2; ++k) dst[m][k] = *(const PG8_LAS bf16x8*)(lds + PG8_SA(b, h) + aoff + m * 2048 + k * 1024); } while (0)
#define PG8_LDB(dst, b, h) do { _Pragma("unroll") for (int n = 0; n < 2; ++n) _Pragma("unroll") for (int k = 0; k < 2; ++k) dst[n][k] = *(const PG8_LAS bf16x8*)(lds + PG8_SB(b, h) + boff + n * 2048 + k * 1024); } while (0)
#define PG8_MMA(ai, bj, At, Bt) do { __builtin_amdgcn_s_setprio(1); _Pragma("unroll") for (int m = 0; m < 4; ++m) _Pragma("unroll") for (int n = 0; n < 2; ++n) _Pragma("unroll") for (int k = 0; k < 2; ++k) \
        acc[ai][bj][m][n] = __builtin_amdgcn_mfma_f32_16x16x32_bf16(Bt[n][k], At[m][k], acc[ai][bj][m][n], 0, 0, 0); __builtin_amdgcn_s_setprio(0); } while (0)
#define PG8_WAIT_V(n) asm volatile("s_waitcnt vmcnt(" #n ")" ::: "memory")
#define PG8_WAIT_L(n) asm volatile("s_waitcnt lgkmcnt(" #n ")" ::: "memory")
#define PG8_BAR __builtin_amdgcn_s_barrier()
#define PG8_SCHED __builtin_amdgcn_sched_barrier(0)
    Unit cur, nxt; int ui = 0;
    if (!S.next(0, cur)) return;
    f32x4 acc[2][2][4][2];
#pragma unroll
    for (int a = 0; a < 2; ++a)
#pragma unroll
        for (int b = 0; b < 2; ++b)
#pragma unroll
            for (int m = 0; m < 4; ++m)
#pragma unroll
                for (int n = 0; n < 2; ++n) acc[a][b][m][n] = (f32x4){0.f, 0.f, 0.f, 0.f};
    bf16x8 At[4][2], B0[2][2], B1[2][2];
    const char* cA = (const char*)g.A + (size_t)cur.pm * tstepA; const char* cB = (const char*)g.Bt + (size_t)cur.pn * tstepB;
    PG8_STAGE(PG8_SB(0, 0), cB, voffB); PG8_STAGE(PG8_SB(0, 1), cB + hstepB, voffB); PG8_STAGE(PG8_SA(0, 0), cA, voffA); PG8_STAGE(PG8_SA(0, 1), cA + hstepA, voffA);
    if (wr == 1) PG8_BAR;
    PG8_WAIT_V(2); PG8_BAR;
    PG8_STAGE(PG8_SB(1, 0), cB + kstep, voffB); PG8_STAGE(PG8_SA(1, 0), cA + kstep, voffA); PG8_STAGE(PG8_SB(1, 1), cB + hstepB + kstep, voffB);
    PG8_WAIT_V(6); PG8_BAR;
#pragma nounroll
    for (;;) {
        const bool has_next = S.next(ui + 1, nxt);
        const char* nA = has_next ? (const char*)g.A + (size_t)nxt.pm * tstepA : cA; const char* nB = has_next ? (const char*)g.Bt + (size_t)nxt.pn * tstepB : cB;
#pragma nounroll
        for (int t = 0; t < nt; t += 2) {
            const bool last = (t == nt - 2);
            const char* a1 = cA + (size_t)(t + 1) * kstep;
            const char* a2 = last ? nA : cA + (size_t)(t + 2) * kstep; const char* b2 = last ? nB : cB + (size_t)(t + 2) * kstep;
            const char* a3 = a2 + kstep; const char* b3 = b2 + kstep;
            PG8_LDB(B0, 0, 0); PG8_LDB(B1, 0, 1); PG8_SCHED; PG8_LDA(At, 0, 0); PG8_STAGE(PG8_SA(1, 1), a1 + hstepA, voffA);
            PG8_WAIT_V(8); PG8_WAIT_L(0); PG8_BAR; PG8_MMA(0, 0, At, B0); PG8_MMA(0, 1, At, B1); PG8_BAR; PG8_SCHED;
            PG8_LDA(At, 0, 1); PG8_STAGE(PG8_SB(0, 0), b2, voffB); PG8_STAGE(PG8_SB(0, 1), b2 + hstepB, voffB); PG8_STAGE(PG8_SA(0, 0), a2, voffA);
            PG8_WAIT_V(8); PG8_WAIT_L(0); PG8_BAR; PG8_MMA(1, 0, At, B0); PG8_MMA(1, 1, At, B1); PG8_BAR; PG8_SCHED;
            PG8_LDB(B0, 1, 0); PG8_LDB(B1, 1, 1); PG8_SCHED; PG8_LDA(At, 1, 0); PG8_STAGE(PG8_SA(0, 1), a2 + hstepA, voffA);
            PG8_WAIT_V(8); PG8_WAIT_L(0); PG8_BAR; PG8_MMA(0, 0, At, B0); PG8_MMA(0, 1, At, B1); PG8_BAR; PG8_SCHED;
            PG8_LDA(At, 1, 1); PG8_STAGE(PG8_SB(1, 0), b3, voffB); PG8_STAGE(PG8_SB(1, 1), b3 + hstepB, voffB); PG8_STAGE(PG8_SA(1, 0), a3, voffA);
            PG8_WAIT_V(8); PG8_WAIT_L(0); PG8_BAR; PG8_MMA(1, 0, At, B0); PG8_MMA(1, 1, At, B1); PG8_BAR; PG8_SCHED;
        }
        if constexpr (ALIGN_EPI) { if (wr == 0) PG8_BAR; }
        E(acc, cur, wr, wc, fr, fq);
        if (!has_next) break;
#pragma unroll
        for (int a = 0; a < 2; ++a)
#pragma unroll
            for (int b = 0; b < 2; ++b)
#pragma unroll
                for (int m = 0; m < 4; ++m)
#pragma unroll
                    for (int n = 0; n < 2; ++n) acc[a][b][m][n] = (f32x4){0.f, 0.f, 0.f, 0.f};
        cur = nxt; cA = nA; cB = nB; ++ui;
        if constexpr (ALIGN_EPI) { if (wr == 1) PG8_BAR; }
    }
    PG8_WAIT_V(0);
    if constexpr (!ALIGN_EPI) { if (wr == 0) PG8_BAR; }
    PG8_BAR;
#undef PG8_SA
#undef PG8_SB
#undef PG8_STAGE
#undef PG8_LDA
#undef PG8_LDB
#undef PG8_MMA
#undef PG8_WAIT_V
#undef PG8_WAIT_L
#undef PG8_BAR
#undef PG8_SCHED
}
}

__device__ __forceinline__ u32x4 pack8(const f32x4& a0, const f32x4& a1) { u32x4 w; w.x = pk2(a0[0], a0[1]); w.y = pk2(a0[2], a0[3]); w.z = pk2(a1[0], a1[1]); w.w = pk2(a1[2], a1[3]); return w; }
typedef _Float16 f16x8 __attribute__((ext_vector_type(8)));
struct FP {
    bf16_t* P;
    __device__ __forceinline__ void operator()(int row, int col, const f32x4& a0, const f32x4& a1, const f32x4& b0, const f32x4& b1) const {
        if (col < NIN) *(u32x4*)(P + (size_t)row * NIN + col) = pack8(a0, a1);
        if (col + 128 < NIN) *(u32x4*)(P + (size_t)row * NIN + col + 128) = pack8(b0, b1);
    }
};
struct FQ {
    bf16_t* Q; const float* rstd; const float* rope;
    __device__ __forceinline__ void one(int row, int col, float rs, f32x4 a0, f32x4 a1) const {
        a0 = a0 * rs; a1 = a1 * rs;
        const int c = col % DQK;
        if (c >= 128) { const f32x4* t = (const f32x4*)(rope + ((size_t)row_pos(row) * 32 + ((c - 128) >> 1)) * 2); const f32x4 t0 = t[0], t1 = t[1];
            f32x4 o0, o1;
            o0[0] = a0[0] * t0[0] - a0[1] * t0[1]; o0[1] = a0[1] * t0[0] + a0[0] * t0[1]; o0[2] = a0[2] * t0[2] - a0[3] * t0[3]; o0[3] = a0[3] * t0[2] + a0[2] * t0[3];
            o1[0] = a1[0] * t1[0] - a1[1] * t1[1]; o1[1] = a1[1] * t1[0] + a1[0] * t1[1]; o1[2] = a1[2] * t1[2] - a1[3] * t1[3]; o1[3] = a1[3] * t1[2] + a1[2] * t1[3];
            a0 = o0; a1 = o1; }
        *(u32x4*)(Q + (size_t)row * 768 + col) = pack8(a0, a1);
    }
    __device__ __forceinline__ void operator()(int row, int col, const f32x4& a0, const f32x4& a1, const f32x4& b0, const f32x4& b1) const {
        const float rs = rstd[row] * QSCALE; one(row, col, rs, a0, a1); one(row, col + 128, rs, b0, b1); }
};
struct FKV {
    bf16_t* K; bf16_t* V; const float* rstd;
    __device__ __forceinline__ void one(int row, int col, float rs, const f32x4& a0, const f32x4& a1) const {
        const int h = col >> 8, c = col & 255; const u32x4 w = pack8(a0 * rs, a1 * rs);
        if (c < 128) *(u32x4*)(K + (size_t)row * 768 + h * DQK + c) = w; else *(u32x4*)(V + (size_t)row * 512 + h * DV + (c - 128)) = w; }
    __device__ __forceinline__ void operator()(int row, int col, const f32x4& a0, const f32x4& a1, const f32x4& b0, const f32x4& b1) const {
        const float rs = rstd[row]; one(row, col, rs, a0, a1); one(row, col + 128, rs, b0, b1); }
};
struct FLwa {
    f16_t* EW; f16_t* KMOD; const f16_t* KK; f16_t* Bv; const float* w0; const float* a0p; const float* k_a;
    __device__ __forceinline__ void one(int row, int col, const f32x4& a0, const f32x4& a1) const {
        float v[8] = {a0[0], a0[1], a0[2], a0[3], a1[0], a1[1], a1[2], a1[3]};
        if (col < 512) {
            f16x8 o;
#pragma unroll
            for (int j = 0; j < 8; ++j) { const float xx = w0[col + j] + v[j]; const float sp = (-xx > 20.f) ? -xx : __logf(1.f + __expf(-xx)); o[j] = (f16_t)__expf(-sp - 0.5f); }
            *(f16x8*)(EW + (size_t)row * 512 + col) = o;
        } else {
            const int c = col - 512; const size_t idx = (size_t)row * 512 + c;
            const f16x8 kv = *(const f16x8*)(KMOD + idx), kkv = *(const f16x8*)(KK + idx); f16x8 ko, bo;
#pragma unroll
            for (int j = 0; j < 8; ++j) { const float a = sigmoidf_(a0p[c + j] + v[j]); ko[j] = (f16_t)((float)kv[j] * (1.f + (a - 1.f) * k_a[c + j])); bo[j] = (f16_t)((float)kkv[j] * a); }
            *(f16x8*)(KMOD + idx) = ko; *(f16x8*)(Bv + idx) = bo;
        }
    }
    __device__ __forceinline__ void operator()(int row, int col, const f32x4& a0, const f32x4& a1, const f32x4& b0, const f32x4& b1) const { one(row, col, a0, a1); one(row, col + 128, b0, b1); }
};
struct FG { bf16_t* G;
    __device__ __forceinline__ void operator()(int row, int col, const f32x4& a0, const f32x4& a1, const f32x4& b0, const f32x4& b1) const {
        *(u32x4*)(G + (size_t)row * 512 + col) = pack8(a0, a1); *(u32x4*)(G + (size_t)row * 512 + col + 128) = pack8(b0, b1); } };
struct FOut {
    const float* x; float* H2; bf16_t* H2B; float* ssq;
    __device__ __forceinline__ float one(size_t idx, const f32x4& a0, const f32x4& a1) const {
        const f32x4 h0 = *(const f32x4*)(x + idx) + a0, h1 = *(const f32x4*)(x + idx + 4) + a1;
        *(f32x4*)(H2 + idx) = h0; *(f32x4*)(H2 + idx + 4) = h1; *(u32x4*)(H2B + idx) = pack8(h0, h1);
        return (h0[0] * h0[0] + h0[1] * h0[1]) + (h0[2] * h0[2] + h0[3] * h0[3]) + (h1[0] * h1[0] + h1[1] * h1[1]) + (h1[2] * h1[2] + h1[3] * h1[3]); }
    __device__ __forceinline__ void operator()(int row, int col, const f32x4& a0, const f32x4& a1, const f32x4& b0, const f32x4& b1) const {
        float s = one((size_t)row * DM + col, a0, a1) + one((size_t)row * DM + col + 128, b0, b1);
        s += __shfl_xor(s, 16); s += __shfl_xor(s, 32);
        if ((threadIdx.x & 63) < 16) atomicAdd(ssq + row, s); }
};
struct FAct {
    bf16_t* ACT; const float* ssq;
    __device__ __forceinline__ void operator()(int row, int col, const f32x4& a0, const f32x4& a1, const f32x4& b0, const f32x4& b1) const {
        const float rs = 1.0f / sqrtf(ssq[row] * (1.f / DM) + RMS_EPS);
        f32x4 o0, o1;
#pragma unroll
        for (int j = 0; j < 4; ++j) { const float g0 = a0[j] * rs, g1 = a1[j] * rs; o0[j] = g0 * sigmoidf_(g0) * (b0[j] * rs); o1[j] = g1 * sigmoidf_(g1) * (b1[j] * rs); }
        *(u32x4*)(ACT + (size_t)row * DFF + (col >> 8) * 128 + (col & 127)) = pack8(o0, o1); }
};
struct FDown {
    float* H; float* ssq;
    __device__ __forceinline__ float one(size_t idx, const f32x4& a0, const f32x4& a1) const {
        const f32x4 h0 = *(const f32x4*)(H + idx) + a0, h1 = *(const f32x4*)(H + idx + 4) + a1; *(f32x4*)(H + idx) = h0; *(f32x4*)(H + idx + 4) = h1;
        return (h0[0] * h0[0] + h0[1] * h0[1]) + (h0[2] * h0[2] + h0[3] * h0[3]) + (h1[0] * h1[0] + h1[1] * h1[1]) + (h1[2] * h1[2] + h1[3] * h1[3]); }
    __device__ __forceinline__ void operator()(int row, int col, const f32x4& a0, const f32x4& a1, const f32x4& b0, const f32x4& b1) const {
        float s = one((size_t)row * DM + col, a0, a1) + one((size_t)row * DM + col + 128, b0, b1);
        s += __shfl_xor(s, 16); s += __shfl_xor(s, 32);
        if ((threadIdx.x & 63) < 16) atomicAdd(ssq + row, s); }
};

__device__ __forceinline__ void scan_simple_unit(const Params& p, int unit, int t256) {
    unsigned char* ws = p.ws;
    const f16_t* R = (const f16_t*)(ws + O_R); const f16_t* VV = (const f16_t*)(ws + O_VV); const f16_t* KK = (const f16_t*)(ws + O_KK); const f16_t* KM = (const f16_t*)(ws + O_KMOD);
    const f16_t* EW = (const f16_t*)(ws + O_EW); const f16_t* Bv = (const f16_t*)(ws + O_B);
    float* YRAW = p.out;
    const int bh = unit >> 2, quarter = unit & 3, b = bh >> 3, h = bh & 7;
    const int il = t256 >> 4, c = t256 & 15, i = 16 * quarter + il;
    float S[4] = {0.f, 0.f, 0.f, 0.f};
    const size_t base = ((size_t)b * LP + LPAD) * 512 + h * 64;
    for (int t = 0; t < L; ++t) {
        const size_t o = base + (size_t)t * 512 + 4 * c;
        float w[4], kk[4], bb[4], k[4], r[4];
#pragma unroll
        for (int j = 0; j < 4; ++j) { w[j] = __expf(-(float)EW[o + j]); kk[j] = (float)KK[o + j]; bb[j] = (float)Bv[o + j]; k[j] = (float)KM[o + j]; r[j] = (float)R[o + j]; }
        const float v = (float)VV[base + (size_t)t * 512 + i];
        float sa = 0.f;
#pragma unroll
        for (int j = 0; j < 4; ++j) sa += S[j] * kk[j];
        sa += __shfl_xor(sa, 1); sa += __shfl_xor(sa, 2); sa += __shfl_xor(sa, 4); sa += __shfl_xor(sa, 8);
        sa = -sa;
        float y = 0.f;
#pragma unroll
        for (int j = 0; j < 4; ++j) { S[j] = S[j] * w[j] + sa * bb[j] + v * k[j]; y += S[j] * r[j]; }
        y += __shfl_xor(y, 1); y += __shfl_xor(y, 2); y += __shfl_xor(y, 4); y += __shfl_xor(y, 8);
        if (c == 0) YRAW[base + (size_t)t * 512 + i] = y;
    }
}

__device__ __forceinline__ void attn_simple_unit(const Params& p, float* sm, int unit, int tid) {
    float* Qs = sm;
    float* Ks = Qs + 64 * 192;
    float* Vs = Ks + 64 * 193;
    float* Ps = Vs + 64 * 128;
    unsigned char* ws = p.ws;
    const bf16_t* Q = (const bf16_t*)(ws + O_Q); const bf16_t* Kb = (const bf16_t*)(ws + O_K); const bf16_t* V = (const bf16_t*)(ws + O_V);
    bf16_t* Y = (bf16_t*)(ws + O_Y); const float* og = p.in[19];
    const int qt = unit & 63, h = (unit >> 6) & 3, b = unit >> 8;
    const size_t rb = (size_t)b * LP;
    const int qrow0 = 64 + 64 * qt;
    __syncthreads();
    for (int i = tid; i < 64 * 192; i += 512) { const int r = i / 192, d = i % 192; Qs[i] = bf2f(Q[(rb + qrow0 + r) * 768 + h * DQK + d]); }
    const int qi = (tid & 255) >> 2, sub = tid & 3; const bool act = tid < 256;
    float m = -1e30f, l = 0.f; float o[32];
#pragma unroll
    for (int j = 0; j < 32; ++j) o[j] = 0.f;
    const int nkt = qt + 2;
    for (int kt = 0; kt < nkt; ++kt) {
        __syncthreads();
        for (int i = tid; i < 64 * 192; i += 512) { const int r = i / 192, d = i % 192; Ks[r * 193 + d] = bf2f(Kb[(rb + 64 * kt + r) * 768 + h * DQK + d]); }
        for (int i = tid; i < 64 * 128; i += 512) { const int r = i >> 7, d = i & 127; Vs[i] = bf2f(V[(rb + 64 * kt + r) * 512 + h * DV + d]); }
        __syncthreads();
        float scale = 1.f;
        if (act) {
            float sc[16]; float mx = -1e30f;
#pragma unroll
            for (int kk = 0; kk < 16; ++kk) {
                const int key = sub + 4 * kk; float s = 0.f;
                for (int d = 0; d < 192; ++d) s += Qs[qi * 192 + d] * Ks[key * 193 + d];
                const int krow = 64 * kt + key;
                if (krow < LPAD || krow > qrow0 + qi) s = -1e30f;
                sc[kk] = s; mx = fmaxf(mx, s);
            }
            mx = fmaxf(mx, __shfl_xor(mx, 1)); mx = fmaxf(mx, __shfl_xor(mx, 2));
            const float mn = fmaxf(m, mx); scale = exp2f(m - mn);
            float ps = 0.f;
#pragma unroll
            for (int kk = 0; kk < 16; ++kk) { const float pv = (sc[kk] <= -1e29f) ? 0.f : exp2f(sc[kk] - mn); Ps[qi * 65 + sub + 4 * kk] = pv; ps += pv; }
            ps += __shfl_xor(ps, 1); ps += __shfl_xor(ps, 2);
            l = l * scale + ps; m = mn;
        }
        __syncthreads();
        if (act) {
#pragma unroll
            for (int j = 0; j < 32; ++j) o[j] *= scale;
            for (int key = 0; key < 64; ++key) { const float pv = Ps[qi * 65 + key];
#pragma unroll
                for (int j = 0; j < 32; ++j) o[j] += pv * Vs[key * 128 + sub * 32 + j]; }
        }
    }
    if (act) {
        const float il = 1.f / l; float ss = 0.f;
#pragma unroll
        for (int j = 0; j < 32; ++j) { o[j] *= il; ss += o[j] * o[j]; }
        ss += __shfl_xor(ss, 1); ss += __shfl_xor(ss, 2);
        const float rs = 1.0f / sqrtf(ss * (1.f / DV) + RMS_EPS);
        const size_t yrow = (size_t)b * SEQ + 64 * qt + qi;
#pragma unroll
        for (int j = 0; j < 32; ++j) Y[yrow * DM + 512 + h * DV + sub * 32 + j] = (bf16_t)f2bf(o[j] * rs * og[h * DV + sub * 32 + j]);
    }
}

namespace scan {
#define SC_LAS __attribute__((address_space(3)))
constexpr int TS = 32, STEP_F = 5 * 64 + 16, BUF_F = TS * STEP_F, NCH = (L + TS - 1) / TS;
constexpr int SCAN_LDS = 2 * BUF_F * 4;
typedef _Float16 h8 __attribute__((ext_vector_type(8)));
typedef _Float16 h2 __attribute__((ext_vector_type(2)));
template <int CTRL> __device__ __forceinline__ float dppf(float x) { return __builtin_bit_cast(float, __builtin_amdgcn_update_dpp(0, __builtin_bit_cast(int, x), CTRL, 0xF, 0xF, true)); }
__device__ __forceinline__ float row_sum16(float x) { x += dppf<0xB1>(x); x += dppf<0x4E>(x); x += dppf<0x141>(x); x += dppf<0x140>(x); return x; }

__device__ __forceinline__ void scan_unit(const Params& p, SC_LAS float* lds, int unit) {
    unsigned char* ws = p.ws;
    const int tid = threadIdx.x, lane = tid & 63; const int wave = __builtin_amdgcn_readfirstlane(tid >> 6);
    const int bh = unit >> 2, quarter = unit & 3, b = bh >> 3, h = bh & 7;
    const size_t ebase = ((size_t)b * LP + LPAD) * 512 + h * 64;
    __syncthreads();
    if (wave >= 4) {
        const f16_t* src[5] = {(const f16_t*)(ws + O_EW), (const f16_t*)(ws + O_KK), (const f16_t*)(ws + O_B), (const f16_t*)(ws + O_KMOD), (const f16_t*)(ws + O_R)};
        const f16_t* VV = (const f16_t*)(ws + O_VV);
        const int t2 = tid - 256, tt = t2 >> 3, c8 = (t2 & 7) * 8, pr = t2 & 7;
#pragma nounroll
        for (int ch = 0; ch <= NCH; ++ch) {
            if (ch < NCH) {
                const int t = ch * TS + tt;
                if (t < L) {
                    SC_LAS float* dst = lds + (ch & 1) * BUF_F + tt * STEP_F;
                    const size_t e = ebase + (size_t)t * 512;
#pragma unroll
                    for (int a = 0; a < 5; ++a) {
                        const h8 v = *(const h8*)(src[a] + e + c8);
                        f32x4 lo, hi;
#pragma unroll
                        for (int j = 0; j < 4; ++j) { lo[j] = (float)v[j]; hi[j] = (float)v[4 + j]; }
                        if (a == 0) {
#pragma unroll
                            for (int j = 0; j < 4; ++j) { lo[j] = __expf(-lo[j]); hi[j] = __expf(-hi[j]); }
                        }
                        *(SC_LAS f32x4*)(dst + a * 64 + c8) = lo; *(SC_LAS f32x4*)(dst + a * 64 + c8 + 4) = hi;
                    }
                    const h2 vv = *(const h2*)(VV + e + 16 * quarter + 2 * pr);
                    dst[320 + 2 * pr] = (float)vv[0]; dst[320 + 2 * pr + 1] = (float)vv[1];
                }
            }
            __syncthreads();
        }
    } else {
        const int g = lane >> 4, c = lane & 15, i = 16 * quarter + 4 * wave + g;
        float* yout = p.out + ebase + i;
        typedef float f2 __attribute__((ext_vector_type(2)));
        f2 S01 = {0.f, 0.f}, S23 = {0.f, 0.f};
        __syncthreads();
#pragma nounroll
        for (int ch = 0; ch < NCH; ++ch) {
            const SC_LAS float* st = lds + (ch & 1) * BUF_F + 4 * c;
            const SC_LAS float* sv = lds + (ch & 1) * BUF_F + 320 + 4 * wave + g;
            const int n = (L - ch * TS) < TS ? (L - ch * TS) : TS;
            float* yo = yout + (size_t)(ch * TS + c) * 512;
#pragma nounroll
            for (int tb = 0; tb < n; tb += 16) {
                float ykeep = 0.f;
#pragma unroll
                for (int tt = 0; tt < 16; ++tt) {
                    const f32x4 w4 = *(const SC_LAS f32x4*)(st + tt * STEP_F), kk4 = *(const SC_LAS f32x4*)(st + tt * STEP_F + 64), b4 = *(const SC_LAS f32x4*)(st + tt * STEP_F + 128),
                                k4 = *(const SC_LAS f32x4*)(st + tt * STEP_F + 192), r4 = *(const SC_LAS f32x4*)(st + tt * STEP_F + 256);
                    const float v = sv[tt * STEP_F];
                    f2 pa = S01 * (f2){kk4[0], kk4[1]}; pa = S23 * (f2){kk4[2], kk4[3]} + pa;
                    const float sa = -row_sum16(pa.x + pa.y);
                    const f2 sa2 = {sa, sa}, v2 = {v, v};
                    f2 t01 = v2 * (f2){k4[0], k4[1]}, t23 = v2 * (f2){k4[2], k4[3]};
                    t01 = sa2 * (f2){b4[0], b4[1]} + t01; t23 = sa2 * (f2){b4[2], b4[3]} + t23;
                    S01 = S01 * (f2){w4[0], w4[1]} + t01; S23 = S23 * (f2){w4[2], w4[3]} + t23;
                    f2 py = S01 * (f2){r4[0], r4[1]}; py = S23 * (f2){r4[2], r4[3]} + py;
                    const float y = row_sum16(py.x + py.y);
                    ykeep = (c == tt) ? y : ykeep;
                }
                yo[(size_t)tb * 512] = ykeep;
                st += 16 * STEP_F; sv += 16 * STEP_F;
            }
            __syncthreads();
        }
    }
}
}

namespace att {
#define ATT_LAS __attribute__((address_space(3)))
typedef float f32x16 __attribute__((ext_vector_type(16)));
typedef short bf16x8 __attribute__((ext_vector_type(8)));
typedef short s16x4 __attribute__((ext_vector_type(4)));
typedef float f32x2_t __attribute__((ext_vector_type(2)));
typedef __bf16 bf16x2_t __attribute__((ext_vector_type(2)));
constexpr int KROW = 400, VROW = 320, KBUF = 64 * KROW, VBUF = 64 * VROW;
constexpr int L_K = 0, L_V = 2 * KBUF, L_SCR = 2 * KBUF + 2 * VBUF, ATT_LDS = L_SCR + 8 * 256;
__device__ __forceinline__ int crow(int i, int hi) { return (i & 3) + 8 * (i >> 2) + 4 * hi; }
__device__ __forceinline__ unsigned cvtpk(float lo, float hi) { f32x2_t v = {lo, hi}; bf16x2_t b = __builtin_convertvector(v, bf16x2_t); return __builtin_bit_cast(unsigned, b); }
template <int K> __device__ __forceinline__ float swz_xor(float x) { return __builtin_bit_cast(float, __builtin_amdgcn_ds_swizzle(__builtin_bit_cast(int, x), 0x1F | (K << 10))); }
__device__ __forceinline__ float x32_max(float x) { float a = x, b = x; asm volatile("s_nop 1\n\tv_permlane32_swap_b32 %0, %1" : "+v"(a), "+v"(b)); return fmaxf(a, b); }
__device__ __forceinline__ float x32_sum(float x) { float a = x, b = x; asm volatile("s_nop 1\n\tv_permlane32_swap_b32 %0, %1" : "+v"(a), "+v"(b)); return a + b; }
__device__ __forceinline__ s16x4 vtr(const ATT_LAS unsigned char* p) { return __builtin_bit_cast(s16x4, __builtin_amdgcn_ds_read_tr16_b64_v4i16((ATT_LAS s16x4*)p)); }

__device__ __forceinline__ void attn_unit(const Params& p, ATT_LAS unsigned char* lds, int b, int h, int qblk) {
    const int tid = threadIdx.x, lane = tid & 63, r32 = lane & 31, hi = lane >> 5; const int w = __builtin_amdgcn_readfirstlane(tid >> 6);
    unsigned char* ws = p.ws;
    const bf16_t* Q = (const bf16_t*)(ws + O_Q); const bf16_t* Kg = (const bf16_t*)(ws + O_K); const bf16_t* Vg = (const bf16_t*)(ws + O_V);
    const size_t rowbase = (size_t)b * LP;
    const int qrow = 64 + 256 * qblk + 32 * w + r32;
    const int NT = 4 * qblk + 5, jband = 4 * qblk + 1, jdiag = jband + (w >> 1);
    bf16x8 qf[12];
    { const bf16_t* qp = Q + (rowbase + qrow) * 768 + h * DQK + 8 * hi;
#pragma unroll
      for (int s = 0; s < 12; ++s) qf[s] = *(const bf16x8*)(qp + 16 * s); }
    const unsigned char* kbase = (const unsigned char*)(Kg + rowbase * 768 + h * DQK);
    const unsigned char* vbase = (const unsigned char*)(Vg + rowbase * 512 + h * DV);
    const unsigned sr = (unsigned)tid >> 3, sc8 = ((unsigned)tid & 7u) * 16u;
    const unsigned ko = sr * 1536u + sc8, vo = sr * 1024u + sc8, kl = (unsigned)L_K + sr * KROW + sc8, vl = (unsigned)L_V + sr * VROW + sc8;
    u32x4 sk[3], sv[2];
#define ATT_LOAD(j) do { const unsigned char* kb_ = kbase + (size_t)(j) * (64 * 768 * 2) + ko; const unsigned char* vb_ = vbase + (size_t)(j) * (64 * 512 * 2) + vo; \
                         _Pragma("unroll") for (int i_ = 0; i_ < 3; ++i_) sk[i_] = *(const u32x4*)(kb_ + 128 * i_); \
                         _Pragma("unroll") for (int i_ = 0; i_ < 2; ++i_) sv[i_] = *(const u32x4*)(vb_ + 128 * i_); } while (0)
#define ATT_WRITE(buf) do { _Pragma("unroll") for (int i_ = 0; i_ < 3; ++i_) *(ATT_LAS u32x4*)(lds + kl + (buf) * KBUF + 128 * i_) = sk[i_]; \
                            _Pragma("unroll") for (int i_ = 0; i_ < 2; ++i_) *(ATT_LAS u32x4*)(lds + vl + (buf) * VBUF + 128 * i_) = sv[i_]; } while (0)
    ATT_LAS float* scr = (ATT_LAS float*)(lds + L_SCR + w * 256);
    f32x16 o[4];
#pragma unroll
    for (int d = 0; d < 4; ++d)
#pragma unroll
        for (int i = 0; i < 16; ++i) o[d][i] = 0.f;
    float m = -1e30f, lsum = 0.f;
    const ATT_LAS unsigned char* kp0 = lds + L_K + r32 * KROW + hi * 16;
    const ATT_LAS unsigned char* vp0 = lds + L_V + (4 * hi + ((lane & 15) >> 2)) * VROW + (((lane >> 4) & 1) * 16 + (lane & 3) * 4) * 2;
    ATT_LOAD(0); ATT_WRITE(0);
    __syncthreads();
#pragma nounroll
    for (int j = 0; j < NT; ++j) {
        const int buf = j & 1;
        if (j + 1 < NT) ATT_LOAD(j + 1);
        if (j <= jdiag) {
            const ATT_LAS unsigned char* kp = kp0 + buf * KBUF;
            f32x16 p0, p1;
#pragma unroll
            for (int i = 0; i < 16; ++i) { p0[i] = 0.f; p1[i] = 0.f; }
#pragma unroll
            for (int s = 0; s < 12; ++s) {
                const bf16x8 k0 = *(const ATT_LAS bf16x8*)(kp + s * 32), k1 = *(const ATT_LAS bf16x8*)(kp + 32 * KROW + s * 32);
                p0 = __builtin_amdgcn_mfma_f32_32x32x16_bf16(k0, qf[s], p0, 0, 0, 0);
                p1 = __builtin_amdgcn_mfma_f32_32x32x16_bf16(k1, qf[s], p1, 0, 0, 0);
                if ((s & 3) == 3) __builtin_amdgcn_sched_barrier(0);
            }
            if (j == 0 || j >= jband) {
#pragma unroll
                for (int i = 0; i < 16; ++i) { const int kr = 64 * j + crow(i, hi);
                    if (kr < LPAD || kr > qrow) p0[i] = -1e30f;
                    if (kr + 32 < LPAD || kr + 32 > qrow) p1[i] = -1e30f; }
            }
            float mx = fmaxf(p0[0], p1[0]);
#pragma unroll
            for (int i = 1; i < 16; ++i) mx = fmaxf(mx, fmaxf(p0[i], p1[i]));
            mx = x32_max(mx);
            const float mn = fmaxf(m, mx);
            const bool grew = mn > m;
            const float alpha = __builtin_amdgcn_exp2f(m - mn);
            m = mn;
            float rs = 0.f;
#pragma unroll
            for (int i = 0; i < 16; ++i) { p0[i] = __builtin_amdgcn_exp2f(p0[i] - mn); p1[i] = __builtin_amdgcn_exp2f(p1[i] - mn); rs += p0[i] + p1[i]; }
            lsum = lsum * alpha + rs;
            if (__any(grew)) {
                if (hi == 0) scr[r32] = alpha;
#pragma unroll
                for (int g = 0; g < 4; ++g) { const f32x4 a4 = *(const ATT_LAS f32x4*)(scr + 8 * g + 4 * hi);
#pragma unroll
                    for (int d = 0; d < 4; ++d) { o[d][4 * g + 0] *= a4[0]; o[d][4 * g + 1] *= a4[1]; o[d][4 * g + 2] *= a4[2]; o[d][4 * g + 3] *= a4[3]; } }
            }
            u32x4 pw[4];
#pragma unroll
            for (int s = 0; s < 2; ++s) {
                pw[s] = (u32x4){cvtpk(p0[8 * s], p0[8 * s + 1]), cvtpk(p0[8 * s + 2], p0[8 * s + 3]), cvtpk(p0[8 * s + 4], p0[8 * s + 5]), cvtpk(p0[8 * s + 6], p0[8 * s + 7])};
                pw[2 + s] = (u32x4){cvtpk(p1[8 * s], p1[8 * s + 1]), cvtpk(p1[8 * s + 2], p1[8 * s + 3]), cvtpk(p1[8 * s + 4], p1[8 * s + 5]), cvtpk(p1[8 * s + 6], p1[8 * s + 7])};
            }
            const ATT_LAS unsigned char* vp = vp0 + buf * VBUF;
            __builtin_amdgcn_sched_barrier(0);
#pragma unroll
            for (int ks = 0; ks < 4; ++ks) {
                const bf16x8 pa = __builtin_bit_cast(bf16x8, pw[ks]);
#pragma unroll
                for (int d = 0; d < 4; ++d) {
                    const s16x4 lo = vtr(vp + (16 * ks) * VROW + 64 * d), hh = vtr(vp + (16 * ks + 8) * VROW + 64 * d);
                    const bf16x8 vb = (bf16x8){lo[0], lo[1], lo[2], lo[3], hh[0], hh[1], hh[2], hh[3]};
                    o[d] = __builtin_amdgcn_mfma_f32_32x32x16_bf16(pa, vb, o[d], 0, 0, 0);
                }
                __builtin_amdgcn_sched_barrier(0);
            }
        }
        if (j + 1 < NT) ATT_WRITE(buf ^ 1);
        __syncthreads();
    }
#undef ATT_LOAD
#undef ATT_WRITE
    const float ltot = x32_sum(lsum);
    if (hi == 0) scr[32 + r32] = ltot;
    const float* og = p.in[19] + h * DV;
    float gl[4];
#pragma unroll
    for (int d = 0; d < 4; ++d) gl[d] = og[32 * d + r32];
    bf16_t* Y = (bf16_t*)(ws + O_Y) + ((size_t)b * SEQ + 256 * qblk + 32 * w) * DM + 512 + h * DV + r32;
#pragma unroll
    for (int g = 0; g < 4; ++g) {
        const f32x4 l4 = *(const ATT_LAS f32x4*)(scr + 32 + 8 * g + 4 * hi);
#pragma unroll
        for (int e = 0; e < 4; ++e) {
            const int i = 4 * g + e;
            float ss = o[0][i] * o[0][i] + o[1][i] * o[1][i] + o[2][i] * o[2][i] + o[3][i] * o[3][i];
            ss += swz_xor<1>(ss); ss += swz_xor<2>(ss); ss += swz_xor<4>(ss); ss += swz_xor<8>(ss); ss += swz_xor<16>(ss);
            const float inv = 1.f / l4[e];
            const float sc = inv / sqrtf(ss * inv * inv * (1.f / DV) + RMS_EPS);
            bf16_t* yr = Y + (size_t)crow(i, hi) * DM;
#pragma unroll
            for (int d = 0; d < 4; ++d) yr[32 * d] = (bf16_t)f2bf(o[d][i] * sc * gl[d]);
        }
    }
}
}

__device__ __forceinline__ void p5_phase(const Params& p, int gw, int ngw, int lane) {
    unsigned char* ws = p.ws;
    const float* YRAW = p.out;
    const f16_t* R = (const f16_t*)(ws + O_R); const f16_t* VV = (const f16_t*)(ws + O_VV); const f16_t* KM = (const f16_t*)(ws + O_KMOD); const bf16_t* G = (const bf16_t*)(ws + O_G);
    bf16_t* Y = (bf16_t*)(ws + O_Y);
    const float* r_k = p.in[12]; const float* ln_w = p.in[13]; const float* ln_b = p.in[14];
    for (int it = gw; it < TR * RH; it += ngw) {
        const int rr = it >> 3, h = it & 7, b = rr / SEQ, s = rr % SEQ;
        const size_t idx = ((size_t)b * LP + 64 + s) * 512 + h * 64 + lane;
        const float y = YRAW[idx];
        const float mean = wave_sum(y) * (1.f / 64.f); const float d = y - mean; const float var = wave_sum(d * d) * (1.f / 64.f);
        const float r = (float)R[idx], k = (float)KM[idx], v = (float)VV[idx];
        const float bonus = wave_sum(r * k * r_k[h * 64 + lane]);
        float yo = d * (1.0f / sqrtf(var + GN_EPS)) * ln_w[h * 64 + lane] + ln_b[h * 64 + lane] + bonus * v;
        yo *= bf2f(G[idx]);
        Y[(size_t)rr * DM + h * 64 + lane] = (bf16_t)f2bf(yo);
    }
}
__device__ __forceinline__ void p9_phase(const Params& p, int gw, int ngw, int lane) {
    const float* ssq = (const float*)(p.ws + O_SSQ3); const float* g = p.in[25];
    for (int row = gw; row < TR; row += ngw) {
        const float rs = 1.0f / sqrtf(ssq[row] * (1.f / DM) + RMS_EPS);
        f32x4* o = (f32x4*)(p.out + (size_t)row * DM) + lane;
#pragma unroll
        for (int j = 0; j < 4; ++j) { const f32x4 gv = ((const f32x4*)g)[lane + 64 * j]; f32x4 v = o[64 * j]; v = v * rs * gv; o[64 * j] = v; }
    }
}


#define GAS __attribute__((address_space(1)))
#define LAS __attribute__((address_space(3)))
#define XB_TMO      128
#define XB_XCNT(j)  (256  + 64 * (j))
#define XB_XSUB(j)  (1280 + 64 * (j))
#define XB_XGEN(j)  (2304 + 64 * (j))
#define XB_TOP      3328
#define XB_TOPGEN   3392
#define XCD_BAR_WORDS 3456
#define XB_SPIN_CAP (1u << 22)
__device__ __forceinline__ unsigned xb_ld(unsigned* p)              { return __hip_atomic_load(p, __ATOMIC_RELAXED, __HIP_MEMORY_SCOPE_AGENT); }
__device__ __forceinline__ unsigned xb_add(unsigned* p, unsigned v) { return __hip_atomic_fetch_add(p, v, __ATOMIC_RELAXED, __HIP_MEMORY_SCOPE_AGENT); }
__device__ __forceinline__ unsigned xb_xcc_id() { return (unsigned)__builtin_amdgcn_s_getreg((3 << 11) | 20) & 0xFu; }
#define XB_SPIN(cond, bar) do { unsigned _sp = 0; while (cond) { __builtin_amdgcn_s_sleep(1); \
    if ((++_sp & 255u) == 0u) { if (xb_ld(&(bar)[XB_TMO])) break; if (_sp > XB_SPIN_CAP) { atomicAdd(&(bar)[XB_TMO], 1u); break; } } } } while (0)
struct XcdBarrier { unsigned* bar; unsigned x; volatile LAS unsigned* st; };
__device__ __forceinline__ XcdBarrier xcd_barrier_post(unsigned* bar, volatile LAS unsigned* st) {
    XcdBarrier b; b.bar = bar; b.x = xb_xcc_id(); b.st = st;
    if (threadIdx.x == 0) (void)xb_add(&bar[XB_XCNT(b.x)], 1u);
    return b;
}
__device__ __forceinline__ void xcd_barrier_complete(unsigned* bar, unsigned x, unsigned& nloc, unsigned& nx) {
    const unsigned G = gridDim.x * gridDim.y * gridDim.z;
    unsigned sum, cnt, mine, sp = 0u;
    for (;;) {
        sum = 0u; cnt = 0u; mine = 0u;
#pragma unroll
        for (unsigned j = 0; j < 16; ++j) { const unsigned c = xb_ld(&bar[XB_XCNT(j)]); sum += c; cnt += (c > 0u) ? 1u : 0u; mine = (j == x) ? c : mine; }
        if (sum == G) break;
        __builtin_amdgcn_s_sleep(1);
        if ((++sp & 255u) == 0u) { if (xb_ld(&bar[XB_TMO])) break; if (sp > XB_SPIN_CAP) { atomicAdd(&bar[XB_TMO], 1u); break; } }
    }
    nloc = mine > 0u ? mine : 1u; nx = cnt > 0u ? cnt : 1u;
}
__device__ __forceinline__ void xcd_barrier(const XcdBarrier& b) {
    asm volatile("s_waitcnt vmcnt(0)" ::: "memory");
    __syncthreads();
    if (threadIdx.x == 0) {
        unsigned* bar = b.bar;
        __builtin_amdgcn_s_waitcnt(0);
        unsigned nloc = b.st[0], nx = b.st[1];
        if (nloc == 0u) { xcd_barrier_complete(bar, b.x, nloc, nx); b.st[0] = nloc; b.st[1] = nx; }
        const unsigned old = xb_add(&bar[XB_XSUB(b.x)], 1u);
        const unsigned gen = old / nloc;
        if (old + 1u == (gen + 1u) * nloc) {
            __builtin_amdgcn_fence(__ATOMIC_RELEASE, "agent");
            asm volatile("s_waitcnt vmcnt(0)" ::: "memory");
            const unsigned og = xb_add(&bar[XB_TOP], 1u);
            const unsigned tg = og / nx;
            if (og + 1u == (tg + 1u) * nx) xb_add(&bar[XB_TOPGEN], 1u);
            else XB_SPIN(xb_ld(&bar[XB_TOPGEN]) == tg, bar);
            __builtin_amdgcn_fence(__ATOMIC_ACQUIRE, "agent");
            xb_add(&bar[XB_XGEN(b.x)], 1u);
            asm volatile("s_waitcnt vmcnt(0)" ::: "memory");
        } else {
            XB_SPIN(xb_ld(&bar[XB_XGEN(b.x)]) == gen, bar);
            __builtin_amdgcn_fence(__ATOMIC_ACQUIRE, "agent");
            asm volatile("s_waitcnt vmcnt(0)" ::: "memory");
        }
    }
    __syncthreads();
}

#ifndef PH_MASK
#define PH_MASK 0xFFFF
#endif
#define PH(k) ((PH_MASK >> (k)) & 1)
#ifndef PROBE_PHASE
#define PROBE_PHASE -1
#endif
#define PROBE_EXTRA 4
#define NREP(k) ((PH(k) ? 1 : 0) + ((PROBE_PHASE == (k)) ? PROBE_EXTRA : 0))
constexpr int LDS_BYTES = 153600;
constexpr int LDS_MISC = LDS_BYTES - 256;
__global__ void __launch_bounds__(512, 2) mega_fwd(Params p) {
    extern __shared__ __attribute__((aligned(16))) unsigned char lds[];
    const int tid = threadIdx.x, lane = tid & 63; const int wave = __builtin_amdgcn_readfirstlane(tid >> 6);
    const int G = gridDim.x, gw = blockIdx.x * 8 + wave, ngw = G * 8;
    unsigned char* ws = p.ws;
    PG8_LAS unsigned char* ldsg = (PG8_LAS unsigned char*)lds;
    unsigned* ctl = (unsigned*)(ws + O_CTL);
    volatile LAS unsigned* misc = (volatile LAS unsigned*)(lds + LDS_MISC);
    if (tid < 2) misc[tid] = 0u;
    __syncthreads();
    const XcdBarrier xbar = xcd_barrier_post(ctl + 1024, misc);
#define GRID_SYNC() xcd_barrier(xbar)
    for (int rep_ = 0; rep_ < NREP(0); ++rep_) p0_phase(p, (float*)lds, gw, ngw, lane, wave);
    if (blockIdx.x == 0 && tid < 64) ctl[tid] = 0u;
    GRID_SYNC();
    for (int rep_ = 0; rep_ < NREP(1); ++rep_) { pg8::Gemm g{(const bf16_t*)(ws + O_U1), (const bf16_t*)(ws + O_WIN), DM, DM, DM}; pg8::StaticOrder S; S.init(TP, NINP, G, blockIdx.x);
      pg8::Epi8<FP> E{FP{(bf16_t*)(ws + O_P)}}; pg8::gemm_phase<pg8::Epi8<FP>, true>(ldsg, g, S, E); }
    GRID_SYNC();
    for (int rep_ = 0; rep_ < NREP(2); ++rep_) for (int row = gw; row < TP; row += ngw) p2_row(p, row, lane);
    GRID_SYNC();
    for (int rep_ = 0; rep_ < NREP(3); ++rep_) { pg8::Gemm g{(const bf16_t*)(ws + O_CQKV), (const bf16_t*)(ws + O_WUQ), 640, QL, QL}; pg8::StaticOrder S; S.init(TP, 768, G, blockIdx.x);
      pg8::Epi8<FQ> E{FQ{(bf16_t*)(ws + O_Q), (const float*)(ws + O_RSTDQ), (const float*)(ws + O_ROPE)}}; pg8::gemm_phase<pg8::Epi8<FQ>, true>(ldsg, g, S, E); }
    for (int rep_ = 0; rep_ < NREP(4); ++rep_) { pg8::Gemm g{(const bf16_t*)(ws + O_CQKV) + 384, (const bf16_t*)(ws + O_WUKV), 640, KVL, KVL}; pg8::StaticOrder S; S.init(TP, 1024, G, blockIdx.x);
      pg8::Epi8<FKV> E{FKV{(bf16_t*)(ws + O_K), (bf16_t*)(ws + O_V), (const float*)(ws + O_RSTDKV)}}; pg8::gemm_phase<pg8::Epi8<FKV>, true>(ldsg, g, S, E); }
    if (PH(5)) { pg8::Gemm g{(const bf16_t*)(ws + O_LIN), (const bf16_t*)(ws + O_LWA), 384, 256, 256}; pg8::StaticOrder S; S.init(TP, 1024, G, blockIdx.x);
      pg8::Epi8<FLwa> E{FLwa{(f16_t*)(ws + O_EW), (f16_t*)(ws + O_KMOD), (const f16_t*)(ws + O_KK), (f16_t*)(ws + O_B), p.in[5], p.in[7], p.in[11]}}; pg8::gemm_phase<pg8::Epi8<FLwa>, true>(ldsg, g, S, E); }
    for (int rep_ = 0; rep_ < NREP(6); ++rep_) { pg8::Gemm g{(const bf16_t*)(ws + O_LIN) + 128, (const bf16_t*)(ws + O_LG), 384, 256, 256}; pg8::StaticOrder S; S.init(TP, 512, G, blockIdx.x);
      pg8::Epi8<FG> E{FG{(bf16_t*)(ws + O_G)}}; pg8::gemm_phase<pg8::Epi8<FG>, true>(ldsg, g, S, E); }
    GRID_SYNC();
    for (int rep_ = 0; rep_ < NREP(7); ++rep_) for (int u = blockIdx.x; u < NB * RH * 4; u += G) scan::scan_unit(p, (SC_LAS float*)lds, u);
    for (int rep_ = 0; rep_ < NREP(8); ++rep_) {
        const int vcu = (G % 8 == 0) ? (int)(blockIdx.x % 8) * (G / 8) + (int)(blockIdx.x / 8) : (int)blockIdx.x;
        for (int pr = vcu; pr < NB * NH * 8; pr += G) {
            const int bh = pr >> 3, q0 = pr & 7;
#pragma nounroll
            for (int u2 = 0; u2 < 2; ++u2) att::attn_unit(p, ldsg, bh >> 2, bh & 3, u2 ? q0 : 15 - q0);
        }
    }
    GRID_SYNC();
    for (int rep_ = 0; rep_ < NREP(9); ++rep_) p5_phase(p, gw, ngw, lane);
    GRID_SYNC();
    if (PH(10)) { pg8::Gemm g{(const bf16_t*)(ws + O_Y), (const bf16_t*)(ws + O_WOUT), DM, DM, DM}; pg8::StaticOrder S; S.init(TR, DM, G, blockIdx.x);
      pg8::Epi8<FOut> E{FOut{p.in[0], p.out, (bf16_t*)(ws + O_H2B), (float*)(ws + O_SSQ2)}}; pg8::gemm_phase<pg8::Epi8<FOut>, true>(ldsg, g, S, E); }
    GRID_SYNC();
    for (int rep_ = 0; rep_ < NREP(11); ++rep_) { pg8::Gemm g{(const bf16_t*)(ws + O_H2B), (const bf16_t*)(ws + O_WGU), DM, DM, DM}; pg8::StaticOrder S; S.init(TR, 2 * DFF, G, blockIdx.x);
      pg8::Epi8<FAct> E{FAct{(bf16_t*)(ws + O_ACT), (const float*)(ws + O_SSQ2)}}; pg8::gemm_phase<pg8::Epi8<FAct>, true>(ldsg, g, S, E); }
    GRID_SYNC();
    if (PH(12)) { pg8::Gemm g{(const bf16_t*)(ws + O_ACT), (const bf16_t*)(ws + O_WDN), DFF, DFF, DFF}; pg8::StaticOrder S; S.init(TR, DM, G, blockIdx.x);
      pg8::Epi8<FDown> E{FDown{p.out, (float*)(ws + O_SSQ3)}}; pg8::gemm_phase<pg8::Epi8<FDown>, true>(ldsg, g, S, E); }
    GRID_SYNC();
    if (PH(13)) p9_phase(p, gw, ngw, lane);
}

extern "C" void kernel_launch(void* const* d_in, const int* in_sizes, int n_in, void* d_out, int out_size, void* d_ws, size_t ws_size, hipStream_t stream) {
    static int grid_blocks = 0;
    if (grid_blocks == 0) {
        if (n_in != 26 || out_size != TR * DM || ws_size < 512 * MiB) { fprintf(stderr, "kernel_launch: unexpected sizes n_in=%d out=%d ws=%zu\n", n_in, out_size, ws_size); grid_blocks = -1; return; }
        int dev = 0, cus = 0, per_cu = 0;
        (void)hipGetDevice(&dev); (void)hipDeviceGetAttribute(&cus, hipDeviceAttributeMultiprocessorCount, dev);
        (void)hipFuncSetAttribute((const void*)mega_fwd, hipFuncAttributeMaxDynamicSharedMemorySize, LDS_BYTES);
        (void)hipOccupancyMaxActiveBlocksPerMultiprocessor(&per_cu, (const void*)mega_fwd, 512, LDS_BYTES);
        if (per_cu < 1) { fprintf(stderr, "kernel_launch: occupancy query says %d blocks per CU\n", per_cu); per_cu = 1; }
        if (per_cu > 1) per_cu = 1;
        grid_blocks = cus * per_cu;
    }
    if (grid_blocks < 0) return;
    Params p{};
    for (int i = 0; i < 26; ++i) p.in[i] = (const float*)d_in[i];
    p.out = (float*)d_out; p.ws = (unsigned char*)d_ws;
    (void)hipMemsetAsync((unsigned char*)d_ws + O_CTL + 4096, 0, XCD_BAR_WORDS * 4, stream);
    hipLaunchKernelGGL(mega_fwd, dim3(grid_blocks), dim3(512), LDS_BYTES, stream, p);
    hipError_t e = hipPeekAtLastError();
    if (e != hipSuccess) fprintf(stderr, "launch failed: %s (grid %d)\n", hipGetErrorString(e), grid_blocks);
}
```

```cpp
#include <hip/hip_runtime.h>
#include <hip/hip_cooperative_groups.h>
namespace cg = cooperative_groups;
#include <cstdio>
#include <cstdint>

typedef unsigned short bf16_t;
typedef _Float16 f16_t;
typedef float f32x4 __attribute__((ext_vector_type(4)));
typedef unsigned u32x4 __attribute__((ext_vector_type(4)));
typedef unsigned u32x2 __attribute__((ext_vector_type(2)));

constexpr int NB = 8, SEQ = 4096, DM = 1024, NMETA = 16, L = SEQ + NMETA;
constexpr int LPAD = 48, LP = L + LPAD;
constexpr int TP = NB * LP;
constexpr int TR = NB * SEQ;
constexpr int NIN = 2528, NINP = 2560, RW = 512, RCOLS = 1824;
constexpr int QL = 384, KVL = 256, DQK = 192, DV = 128, NH = 4, RH = 8, RN = 64;
constexpr int DFF = 2816;
constexpr float RMS_EPS = 1e-6f, GN_EPS = 64e-5f;
constexpr float QSCALE = 0.07216878364870323f * 1.4426950408889634f;

constexpr size_t MiB = 1u << 20;
constexpr size_t al256(size_t x) { return (x + 255) & ~(size_t)255; }
constexpr size_t O_WIN = 0;
constexpr size_t O_WUQ = O_WIN + al256((size_t)NINP * DM * 2);
constexpr size_t O_WUKV = O_WUQ + al256((size_t)768 * QL * 2);
constexpr size_t O_LWA = O_WUKV + al256((size_t)1024 * KVL * 2);
constexpr size_t O_LG = O_LWA + al256((size_t)1024 * 256 * 2);
constexpr size_t O_WOUT = O_LG + al256((size_t)512 * 256 * 2);
constexpr size_t O_WGU = O_WOUT + al256((size_t)DM * DM * 2);
constexpr size_t O_WDN = O_WGU + al256((size_t)2 * DFF * DM * 2);
constexpr size_t O_ROPE = O_WDN + al256((size_t)DM * DFF * 2);
constexpr size_t O_RSTDQ = O_ROPE + al256((size_t)L * 32 * 8);
constexpr size_t O_RSTDKV = O_RSTDQ + al256((size_t)TP * 4);
constexpr size_t O_SSQ2 = O_RSTDKV + al256((size_t)TP * 4);
constexpr size_t O_SSQ3 = O_SSQ2 + al256((size_t)TR * 4);
constexpr size_t O_CTL = O_SSQ3 + al256((size_t)TR * 4);
constexpr size_t O_WEND = O_CTL + 65536;
static_assert(O_WEND <= 32 * MiB, "weight region");
constexpr size_t ROWB = (size_t)TP * 512 * 2;
constexpr size_t O_P = 32 * MiB;
constexpr size_t O_Q = O_P;
constexpr size_t O_V = O_Q + al256((size_t)TP * 768 * 2);
constexpr size_t O_EW = O_V + ROWB;
constexpr size_t O_B = O_EW + ROWB;
static_assert(O_B + ROWB <= O_P + al256((size_t)TP * NIN * 2), "aliases inside P");
constexpr size_t O_U1 = 193 * MiB;
constexpr size_t O_R = O_U1;
constexpr size_t O_VV = O_R + ROWB;
static_assert(O_P + al256((size_t)TP * NIN * 2) <= O_U1 && O_VV + ROWB <= 258 * MiB, "U1 region");
constexpr size_t O_KK = 258 * MiB;
constexpr size_t O_KMOD = O_KK + ROWB;
constexpr size_t O_LIN = O_KMOD + ROWB;
constexpr size_t O_CQKV = O_LIN + al256((size_t)TP * 384 * 2);
constexpr size_t O_K = O_CQKV + al256((size_t)TP * 640 * 2);
constexpr size_t O_G = O_K + al256((size_t)TP * 768 * 2);
constexpr size_t O_END1 = O_G + ROWB;
static_assert(O_END1 <= 512 * MiB, "ws");
constexpr size_t O_Y = O_LIN;
static_assert(O_Y + (size_t)TR * DM * 2 <= O_K, "Y alias");
constexpr size_t O_H2B = O_P;
constexpr size_t O_ACT = O_P + 64 * MiB;
static_assert(O_ACT + (size_t)TR * DFF * 2 <= O_Y, "ACT alias");
static_assert((size_t)TP * 512 * 4 <= (size_t)TR * DM * 4, "YRAW in d_out");

struct Params {
    const float* in[26];
    float* out;
    unsigned char* ws;
};

__device__ __forceinline__ unsigned f2bf(float f) { unsigned u = __builtin_bit_cast(unsigned, f); return (u + 0x7fffu + ((u >> 16) & 1u)) >> 16; }
__device__ __forceinline__ float bf2f(unsigned h) { return __builtin_bit_cast(float, h << 16); }
__device__ __forceinline__ unsigned pk2(float lo, float hi) { return f2bf(lo) | (f2bf(hi) << 16); }
__device__ __forceinline__ float wave_sum(float v) {
#pragma unroll
    for (int o = 1; o < 64; o <<= 1) v += __shfl_xor(v, o);
    return v;
}
__device__ __forceinline__ int lane_id_fresh() { int l; asm volatile("v_mbcnt_lo_u32_b32 %0, -1, 0\n\tv_mbcnt_hi_u32_b32 %0, -1, %0" : "=v"(l)); return l; }
__device__ __forceinline__ float sigmoidf_(float x) { return 1.f / (1.f + __expf(-x)); }
__device__ __forceinline__ int row_pos(int row) { int p = row % LP - LPAD; return p < 0 ? 0 : p; }

__constant__ double c_inv_freq[32] = {
    1.0, 0.7498942093324559, 0.5623413251903491, 0.4216965034285822, 0.31622776601683794, 0.23713737056616552, 0.1778279410038923, 0.1333521432163324,
    0.1, 0.07498942093324558, 0.05623413251903491, 0.04216965034285822, 0.03162277660168379, 0.023713737056616554, 0.01778279410038923, 0.01333521432163324,
    0.01, 0.007498942093324559, 0.005623413251903491, 0.004216965034285823, 0.0031622776601683794, 0.0023713737056616554, 0.0017782794100389228, 0.001333521432163324,
    0.001, 0.0007498942093324559, 0.0005623413251903491, 0.0004216965034285822, 0.00031622776601683794, 0.00023713737056616554, 0.00017782794100389227, 0.0001333521432163324};

__device__ __forceinline__ void sincos_d(double a, float& s, float& c) {
    const double q = __builtin_rint(a * 0.6366197723675814);
    double r = __builtin_fma(-q, 1.5707963267948966, a);
    r = __builtin_fma(-q, 6.123233995736766e-17, r);
    const double r2 = r * r;
    double sp = -1.0 / 1307674368000.0;
    sp = sp * r2 + 1.0 / 6227020800.0; sp = sp * r2 - 1.0 / 39916800.0; sp = sp * r2 + 1.0 / 362880.0; sp = sp * r2 - 1.0 / 5040.0; sp = sp * r2 + 1.0 / 120.0; sp = sp * r2 - 1.0 / 6.0;
    const double sn = r + r * r2 * sp;
    double cp = 1.0 / 87178291200.0;
    cp = cp * r2 - 1.0 / 479001600.0; cp = cp * r2 + 1.0 / 3628800.0; cp = cp * r2 - 1.0 / 40320.0; cp = cp * r2 + 1.0 / 720.0; cp = cp * r2 - 1.0 / 24.0; cp = cp * r2 + 0.5;
    const double cs = 1.0 - r2 * cp;
    const int qi = ((int)q) & 3;
    const double ss = (qi == 0) ? sn : (qi == 1) ? cs : (qi == 2) ? -sn : -cs;
    const double cc = (qi == 0) ? cs : (qi == 1) ? -sn : (qi == 2) ? -cs : sn;
    s = (float)ss; c = (float)cc;
}

struct SrcWin { const float* w; __device__ float operator()(int k, int n) const {
        if (n >= NIN) return 0.f; int ns = n;
        if (n >= 2464) { const int j = n - 2464; ns = 2464 + (j >> 1) + 32 * (j & 1); }
        return w[(size_t)k * NIN + ns]; } };
struct SrcWuq { const float* w; const float* g; __device__ float operator()(int k, int n) const {
        const int h = n / DQK, c = n % DQK; int cs = c; if (c >= 128) { const int j = c - 128; cs = 128 + (j >> 1) + 32 * (j & 1); }
        return w[(size_t)k * 768 + h * DQK + cs] * g[k]; } };
struct SrcWukv { const float* w; const float* g; __device__ float operator()(int k, int n) const { return w[(size_t)k * 1024 + n] * g[k]; } };
struct SrcLwa { const float* w2; const float* a2; __device__ float operator()(int k, int n) const {
        if (n < 512) return k < 64 ? w2[(size_t)k * 512 + n] : 0.f;
        return (k >= 64 && k < 128) ? a2[(size_t)(k - 64) * 512 + (n - 512)] : 0.f; } };
struct SrcLg { const float* g2; __device__ float operator()(int k, int n) const { return k < 160 ? g2[(size_t)k * 512 + n] : 0.f; } };
struct SrcWout { const float* w; __device__ float operator()(int k, int n) const { return w[(size_t)k * DM + n]; } };
struct SrcWgu { const float* wg; const float* wu; const float* g; __device__ float operator()(int k, int n) const {
        const int j = n >> 8, c = n & 255; const float v = c < 128 ? wg[(size_t)k * DFF + 128 * j + c] : wu[(size_t)k * DFF + 128 * j + (c - 128)];
        return v * g[k]; } };
struct SrcWdn { const float* w; __device__ float operator()(int k, int n) const { return w[(size_t)k * DM + n]; } };

template <class F>
__device__ __forceinline__ void wconv_item(const F& f, bf16_t* WT, int K, int nblk, int item, float* scr, int lane) {
    const int kb = item / nblk, nb = item % nblk, k0 = 64 * kb, n0 = 32 * nb;
#pragma unroll 8
    for (int i = 0; i < 32; ++i) { const int kk = 2 * i + (lane >> 5); scr[kk * 33 + (lane & 31)] = f(k0 + kk, n0 + (lane & 31)); }
    asm volatile("s_waitcnt lgkmcnt(0)" ::: "memory");
    const int c = lane & 7;
#pragma unroll
    for (int j = 0; j < 4; ++j) { const int n = (lane >> 3) + 8 * j; const float* s = scr + (8 * c) * 33 + n;
        u32x4 o; o.x = pk2(s[0 * 33], s[1 * 33]); o.y = pk2(s[2 * 33], s[3 * 33]); o.z = pk2(s[4 * 33], s[5 * 33]); o.w = pk2(s[6 * 33], s[7 * 33]);
        *(u32x4*)(WT + (size_t)(n0 + n) * K + k0 + 8 * c) = o; }
    asm volatile("s_waitcnt lgkmcnt(0)" ::: "memory");
}

__device__ __forceinline__ void p0_phase(const Params& p, float* scr_all, int gw, int ngw, int lane, int wave_in_block) {
    float* scr = scr_all + wave_in_block * (64 * 33);
    unsigned char* ws = p.ws;
    constexpr int I0 = (DM / 64) * (NINP / 32), I1 = (QL / 64) * (768 / 32), I2 = (KVL / 64) * (1024 / 32), I3 = (256 / 64) * (1024 / 32), I4 = (256 / 64) * (512 / 32),
                  I5 = (DM / 64) * (DM / 32), I6 = (DM / 64) * (2 * DFF / 32), I7 = (DFF / 64) * (DM / 32);
    constexpr int NIT = I0 + I1 + I2 + I3 + I4 + I5 + I6 + I7;
    for (int it = gw; it < NIT; it += ngw) {
        int r = it;
        if (r < I0) { wconv_item(SrcWin{p.in[3]}, (bf16_t*)(ws + O_WIN), DM, NINP / 32, r, scr, lane); continue; } r -= I0;
        if (r < I1) { wconv_item(SrcWuq{p.in[16], p.in[15]}, (bf16_t*)(ws + O_WUQ), QL, 768 / 32, r, scr, lane); continue; } r -= I1;
        if (r < I2) { wconv_item(SrcWukv{p.in[18], p.in[17]}, (bf16_t*)(ws + O_WUKV), KVL, 1024 / 32, r, scr, lane); continue; } r -= I2;
        if (r < I3) { wconv_item(SrcLwa{p.in[6], p.in[8]}, (bf16_t*)(ws + O_LWA), 256, 1024 / 32, r, scr, lane); continue; } r -= I3;
        if (r < I4) { wconv_item(SrcLg{p.in[9]}, (bf16_t*)(ws + O_LG), 256, 512 / 32, r, scr, lane); continue; } r -= I4;
        if (r < I5) { wconv_item(SrcWout{p.in[20]}, (bf16_t*)(ws + O_WOUT), DM, DM / 32, r, scr, lane); continue; } r -= I5;
        if (r < I6) { wconv_item(SrcWgu{p.in[22], p.in[23], p.in[21]}, (bf16_t*)(ws + O_WGU), DM, 2 * DFF / 32, r, scr, lane); continue; } r -= I6;
        wconv_item(SrcWdn{p.in[24]}, (bf16_t*)(ws + O_WDN), DFF, DM / 32, r, scr, lane);
    }
    const float* x = p.in[0]; const float* meta = p.in[1]; const float* g1 = p.in[2];
    bf16_t* U1 = (bf16_t*)(ws + O_U1);
    for (int row = gw; row < TP; row += ngw) {
        const int b = row / LP, pr = row % LP - LPAD;
        u32x2* o = (u32x2*)(U1 + (size_t)row * DM) + lane;
        if (pr < 0) {
#pragma unroll
            for (int j = 0; j < 4; ++j) o[64 * j] = (u32x2){0u, 0u};
            continue;
        }
        const float* src = pr < NMETA ? meta + (size_t)pr * DM : x + ((size_t)b * SEQ + (pr - NMETA)) * DM;
        const f32x4* xr = (const f32x4*)src + lane;
        f32x4 v[4]; float s = 0.f;
#pragma unroll
        for (int j = 0; j < 4; ++j) { v[j] = xr[64 * j]; s += (v[j].x * v[j].x + v[j].y * v[j].y) + (v[j].z * v[j].z + v[j].w * v[j].w); }
        const float rstd = 1.0f / sqrtf(wave_sum(s) * (1.f / DM) + RMS_EPS);
#pragma unroll
        for (int j = 0; j < 4; ++j) { const f32x4 g = ((const f32x4*)g1)[lane + 64 * j];
            o[64 * j] = (u32x2){pk2(v[j].x * rstd * g.x, v[j].y * rstd * g.y), pk2(v[j].z * rstd * g.z, v[j].w * rstd * g.w)}; }
    }
    float* rope = (float*)(ws + O_ROPE);
    for (int i = gw * 64 + lane; i < L * 32; i += ngw * 64) {
        const int pos = i >> 5, f = i & 31; float s, c; sincos_d((double)pos * c_inv_freq[f], s, c);
        rope[2 * i] = c; rope[2 * i + 1] = s;
    }
    float* ssq = (float*)(ws + O_SSQ2);
    for (int i = gw * 64 + lane; i < (int)((O_CTL - O_SSQ2) / 4); i += ngw * 64) ssq[i] = 0.f;
}

__device__ __forceinline__ void p2_row(const Params& p, int row, int lane) {
    unsigned char* ws = p.ws;
    const bf16_t* P = (const bf16_t*)(ws + O_P);
    const bf16_t* cur = P + (size_t)row * NIN; const bf16_t* prv = cur - NIN;
    const bool has_prev = row > 0;
    const float* mu = p.in[4]; const float* k_k = p.in[10];
    f16_t* R = (f16_t*)(ws + O_R); f16_t* VV = (f16_t*)(ws + O_VV); f16_t* KK = (f16_t*)(ws + O_KK); f16_t* KM = (f16_t*)(ws + O_KMOD);
    bf16_t* LIN = (bf16_t*)(ws + O_LIN); bf16_t* CQKV = (bf16_t*)(ws + O_CQKV); bf16_t* Kb = (bf16_t*)(ws + O_K);
    float ssq_q = 0.f, ssq_kv = 0.f;
    for (int ch = lane; ch < 320; ch += 64) {
        const bool act = ch < 316; const int c0 = 8 * ch;
        float v[8];
        {
            u32x4 a = (u32x4){0u, 0u, 0u, 0u};
            if (act) a = *(const u32x4*)(cur + c0);
            v[0] = bf2f(a.x & 0xffffu); v[1] = bf2f(a.x >> 16); v[2] = bf2f(a.y & 0xffffu); v[3] = bf2f(a.y >> 16);
            v[4] = bf2f(a.z & 0xffffu); v[5] = bf2f(a.z >> 16); v[6] = bf2f(a.w & 0xffffu); v[7] = bf2f(a.w >> 16);
        }
        if (c0 < RCOLS) {
            u32x4 b = (u32x4){0u, 0u, 0u, 0u};
            if (act && has_prev) b = *(const u32x4*)(prv + c0);
            float q[8];
            q[0] = bf2f(b.x & 0xffffu); q[1] = bf2f(b.x >> 16); q[2] = bf2f(b.y & 0xffffu); q[3] = bf2f(b.y >> 16);
            q[4] = bf2f(b.z & 0xffffu); q[5] = bf2f(b.z >> 16); q[6] = bf2f(b.w & 0xffffu); q[7] = bf2f(b.w >> 16);
#pragma unroll
            for (int j = 0; j < 8; ++j) v[j] = v[j] + (q[j] - v[j]) * mu[c0 + j];
        }
        const bool isk = (c0 >= 512 && c0 < 1024);
        float ss = 0.f; float kkv[8];
        if (isk) {
#pragma unroll
            for (int j = 0; j < 8; ++j) { kkv[j] = v[j] * k_k[c0 - 512 + j]; ss += kkv[j] * kkv[j]; }
        }
        ss += __shfl_xor(ss, 1); ss += __shfl_xor(ss, 2); ss += __shfl_xor(ss, 4);
        if (!act) continue;
        if (c0 < 512) {
#pragma unroll
            for (int j = 0; j < 8; ++j) R[(size_t)row * 512 + c0 + j] = (f16_t)v[j];
        } else if (c0 < 1024) {
            const float inv = 1.f / fmaxf(sqrtf(ss), 1e-12f);
#pragma unroll
            for (int j = 0; j < 8; ++j) { KM[(size_t)row * 512 + c0 - 512 + j] = (f16_t)v[j]; KK[(size_t)row * 512 + c0 - 512 + j] = (f16_t)(kkv[j] * inv); }
        } else if (c0 < 1536) {
#pragma unroll
            for (int j = 0; j < 8; ++j) VV[(size_t)row * 512 + c0 - 1024 + j] = (f16_t)v[j];
        } else if (c0 < 1600) {
#pragma unroll
            for (int j = 0; j < 8; ++j) LIN[(size_t)row * 384 + c0 - 1536 + j] = (bf16_t)f2bf(tanhf(v[j]));
        } else if (c0 < 1664) {
#pragma unroll
            for (int j = 0; j < 8; ++j) LIN[(size_t)row * 384 + c0 - 1536 + j] = (bf16_t)f2bf(v[j]);
        } else if (c0 < 1824) {
#pragma unroll
            for (int j = 0; j < 8; ++j) LIN[(size_t)row * 384 + c0 - 1536 + j] = (bf16_t)f2bf(sigmoidf_(v[j]));
        } else if (c0 < 2208) {
#pragma unroll
            for (int j = 0; j < 8; ++j) { CQKV[(size_t)row * 640 + c0 - 1824 + j] = (bf16_t)f2bf(v[j]); ssq_q += v[j] * v[j]; }
        } else if (c0 < 2464) {
#pragma unroll
            for (int j = 0; j < 8; ++j) { CQKV[(size_t)row * 640 + c0 - 1824 + j] = (bf16_t)f2bf(v[j]); ssq_kv += v[j] * v[j]; }
        } else {
            const float* t = (const float*)(ws + O_ROPE) + ((size_t)row_pos(row) * 32 + ((c0 - 2464) >> 1)) * 2;
            float o[8];
#pragma unroll
            for (int j = 0; j < 4; ++j) { const float cs = t[2 * j], sn = t[2 * j + 1]; o[2 * j] = v[2 * j] * cs - v[2 * j + 1] * sn; o[2 * j + 1] = v[2 * j + 1] * cs + v[2 * j] * sn; }
            u32x4 w; w.x = pk2(o[0], o[1]); w.y = pk2(o[2], o[3]); w.z = pk2(o[4], o[5]); w.w = pk2(o[6], o[7]);
#pragma unroll
            for (int h = 0; h < NH; ++h) *(u32x4*)(Kb + (size_t)row * 768 + h * DQK + 128 + (c0 - 2464)) = w;
        }
    }
    if (lane < 12) *(u32x4*)(LIN + (size_t)row * 384 + 288 + 8 * lane) = (u32x4){0u, 0u, 0u, 0u};
    ssq_q = wave_sum(ssq_q); ssq_kv = wave_sum(ssq_kv);
    if (lane == 0) { ((float*)(ws + O_RSTDQ))[row] = 1.0f / sqrtf(ssq_q * (1.f / QL) + RMS_EPS); ((float*)(ws + O_RSTDKV))[row] = 1.0f / sqrtf(ssq_kv * (1.f / KVL) + RMS_EPS); }
}
namespace pg8 {
#define PG8_LAS __attribute__((address_space(3)))
typedef short bf16x8 __attribute__((ext_vector_type(8)));
constexpr int BM = 256, BK = 64, HALF = 128, HTB = HALF * BK * 2, STAGE_BYTES = 8 * HTB, NXCD = 8, WGM = 8;
__host__ __device__ __forceinline__ int lds_byte(int r, int c) { const int st = (r >> 4) * 2 + (c >> 5), rr = r & 15, cc = c & 31, ob = rr * 64 + cc * 2; return st * 1024 + (ob ^ (((ob >> 9) & 1) << 5)); }
__host__ __device__ __forceinline__ void stage_rc(int b, int& R, int& C) { const int st = b / 1024, sb = b % 1024, swz = sb ^ (((sb >> 9) & 1) << 5); R = (st >> 1) * 16 + swz / 64; C = (st & 1) * 32 + (swz % 64) / 2; }
__host__ __device__ __forceinline__ int perm32(int rho) { const int n = rho >> 4, i = rho & 15; return 8 * (i >> 2) + 4 * n + (i & 3); }
struct Unit { int pm, pn; };
struct Gemm { const bf16_t* A; const bf16_t* Bt; int lda, ldb, K; };
struct StaticOrder {
    int nM, nN, nwg, G, c;
    __host__ __device__ void init(int M, int N, int G_, int c_) { nM = M / BM; nN = N / BM; nwg = nM * nN; G = G_; c = c_; }
    __host__ __device__ bool next(int i, Unit& u) const {
        const long L = (long)i * G + c; if (L >= nwg) return false;
        int wgid = (int)L; { const int q = nwg / NXCD, r = nwg % NXCD, xcd = wgid % NXCD, off = wgid / NXCD; wgid = (xcd < r ? xcd * (q + 1) : r * (q + 1) + (xcd - r) * q) + off; }
        const int nig = WGM * nN, gid = wgid / nig, fm = gid * WGM, gsz = (nM - fm) < WGM ? (nM - fm) : WGM;
        u.pm = fm + ((wgid % nig) % gsz); u.pn = (wgid % nig) / gsz; return true;
    }
};
template <class F> struct Epi8 {
    F f;
    __device__ __forceinline__ void operator()(const f32x4 (&acc)[2][2][4][2], const Unit& u, int wr, int wc, int fr, int fq) const {
        const int col = u.pn * BM + wc * 32 + 8 * fq;
#pragma unroll
        for (int ai = 0; ai < 2; ++ai)
#pragma unroll
            for (int m = 0; m < 4; ++m) f(u.pm * BM + ai * HALF + wr * 64 + m * 16 + fr, col, acc[ai][0][m][0], acc[ai][0][m][1], acc[ai][1][m][0], acc[ai][1][m][1]);
    }
};

template <class Epi, bool ALIGN_EPI>
__device__ __forceinline__ void gemm_phase(PG8_LAS unsigned char* lds, const Gemm g, const StaticOrder& S, const Epi& E) {
    const int tid = threadIdx.x, wid = __builtin_amdgcn_readfirstlane(tid >> 6), lane = tid & 63, wr = wid >> 2, wc = wid & 3, fr = lane & 15, fq = lane >> 4;
    const int K = g.K, nt = K / BK;
    unsigned voffA[2], voffB[2];
#pragma unroll
    for (int i = 0; i < 2; ++i) { int R, C; stage_rc(tid * 16 + i * 8192, R, C); const int Rb = (R & ~31) + perm32(R & 31);
        voffA[i] = (unsigned)(R * g.lda + C) * 2u; voffB[i] = (unsigned)(Rb * g.ldb + C) * 2u; }
    const size_t kstep = (size_t)(BK * 2);
    const size_t hstepA = (size_t)HALF * g.lda * 2, hstepB = (size_t)HALF * g.ldb * 2;
    const size_t tstepA = 2 * hstepA, tstepB = 2 * hstepB;
    const unsigned ldsw = (unsigned)wid * 1024u;
    const int aoff = lds_byte(wr * 64 + fr, fq * 8), boff = lds_byte(wc * 32 + fr, fq * 8);
#define PG8_SA(b, h) (((b) * 2 + (h)) * HTB)
#define PG8_SB(b, h) ((4 + (b) * 2 + (h)) * HTB)
#define PG8_STAGE(bufoff, gbase, voff) do { _Pragma("unroll") for (int _i = 0; _i < 2; ++_i) \
        __builtin_amdgcn_global_load_lds((const unsigned*)((const char*)(gbase) + (voff)[_i]), (PG8_LAS unsigned*)(lds + (bufoff) + ldsw + _i * 8192), 16, 0, 0); } while (0)
#define PG8_LDA(dst, b, h) do { _Pragma("unroll") for (int m = 0; m < 4; ++m) _Pragma("unroll") for (int k = 0; k < 2; ++k) dst[m][k] = *(const PG8_LAS bf16x8*)(lds + PG8_SA(b, h) + aoff + m * 2048 + k * 1024); } while (0)
#define PG8_LDB(dst, b, h) do { _Pragma("unroll") for (int n = 0; n < 2; ++n) _Pragma("unroll") for (int k = 0; k < 2; ++k) dst[n][k] = *(const PG8_LAS bf16x8*)(lds + PG8_SB(b, h) + boff + n * 2048 + k * 1024); } while (0)
#define PG8_MMA(ai, bj, At, Bt) do { __builtin_amdgcn_s_setprio(1); _Pragma("unroll") for (int m = 0; m < 4; ++m) _Pragma("unroll") for (int n = 0; n < 2; ++n) _Pragma("unroll") for (int k = 0; k < 2; ++k) \
        acc[ai][bj][m][n] = __builtin_amdgcn_mfma_f32_16x16x32_bf16(Bt[n][k], At[m][k], acc[ai][bj][m][n], 0, 0, 0); __builtin_amdgcn_s_setprio(0); } while (0)
#define PG8_WAIT_V(n) asm volatile("s_waitcnt vmcnt(" #n ")" ::: "memory")
#define PG8_WAIT_L(n) asm volatile("s_waitcnt lgkmcnt(" #n ")" ::: "memory")
#define PG8_BAR __builtin_amdgcn_s_barrier()
#define PG8_SCHED __builtin_amdgcn_sched_barrier(0)
    Unit cur, nxt; int ui = 0;
    if (!S.next(0, cur)) return;
    f32x4 acc[2][2][4][2];
#pragma unroll
    for (int a = 0; a < 2; ++a)
#pragma unroll
        for (int b = 0; b < 2; ++b)
#pragma unroll
            for (int m = 0; m < 4; ++m)
#pragma unroll
                for (int n = 0; n < 2; ++n) acc[a][b][m][n] = (f32x4){0.f, 0.f, 0.f, 0.f};
    bf16x8 At[4][2], B0[2][2], B1[2][2];
    const char* cA = (const char*)g.A + (size_t)cur.pm * tstepA; const char* cB = (const char*)g.Bt + (size_t)cur.pn * tstepB;
    PG8_STAGE(PG8_SB(0, 0), cB, voffB); PG8_STAGE(PG8_SB(0, 1), cB + hstepB, voffB); PG8_STAGE(PG8_SA(0, 0), cA, voffA); PG8_STAGE(PG8_SA(0, 1), cA + hstepA, voffA);
    if (wr == 1) PG8_BAR;
    PG8_WAIT_V(2); PG8_BAR;
    PG8_STAGE(PG8_SB(1, 0), cB + kstep, voffB); PG8_STAGE(PG8_SA(1, 0), cA + kstep, voffA); PG8_STAGE(PG8_SB(1, 1), cB + hstepB + kstep, voffB);
    PG8_WAIT_V(6); PG8_BAR;
#pragma nounroll
    for (;;) {
        const bool has_next = S.next(ui + 1, nxt);
        const char* nA = has_next ? (const char*)g.A + (size_t)nxt.pm * tstepA : cA; const char* nB = has_next ? (const char*)g.Bt + (size_t)nxt.pn * tstepB : cB;
#pragma nounroll
        for (int t = 0; t < nt; t += 2) {
            const bool last = (t == nt - 2);
            const char* a1 = cA + (size_t)(t + 1) * kstep;
            const char* a2 = last ? nA : cA + (size_t)(t + 2) * kstep; const char* b2 = last ? nB : cB + (size_t)(t + 2) * kstep;
            const char* a3 = a2 + kstep; const char* b3 = b2 + kstep;
            PG8_LDB(B0, 0, 0); PG8_LDB(B1, 0, 1); PG8_SCHED; PG8_LDA(At, 0, 0); PG8_STAGE(PG8_SA(1, 1), a1 + hstepA, voffA);
            PG8_WAIT_V(8); PG8_WAIT_L(0); PG8_BAR; PG8_MMA(0, 0, At, B0); PG8_MMA(0, 1, At, B1); PG8_BAR; PG8_SCHED;
            PG8_LDA(At, 0, 1); PG8_STAGE(PG8_SB(0, 0), b2, voffB); PG8_STAGE(PG8_SB(0, 1), b2 + hstepB, voffB); PG8_STAGE(PG8_SA(0, 0), a2, voffA);
            PG8_WAIT_V(8); PG8_WAIT_L(0); PG8_BAR; PG8_MMA(1, 0, At, B0); PG8_MMA(1, 1, At, B1); PG8_BAR; PG8_SCHED;
            PG8_LDB(B0, 1, 0); PG8_LDB(B1, 1, 1); PG8_SCHED; PG8_LDA(At, 1, 0); PG8_STAGE(PG8_SA(0, 1), a2 + hstepA, voffA);
            PG8_WAIT_V(8); PG8_WAIT_L(0); PG8_BAR; PG8_MMA(0, 0, At, B0); PG8_MMA(0, 1, At, B1); PG8_BAR; PG8_SCHED;
            PG8_LDA(At, 1, 1); PG8_STAGE(PG8_SB(1, 0), b3, voffB); PG8_STAGE(PG8_SB(1, 1), b3 + hstepB, voffB); PG8_STAGE(PG8_SA(1, 0), a3, voffA);
            PG8_WAIT_V(8); PG8_WAIT_L(0); PG8_BAR; PG8_MMA(1, 0, At, B0); PG8_MMA(1, 1, At, B1); PG8_BAR; PG8_SCHED;
        }
        if constexpr (ALIGN_EPI) { if (wr == 0) PG8_BAR; }
        E(acc, cur, wr, wc, fr, fq);
        if (!has_next) break;
#pragma unroll
        for (int a = 0; a < 2; ++a)
#pragma unroll
            for (int b = 0; b < 2; ++b)
#pragma unroll
                for (int m = 0; m < 4; ++m)
#pragma unroll
                    for (int n = 0; n < 2; ++n) acc[a][b][m][n] = (f32x4){0.f, 0.f, 0.f, 0.f};
        cur = nxt; cA = nA; cB = nB; ++ui;
        if constexpr (ALIGN_EPI) { if (wr == 1) PG8_BAR; }
    }
    PG8_WAIT_V(0);
    if constexpr (!ALIGN_EPI) { if (wr == 0) PG8_BAR; }
    PG8_BAR;
#undef PG8_SA
#undef PG8_SB
#undef PG8_STAGE
#undef PG8_LDA
#undef PG8_LDB
#undef PG8_MMA
#undef PG8_WAIT_V
#undef PG8_WAIT_L
#undef PG8_BAR
#undef PG8_SCHED
}
}

__device__ __forceinline__ u32x4 pack8(const f32x4& a0, const f32x4& a1) { u32x4 w; w.x = pk2(a0[0], a0[1]); w.y = pk2(a0[2], a0[3]); w.z = pk2(a1[0], a1[1]); w.w = pk2(a1[2], a1[3]); return w; }
typedef _Float16 f16x8 __attribute__((ext_vector_type(8)));
struct FP {
    bf16_t* P;
    __device__ __forceinline__ void operator()(int row, int col, const f32x4& a0, const f32x4& a1, const f32x4& b0, const f32x4& b1) const {
        if (col < NIN) *(u32x4*)(P + (size_t)row * NIN + col) = pack8(a0, a1);
        if (col + 128 < NIN) *(u32x4*)(P + (size_t)row * NIN + col + 128) = pack8(b0, b1);
    }
};
struct FQ {
    bf16_t* Q; const float* rstd; const float* rope;
    __device__ __forceinline__ void one(int row, int col, float rs, f32x4 a0, f32x4 a1) const {
        a0 = a0 * rs; a1 = a1 * rs;
        const int c = col % DQK;
        if (c >= 128) { const f32x4* t = (const f32x4*)(rope + ((size_t)row_pos(row) * 32 + ((c - 128) >> 1)) * 2); const f32x4 t0 = t[0], t1 = t[1];
            f32x4 o0, o1;
            o0[0] = a0[0] * t0[0] - a0[1] * t0[1]; o0[1] = a0[1] * t0[0] + a0[0] * t0[1]; o0[2] = a0[2] * t0[2] - a0[3] * t0[3]; o0[3] = a0[3] * t0[2] + a0[2] * t0[3];
            o1[0] = a1[0] * t1[0] - a1[1] * t1[1]; o1[1] = a1[1] * t1[0] + a1[0] * t1[1]; o1[2] = a1[2] * t1[2] - a1[3] * t1[3]; o1[3] = a1[3] * t1[2] + a1[2] * t1[3];
            a0 = o0; a1 = o1; }
        *(u32x4*)(Q + (size_t)row * 768 + col) = pack8(a0, a1);
    }
    __device__ __forceinline__ void operator()(int row, int col, const f32x4& a0, const f32x4& a1, const f32x4& b0, const f32x4& b1) const {
        const float rs = rstd[row] * QSCALE; one(row, col, rs, a0, a1); one(row, col + 128, rs, b0, b1); }
};
struct FKV {
    bf16_t* K; bf16_t* V; const float* rstd;
    __device__ __forceinline__ void one(int row, int col, float rs, const f32x4& a0, const f32x4& a1) const {
        const int h = col >> 8, c = col & 255; const u32x4 w = pack8(a0 * rs, a1 * rs);
        if (c < 128) *(u32x4*)(K + (size_t)row * 768 + h * DQK + c) = w; else *(u32x4*)(V + (size_t)row * 512 + h * DV + (c - 128)) = w; }
    __device__ __forceinline__ void operator()(int row, int col, const f32x4& a0, const f32x4& a1, const f32x4& b0, const f32x4& b1) const {
        const float rs = rstd[row]; one(row, col, rs, a0, a1); one(row, col + 128, rs, b0, b1); }
};
struct FLwa {
    f16_t* EW; f16_t* KMOD; const f16_t* KK; f16_t* Bv; const float* w0; const float* a0p; const float* k_a;
    __device__ __forceinline__ void one(int row, int col, const f32x4& a0, const f32x4& a1) const {
        float v[8] = {a0[0], a0[1], a0[2], a0[3], a1[0], a1[1], a1[2], a1[3]};
        if (col < 512) {
            f16x8 o;
#pragma unroll
            for (int j = 0; j < 8; ++j) { const float xx = w0[col + j] + v[j]; const float sp = (-xx > 20.f) ? -xx : __logf(1.f + __expf(-xx)); o[j] = (f16_t)__expf(-sp - 0.5f); }
            *(f16x8*)(EW + (size_t)row * 512 + col) = o;
        } else {
            const int c = col - 512; const size_t idx = (size_t)row * 512 + c;
            const f16x8 kv = *(const f16x8*)(KMOD + idx), kkv = *(const f16x8*)(KK + idx); f16x8 ko, bo;
#pragma unroll
            for (int j = 0; j < 8; ++j) { const float a = sigmoidf_(a0p[c + j] + v[j]); ko[j] = (f16_t)((float)kv[j] * (1.f + (a - 1.f) * k_a[c + j])); bo[j] = (f16_t)((float)kkv[j] * a); }
            *(f16x8*)(KMOD + idx) = ko; *(f16x8*)(Bv + idx) = bo;
        }
    }
    __device__ __forceinline__ void operator()(int row, int col, const f32x4& a0, const f32x4& a1, const f32x4& b0, const f32x4& b1) const { one(row, col, a0, a1); one(row, col + 128, b0, b1); }
};
struct FG { bf16_t* G;
    __device__ __forceinline__ void operator()(int row, int col, const f32x4& a0, const f32x4& a1, const f32x4& b0, const f32x4& b1) const {
        *(u32x4*)(G + (size_t)row * 512 + col) = pack8(a0, a1); *(u32x4*)(G + (size_t)row * 512 + col + 128) = pack8(b0, b1); } };
struct FOut {
    const float* x; float* H2; bf16_t* H2B; float* ssq;
    __device__ __forceinline__ float one(size_t idx, const f32x4& a0, const f32x4& a1) const {
        const f32x4 h0 = *(const f32x4*)(x + idx) + a0, h1 = *(const f32x4*)(x + idx + 4) + a1;
        *(f32x4*)(H2 + idx) = h0; *(f32x4*)(H2 + idx + 4) = h1; *(u32x4*)(H2B + idx) = pack8(h0, h1);
        return (h0[0] * h0[0] + h0[1] * h0[1]) + (h0[2] * h0[2] + h0[3] * h0[3]) + (h1[0] * h1[0] + h1[1] * h1[1]) + (h1[2] * h1[2] + h1[3] * h1[3]); }
    __device__ __forceinline__ void operator()(int row, int col, const f32x4& a0, const f32x4& a1, const f32x4& b0, const f32x4& b1) const {
        float s = one((size_t)row * DM + col, a0, a1) + one((size_t)row * DM + col + 128, b0, b1);
        s += __shfl_xor(s, 16); s += __shfl_xor(s, 32);
        if ((threadIdx.x & 63) < 16) atomicAdd(ssq + row, s); }
};
struct FAct {
    bf16_t* ACT; const float* ssq;
    __device__ __forceinline__ void operator()(int row, int col, const f32x4& a0, const f32x4& a1, const f32x4& b0, const f32x4& b1) const {
        const float rs = 1.0f / sqrtf(ssq[row] * (1.f / DM) + RMS_EPS);
        f32x4 o0, o1;
#pragma unroll
        for (int j = 0; j < 4; ++j) { const float g0 = a0[j] * rs, g1 = a1[j] * rs; o0[j] = g0 * sigmoidf_(g0) * (b0[j] * rs); o1[j] = g1 * sigmoidf_(g1) * (b1[j] * rs); }
        *(u32x4*)(ACT + (size_t)row * DFF + (col >> 8) * 128 + (col & 127)) = pack8(o0, o1); }
};
struct FDown {
    float* H; float* ssq;
    __device__ __forceinline__ float one(size_t idx, const f32x4& a0, const f32x4& a1) const {
        const f32x4 h0 = *(const f32x4*)(H + idx) + a0, h1 = *(const f32x4*)(H + idx + 4) + a1; *(f32x4*)(H + idx) = h0; *(f32x4*)(H + idx + 4) = h1;
        return (h0[0] * h0[0] + h0[1] * h0[1]) + (h0[2] * h0[2] + h0[3] * h0[3]) + (h1[0] * h1[0] + h1[1] * h1[1]) + (h1[2] * h1[2] + h1[3] * h1[3]); }
    __device__ __forceinline__ void operator()(int row, int col, const f32x4& a0, const f32x4& a1, const f32x4& b0, const f32x4& b1) const {
        float s = one((size_t)row * DM + col, a0, a1) + one((size_t)row * DM + col + 128, b0, b1);
        s += __shfl_xor(s, 16); s += __shfl_xor(s, 32);
        if ((threadIdx.x & 63) < 16) atomicAdd(ssq + row, s); }
};

__device__ __forceinline__ void scan_simple_unit(const Params& p, int unit, int t256) {
    unsigned char* ws = p.ws;
    const f16_t* R = (const f16_t*)(ws + O_R); const f16_t* VV = (const f16_t*)(ws + O_VV); const f16_t* KK = (const f16_t*)(ws + O_KK); const f16_t* KM = (const f16_t*)(ws + O_KMOD);
    const f16_t* EW = (const f16_t*)(ws + O_EW); const f16_t* Bv = (const f16_t*)(ws + O_B);
    float* YRAW = p.out;
    const int bh = unit >> 2, quarter = unit & 3, b = bh >> 3, h = bh & 7;
    const int il = t256 >> 4, c = t256 & 15, i = 16 * quarter + il;
    float S[4] = {0.f, 0.f, 0.f, 0.f};
    const size_t base = ((size_t)b * LP + LPAD) * 512 + h * 64;
    for (int t = 0; t < L; ++t) {
        const size_t o = base + (size_t)t * 512 + 4 * c;
        float w[4], kk[4], bb[4], k[4], r[4];
#pragma unroll
        for (int j = 0; j < 4; ++j) { w[j] = __expf(-(float)EW[o + j]); kk[j] = (float)KK[o + j]; bb[j] = (float)Bv[o + j]; k[j] = (float)KM[o + j]; r[j] = (float)R[o + j]; }
        const float v = (float)VV[base + (size_t)t * 512 + i];
        float sa = 0.f;
#pragma unroll
        for (int j = 0; j < 4; ++j) sa += S[j] * kk[j];
        sa += __shfl_xor(sa, 1); sa += __shfl_xor(sa, 2); sa += __shfl_xor(sa, 4); sa += __shfl_xor(sa, 8);
        sa = -sa;
        float y = 0.f;
#pragma unroll
        for (int j = 0; j < 4; ++j) { S[j] = S[j] * w[j] + sa * bb[j] + v * k[j]; y += S[j] * r[j]; }
        y += __shfl_xor(y, 1); y += __shfl_xor(y, 2); y += __shfl_xor(y, 4); y += __shfl_xor(y, 8);
        if (c == 0) YRAW[base + (size_t)t * 512 + i] = y;
    }
}

__device__ __forceinline__ void attn_simple_unit(const Params& p, float* sm, int unit, int tid) {
    float* Qs = sm;
    float* Ks = Qs + 64 * 192;
    float* Vs = Ks + 64 * 193;
    float* Ps = Vs + 64 * 128;
    unsigned char* ws = p.ws;
    const bf16_t* Q = (const bf16_t*)(ws + O_Q); const bf16_t* Kb = (const bf16_t*)(ws + O_K); const bf16_t* V = (const bf16_t*)(ws + O_V);
    bf16_t* Y = (bf16_t*)(ws + O_Y); const float* og = p.in[19];
    const int qt = unit & 63, h = (unit >> 6) & 3, b = unit >> 8;
    const size_t rb = (size_t)b * LP;
    const int qrow0 = 64 + 64 * qt;
    __syncthreads();
    for (int i = tid; i < 64 * 192; i += 512) { const int r = i / 192, d = i % 192; Qs[i] = bf2f(Q[(rb + qrow0 + r) * 768 + h * DQK + d]); }
    const int qi = (tid & 255) >> 2, sub = tid & 3; const bool act = tid < 256;
    float m = -1e30f, l = 0.f; float o[32];
#pragma unroll
    for (int j = 0; j < 32; ++j) o[j] = 0.f;
    const int nkt = qt + 2;
    for (int kt = 0; kt < nkt; ++kt) {
        __syncthreads();
        for (int i = tid; i < 64 * 192; i += 512) { const int r = i / 192, d = i % 192; Ks[r * 193 + d] = bf2f(Kb[(rb + 64 * kt + r) * 768 + h * DQK + d]); }
        for (int i = tid; i < 64 * 128; i += 512) { const int r = i >> 7, d = i & 127; Vs[i] = bf2f(V[(rb + 64 * kt + r) * 512 + h * DV + d]); }
        __syncthreads();
        float scale = 1.f;
        if (act) {
            float sc[16]; float mx = -1e30f;
#pragma unroll
            for (int kk = 0; kk < 16; ++kk) {
                const int key = sub + 4 * kk; float s = 0.f;
                for (int d = 0; d < 192; ++d) s += Qs[qi * 192 + d] * Ks[key * 193 + d];
                const int krow = 64 * kt + key;
                if (krow < LPAD || krow > qrow0 + qi) s = -1e30f;
                sc[kk] = s; mx = fmaxf(mx, s);
            }
            mx = fmaxf(mx, __shfl_xor(mx, 1)); mx = fmaxf(mx, __shfl_xor(mx, 2));
            const float mn = fmaxf(m, mx); scale = exp2f(m - mn);
            float ps = 0.f;
#pragma unroll
            for (int kk = 0; kk < 16; ++kk) { const float pv = (sc[kk] <= -1e29f) ? 0.f : exp2f(sc[kk] - mn); Ps[qi * 65 + sub + 4 * kk] = pv; ps += pv; }
            ps += __shfl_xor(ps, 1); ps += __shfl_xor(ps, 2);
            l = l * scale + ps; m = mn;
        }
        __syncthreads();
        if (act) {
#pragma unroll
            for (int j = 0; j < 32; ++j) o[j] *= scale;
            for (int key = 0; key < 64; ++key) { const float pv = Ps[qi * 65 + key];
#pragma unroll
                for (int j = 0; j < 32; ++j) o[j] += pv * Vs[key * 128 + sub * 32 + j]; }
        }
    }
    if (act) {
        const float il = 1.f / l; float ss = 0.f;
#pragma unroll
        for (int j = 0; j < 32; ++j) { o[j] *= il; ss += o[j] * o[j]; }
        ss += __shfl_xor(ss, 1); ss += __shfl_xor(ss, 2);
        const float rs = 1.0f / sqrtf(ss * (1.f / DV) + RMS_EPS);
        const size_t yrow = (size_t)b * SEQ + 64 * qt + qi;
#pragma unroll
        for (int j = 0; j < 32; ++j) Y[yrow * DM + 512 + h * DV + sub * 32 + j] = (bf16_t)f2bf(o[j] * rs * og[h * DV + sub * 32 + j]);
    }
}

namespace scan {
#define SC_LAS __attribute__((address_space(3)))
constexpr int TS = 32, STEP_F = 5 * 64 + 16, BUF_F = TS * STEP_F, NCH = (L + TS - 1) / TS;
constexpr int SCAN_LDS = 2 * BUF_F * 4;
typedef _Float16 h8 __attribute__((ext_vector_type(8)));
typedef _Float16 h2 __attribute__((ext_vector_type(2)));
template <int CTRL> __device__ __forceinline__ float dppf(float x) { return __builtin_bit_cast(float, __builtin_amdgcn_update_dpp(0, __builtin_bit_cast(int, x), CTRL, 0xF, 0xF, true)); }
__device__ __forceinline__ float row_sum16(float x) { x += dppf<0xB1>(x); x += dppf<0x4E>(x); x += dppf<0x141>(x); x += dppf<0x140>(x); return x; }

__device__ __forceinline__ void scan_unit(const Params& p, SC_LAS float* lds, int unit) {
    unsigned char* ws = p.ws;
    const int tid = threadIdx.x, lane = tid & 63; const int wave = __builtin_amdgcn_readfirstlane(tid >> 6);
    const int bh = unit >> 2, quarter = unit & 3, b = bh >> 3, h = bh & 7;
    const size_t ebase = ((size_t)b * LP + LPAD) * 512 + h * 64;
    __syncthreads();
    if (wave >= 4) {
        const f16_t* src[5] = {(const f16_t*)(ws + O_EW), (const f16_t*)(ws + O_KK), (const f16_t*)(ws + O_B), (const f16_t*)(ws + O_KMOD), (const f16_t*)(ws + O_R)};
        const f16_t* VV = (const f16_t*)(ws + O_VV);
        const int t2 = tid - 256, tt = t2 >> 3, c8 = (t2 & 7) * 8, pr = t2 & 7;
#pragma nounroll
        for (int ch = 0; ch <= NCH; ++ch) {
            if (ch < NCH) {
                const int t = ch * TS + tt;
                if (t < L) {
                    SC_LAS float* dst = lds + (ch & 1) * BUF_F + tt * STEP_F;
                    const size_t e = ebase + (size_t)t * 512;
#pragma unroll
                    for (int a = 0; a < 5; ++a) {
                        const h8 v = *(const h8*)(src[a] + e + c8);
                        f32x4 lo, hi;
#pragma unroll
                        for (int j = 0; j < 4; ++j) { lo[j] = (float)v[j]; hi[j] = (float)v[4 + j]; }
                        if (a == 0) {
#pragma unroll
                            for (int j = 0; j < 4; ++j) { lo[j] = __expf(-lo[j]); hi[j] = __expf(-hi[j]); }
                        }
                        *(SC_LAS f32x4*)(dst + a * 64 + c8) = lo; *(SC_LAS f32x4*)(dst + a * 64 + c8 + 4) = hi;
                    }
                    const h2 vv = *(const h2*)(VV + e + 16 * quarter + 2 * pr);
                    dst[320 + 2 * pr] = (float)vv[0]; dst[320 + 2 * pr + 1] = (float)vv[1];
                }
            }
            __syncthreads();
        }
    } else {
        const int g = lane >> 4, c = lane & 15, i = 16 * quarter + 4 * wave + g;
        float* yout = p.out + ebase + i;
        typedef float f2 __attribute__((ext_vector_type(2)));
        f2 S01 = {0.f, 0.f}, S23 = {0.f, 0.f};
        __syncthreads();
#pragma nounroll
        for (int ch = 0; ch < NCH; ++ch) {
            const SC_LAS float* st = lds + (ch & 1) * BUF_F + 4 * c;
            const SC_LAS float* sv = lds + (ch & 1) * BUF_F + 320 + 4 * wave + g;
            const int n = (L - ch * TS) < TS ? (L - ch * TS) : TS;
            float* yo = yout + (size_t)(ch * TS + c) * 512;
#pragma nounroll
            for (int tb = 0; tb < n; tb += 16) {
                float ykeep = 0.f;
#pragma unroll
                for (int tt = 0; tt < 16; ++tt) {
                    const f32x4 w4 = *(const SC_LAS f32x4*)(st + tt * STEP_F), kk4 = *(const SC_LAS f32x4*)(st + tt * STEP_F + 64), b4 = *(const SC_LAS f32x4*)(st + tt * STEP_F + 128),
                                k4 = *(const SC_LAS f32x4*)(st + tt * STEP_F + 192), r4 = *(const SC_LAS f32x4*)(st + tt * STEP_F + 256);
                    const float v = sv[tt * STEP_F];
                    f2 pa = S01 * (f2){kk4[0], kk4[1]}; pa = S23 * (f2){kk4[2], kk4[3]} + pa;
                    const float sa = -row_sum16(pa.x + pa.y);
                    const f2 sa2 = {sa, sa}, v2 = {v, v};
                    f2 t01 = v2 * (f2){k4[0], k4[1]}, t23 = v2 * (f2){k4[2], k4[3]};
                    t01 = sa2 * (f2){b4[0], b4[1]} + t01; t23 = sa2 * (f2){b4[2], b4[3]} + t23;
                    S01 = S01 * (f2){w4[0], w4[1]} + t01; S23 = S23 * (f2){w4[2], w4[3]} + t23;
                    f2 py = S01 * (f2){r4[0], r4[1]}; py = S23 * (f2){r4[2], r4[3]} + py;
                    const float y = row_sum16(py.x + py.y);
                    ykeep = (c == tt) ? y : ykeep;
                }
                yo[(size_t)tb * 512] = ykeep;
                st += 16 * STEP_F; sv += 16 * STEP_F;
            }
            __syncthreads();
        }
    }
}
}

namespace chk {
#define CK_LAS __attribute__((address_space(3)))
constexpr int C = 32, NCH = (L + C - 1) / C, NCHH = NB * RH * NCH;
constexpr size_t OUT_PS = 0, OUT_QS = OUT_PS + (size_t)NCHH * 8192, OUT_QY = OUT_QS + (size_t)NCHH * 4096, OUT_END = OUT_QY + (size_t)NCHH * 2048;
static_assert(OUT_END <= (size_t)TR * DM * 4, "chunk matrices fit d_out");
constexpr size_t O_PY = O_END1;
static_assert(O_PY + (size_t)NCHH * 4096 <= 512 * MiB, "Py fits the ws tail");
constexpr size_t O_YRAW = O_EW;
static_assert(O_B == O_EW + ROWB, "YRAW overlay");
typedef short bf16x8 __attribute__((ext_vector_type(8)));

__device__ __forceinline__ void pre_simple(const Params& p, float* sm, int ch_head) {
    unsigned char* ws = p.ws;
    const int tid = threadIdx.x;
    const int bh = ch_head / NCH, ch = ch_head % NCH, b = bh >> 3, h = bh & 7;
    const size_t ebase = ((size_t)b * LP + LPAD) * 512 + h * 64;
    const f16_t* EW = (const f16_t*)(ws + O_EW); const f16_t* KK = (const f16_t*)(ws + O_KK); const f16_t* Bv = (const f16_t*)(ws + O_B); const f16_t* KM = (const f16_t*)(ws + O_KMOD); const f16_t* R = (const f16_t*)(ws + O_R);
    float* At = sm; float* Rt = At + 2048; float* Bt = Rt + 2048; float* Kt = Bt + 2048;
    float* Lm = Kt + 2048; float* Gak = Lm + 1024; float* Gbr = Gak + 1024; float* Gkr = Gbr + 1024;
    float* NT = Gkr + 1024; float* Ah = NT + 1024; float* Gh = Ah + 2048; float* WC = Gh + 1024;
    __syncthreads();
    if (tid < 64) {
        float W = 1.f;
        for (int t = 0; t < C; ++t) {
            const int pos = ch * C + t; float w = 1.f, kk = 0.f, bb = 0.f, k = 0.f, r = 0.f;
            if (pos < L) { const size_t e = ebase + (size_t)pos * 512 + tid; w = __expf(-(float)EW[e]); kk = (float)KK[e]; bb = (float)Bv[e]; k = (float)KM[e]; r = (float)R[e]; }
            const float Wp = W; W *= w; const float iw = 1.f / W;
            At[t * 64 + tid] = -kk * Wp; Rt[t * 64 + tid] = r * W; Bt[t * 64 + tid] = bb * iw; Kt[t * 64 + tid] = k * iw;
        }
        WC[tid] = W;
    }
    __syncthreads();
    for (int e = tid; e < 1024; e += 512) { const int s = e >> 5, t = e & 31; float gab = 0.f, gak = 0.f, gbr = 0.f, gkr = 0.f;
        for (int j = 0; j < 64; ++j) { const float a = At[t * 64 + j], r = Rt[t * 64 + j], bb = Bt[s * 64 + j], k = Kt[s * 64 + j]; gab += bb * a; gak += k * a; gbr += bb * r; gkr += k * r; }
        Lm[t * 32 + s] = s < t ? gab : 0.f; Gak[s * 32 + t] = s < t ? gak : 0.f; Gbr[s * 32 + t] = s <= t ? gbr : 0.f; Gkr[s * 32 + t] = s <= t ? gkr : 0.f; }
    __syncthreads();
    if (tid < 32) {
        for (int t = 0; t < C; ++t) { float x = (t == tid) ? 1.f : 0.f; for (int s = 0; s < t; ++s) x += Lm[t * 32 + s] * NT[s * 32 + tid]; NT[t * 32 + tid] = x; }
    }
    __syncthreads();
    for (int e = tid; e < 2048; e += 512) { const int t = e >> 6, j = e & 63; float x = 0.f; for (int s = 0; s < C; ++s) x += NT[t * 32 + s] * At[s * 64 + j]; Ah[e] = x; }
    for (int e = tid; e < 1024; e += 512) { const int t = e >> 5, s2 = e & 31; float x = 0.f; for (int s = 0; s < C; ++s) x += NT[t * 32 + s] * Gak[s2 * 32 + s]; Gh[e] = x; }
    __syncthreads();
    bf16_t* Ps = (bf16_t*)((unsigned char*)p.out + OUT_PS) + (size_t)ch_head * 4096; bf16_t* Qs = (bf16_t*)((unsigned char*)p.out + OUT_QS) + (size_t)ch_head * 2048;
    bf16_t* Qy = (bf16_t*)((unsigned char*)p.out + OUT_QY) + (size_t)ch_head * 1024; bf16_t* Py = (bf16_t*)(ws + O_PY) + (size_t)ch_head * 2048;
    for (int e = tid; e < 4096; e += 512) { const int j = e >> 6, j2 = e & 63; float x = (j == j2) ? 1.f : 0.f; for (int s = 0; s < C; ++s) x += Bt[s * 64 + j] * Ah[s * 64 + j2]; Ps[e] = (bf16_t)f2bf(x * WC[j]); }
    for (int e = tid; e < 2048; e += 512) { const int j = e >> 5, s2 = e & 31; float x = Kt[s2 * 64 + j]; for (int s = 0; s < C; ++s) x += Bt[s * 64 + j] * Gh[s * 32 + s2]; Qs[e] = (bf16_t)f2bf(x * WC[j]); }
    for (int e = tid; e < 2048; e += 512) { const int t = e >> 6, j = e & 63; float x = Rt[e]; for (int s = 0; s < C; ++s) x += Gbr[s * 32 + t] * Ah[s * 64 + j]; Py[e] = (bf16_t)f2bf(x); }
    for (int e = tid; e < 1024; e += 512) { const int t = e >> 5, s2 = e & 31; float x = Gkr[s2 * 32 + t]; for (int s = 0; s < C; ++s) x += Gbr[s * 32 + t] * Gh[s * 32 + s2]; Qy[e] = (bf16_t)f2bf(x); }
}

typedef float f32x16 __attribute__((ext_vector_type(16)));
typedef short s16x4 __attribute__((ext_vector_type(4)));
constexpr int TMS = 144, TMB = 32 * TMS;
constexpr int L_TM = 0, L_LF = 4 * TMB, L_NT = L_LF + 4096, NTS = 80, L_WC = L_NT + 32 * NTS, PRE_LDS = L_WC + 256;
constexpr int PRE_WAVES = 6;
static_assert(PRE_WAVES * PRE_LDS + 256 <= 153600, "precompute LDS");
__device__ __forceinline__ int crow(int i, int hi) { return (i & 3) + 8 * (i >> 2) + 4 * hi; }
__device__ __forceinline__ unsigned cvtpk(float lo, float hi) { typedef float f2_ __attribute__((ext_vector_type(2))); typedef __bf16 b2_ __attribute__((ext_vector_type(2))); f2_ v = {lo, hi}; b2_ b = __builtin_convertvector(v, b2_); return __builtin_bit_cast(unsigned, b); }
__device__ __forceinline__ s16x4 trd(const CK_LAS unsigned char* p) { return __builtin_bit_cast(s16x4, __builtin_amdgcn_ds_read_tr16_b64_v4i16((CK_LAS s16x4*)p)); }
__device__ __forceinline__ bf16x8 dfrag(const f32x16& x, int s) {
    const u32x4 w = (u32x4){cvtpk(x[8 * s], x[8 * s + 1]), cvtpk(x[8 * s + 2], x[8 * s + 3]), cvtpk(x[8 * s + 4], x[8 * s + 5]), cvtpk(x[8 * s + 6], x[8 * s + 7])};
    return __builtin_bit_cast(bf16x8, w);
}
__device__ __forceinline__ f32x16 zero16() { f32x16 z; _Pragma("unroll") for (int i = 0; i < 16; ++i) z[i] = 0.f; return z; }
#define MF32(a, b, c) __builtin_amdgcn_mfma_f32_32x32x16_bf16((a), (b), (c), 0, 0, 0)

__device__ __forceinline__ void pre_mfma(const Params& p, CK_LAS unsigned char* lw, int ch_head) {
    unsigned char* ws = p.ws;
    const int lane = threadIdx.x & 63, r32 = lane & 31, hi = lane >> 5;
    const int bh = ch_head / NCH, ch = ch_head % NCH, b = bh >> 3, h = bh & 7;
    {
        const size_t e0 = ((size_t)b * LP + LPAD + (size_t)ch * C) * 512 + h * 64 + lane;
        const f16_t* EW = (const f16_t*)(ws + O_EW) + e0; const f16_t* KK = (const f16_t*)(ws + O_KK) + e0; const f16_t* Bv = (const f16_t*)(ws + O_B) + e0;
        const f16_t* KM = (const f16_t*)(ws + O_KMOD) + e0; const f16_t* R = (const f16_t*)(ws + O_R) + e0;
        const int nvalid = (L - ch * C) < C ? (L - ch * C) : C;
        float W = 1.f;
        CK_LAS unsigned short* tm = (CK_LAS unsigned short*)(lw + L_TM) + lane;
#pragma nounroll
        for (int t8 = 0; t8 < C; t8 += 8) {
            f16_t hw[8], hk[8], hb[8], hm[8], hr[8];
#pragma unroll
            for (int q = 0; q < 8; ++q) { const int o = (t8 + q) * 512; hw[q] = EW[o]; hk[q] = KK[o]; hb[q] = Bv[o]; hm[q] = KM[o]; hr[q] = R[o]; }
#pragma unroll
            for (int q = 0; q < 8; ++q) {
                const int t = t8 + q; const bool ok = t < nvalid;
                const float w = ok ? __expf(-(float)hw[q]) : 1.f, kk = ok ? (float)hk[q] : 0.f, bb = ok ? (float)hb[q] : 0.f, k = ok ? (float)hm[q] : 0.f, r = ok ? (float)hr[q] : 0.f;
                const float Wp = W; W *= w; const float iw = __builtin_amdgcn_rcpf(W);
                tm[t * (TMS / 2)] = (unsigned short)f2bf(-kk * Wp);
                tm[t * (TMS / 2) + TMB / 2] = (unsigned short)f2bf(r * W);
                tm[t * (TMS / 2) + 2 * (TMB / 2)] = (unsigned short)f2bf(bb * iw);
                tm[t * (TMS / 2) + 3 * (TMB / 2)] = (unsigned short)f2bf(k * iw);
            }
        }
        ((CK_LAS float*)(lw + L_WC))[lane] = W;
    }
    f32x16 Lm = zero16(), G2 = zero16(), Gbr = zero16(), Gkr = zero16();
    {
        const CK_LAS unsigned char* fp = lw + L_TM + r32 * TMS + hi * 16;
#pragma unroll
        for (int ks = 0; ks < 4; ++ks) {
            const bf16x8 fa = *(const CK_LAS bf16x8*)(fp + ks * 32), fr = *(const CK_LAS bf16x8*)(fp + TMB + ks * 32), fb = *(const CK_LAS bf16x8*)(fp + 2 * TMB + ks * 32), fk = *(const CK_LAS bf16x8*)(fp + 3 * TMB + ks * 32);
            Lm = MF32(fa, fb, Lm);
            G2 = MF32(fa, fk, G2);
            Gbr = MF32(fb, fr, Gbr);
            Gkr = MF32(fk, fr, Gkr);
        }
#pragma unroll
        for (int i = 0; i < 16; ++i) { const int row = crow(i, hi);
            if (!(r32 < row)) { Lm[i] = 0.f; G2[i] = 0.f; }
            if (row > r32) { Gbr[i] = 0.f; Gkr[i] = 0.f; } }
    }
    {
        CK_LAS float* lf = (CK_LAS float*)(lw + L_LF);
#pragma unroll
        for (int i = 0; i < 16; ++i) lf[crow(i, hi) * 32 + r32] = Lm[i];
        float x[C];
#pragma unroll
        for (int t = 0; t < C; ++t) {
            float acc = (t == r32) ? 1.f : 0.f;
#pragma unroll
            for (int s4 = 0; s4 < (t + 3) / 4; ++s4) { const f32x4 l4 = *(const CK_LAS f32x4*)(lf + t * 32 + 4 * s4);
#pragma unroll
                for (int e = 0; e < 4; ++e) if (4 * s4 + e < t) acc = __builtin_fmaf(l4[e], x[4 * s4 + e], acc); }
            x[t] = acc;
        }
        CK_LAS unsigned short* nt = (CK_LAS unsigned short*)(lw + L_NT) + r32;
        if (hi == 0) {
#pragma unroll
            for (int t = 0; t < C; ++t) nt[t * (NTS / 2)] = (unsigned short)f2bf(x[t]);
        }
    }
    const CK_LAS unsigned char* trb = lw + L_TM + ((lane & 15) >> 2) * TMS + (((lane >> 4) & 1) * 16 + (lane & 3) * 4) * 2;
    f32x16 Ah[2] = {zero16(), zero16()};
    {
        const CK_LAS unsigned char* np_ = lw + L_NT + r32 * NTS + hi * 16;
#pragma unroll
        for (int ks = 0; ks < 2; ++ks) {
            const bf16x8 fn = *(const CK_LAS bf16x8*)(np_ + ks * 32);
#pragma unroll
            for (int cb = 0; cb < 2; ++cb) {
                const s16x4 lo = trd(trb + (16 * ks + 8 * hi) * TMS + 64 * cb), hh = trd(trb + (16 * ks + 8 * hi + 4) * TMS + 64 * cb);
                const bf16x8 fb = (bf16x8){lo[0], lo[1], lo[2], lo[3], hh[0], hh[1], hh[2], hh[3]};
                Ah[cb] = MF32(fn, fb, Ah[cb]);
            }
        }
    }
    f32x16 Gh = zero16();
    {
        const CK_LAS unsigned char* np_ = lw + L_NT + r32 * NTS + hi * 8;
#pragma unroll
        for (int ks = 0; ks < 2; ++ks) {
            const u32x2 lo = *(const CK_LAS u32x2*)(np_ + ks * 32), hh = *(const CK_LAS u32x2*)(np_ + ks * 32 + 16);
            const u32x4 a = (u32x4){lo.x, lo.y, hh.x, hh.y};
            Gh = MF32(__builtin_bit_cast(bf16x8, a), dfrag(G2, ks), Gh);
        }
    }
    bf16_t* Ps = (bf16_t*)((unsigned char*)p.out + OUT_PS) + (size_t)ch_head * 4096; bf16_t* Qs = (bf16_t*)((unsigned char*)p.out + OUT_QS) + (size_t)ch_head * 2048;
    bf16_t* Qy = (bf16_t*)((unsigned char*)p.out + OUT_QY) + (size_t)ch_head * 1024; bf16_t* Py = (bf16_t*)(ws + O_PY) + (size_t)ch_head * 2048;
#pragma unroll
    for (int rb = 0; rb < 2; ++rb) {
        f32x16 acc;
        { const CK_LAS unsigned char* rp = lw + L_TM + TMB + r32 * TMS + (32 * rb + 4 * hi) * 2;
#pragma unroll
          for (int gq = 0; gq < 4; ++gq) { const u32x2 v = *(const CK_LAS u32x2*)(rp + 16 * gq);
              acc[4 * gq] = bf2f(v.x & 0xffffu); acc[4 * gq + 1] = bf2f(v.x >> 16); acc[4 * gq + 2] = bf2f(v.y & 0xffffu); acc[4 * gq + 3] = bf2f(v.y >> 16); } }
#pragma unroll
        for (int ks = 0; ks < 2; ++ks) acc = MF32(dfrag(Ah[rb], ks), dfrag(Gbr, ks), acc);
        bf16_t* o = Py + r32 * 64 + 32 * rb + 4 * hi;
#pragma unroll
        for (int gq = 0; gq < 4; ++gq) *(u32x2*)(o + 8 * gq) = (u32x2){cvtpk(acc[4 * gq], acc[4 * gq + 1]), cvtpk(acc[4 * gq + 2], acc[4 * gq + 3])};
    }
    {
        f32x16 acc = Gkr;
#pragma unroll
        for (int ks = 0; ks < 2; ++ks) acc = MF32(dfrag(Gh, ks), dfrag(Gbr, ks), acc);
        bf16_t* o = Qy + r32 * 32 + 4 * hi;
#pragma unroll
        for (int gq = 0; gq < 4; ++gq) *(u32x2*)(o + 8 * gq) = (u32x2){cvtpk(acc[4 * gq], acc[4 * gq + 1]), cvtpk(acc[4 * gq + 2], acc[4 * gq + 3])};
    }
    {
        const CK_LAS float* wcp = (const CK_LAS float*)(lw + L_WC);
        bf16x8 ident[2];
#pragma unroll
        for (int ks = 0; ks < 2; ++ks) { u32x4 w;
#pragma unroll
            for (int q = 0; q < 4; ++q) { const int k0 = 16 * ks + 8 * hi + 2 * q; w[q] = (k0 == r32 ? 0x3f80u : 0u) | (k0 + 1 == r32 ? 0x3f800000u : 0u); }
            ident[ks] = __builtin_bit_cast(bf16x8, w); }
#pragma unroll
        for (int cb = 0; cb < 2; ++cb) {
            const float wc = wcp[r32 + 32 * cb];
            bf16x8 fbp[2], fkn[2];
#pragma unroll
            for (int ks = 0; ks < 2; ++ks) {
                const s16x4 lo = trd(trb + 2 * TMB + (16 * ks + 4 * hi) * TMS + 64 * cb), hh = trd(trb + 2 * TMB + (16 * ks + 8 + 4 * hi) * TMS + 64 * cb);
                fbp[ks] = (bf16x8){lo[0], lo[1], lo[2], lo[3], hh[0], hh[1], hh[2], hh[3]};
                const s16x4 lo2 = trd(trb + 3 * TMB + (16 * ks + 8 * hi) * TMS + 64 * cb), hh2 = trd(trb + 3 * TMB + (16 * ks + 8 * hi + 4) * TMS + 64 * cb);
                fkn[ks] = (bf16x8){lo2[0], lo2[1], lo2[2], lo2[3], hh2[0], hh2[1], hh2[2], hh2[3]};
            }
#pragma unroll
            for (int rb = 0; rb < 2; ++rb) {
                f32x16 acc = zero16();
#pragma unroll
                for (int ks = 0; ks < 2; ++ks) acc = MF32(dfrag(Ah[rb], ks), fbp[ks], acc);
                bf16_t* o = Ps + (32 * cb + r32) * 64 + 32 * rb + 4 * hi;
#pragma unroll
                for (int gq = 0; gq < 4; ++gq) {
                    float v[4];
#pragma unroll
                    for (int e = 0; e < 4; ++e) { const int r = 32 * rb + crow(4 * gq + e, hi); v[e] = (acc[4 * gq + e] + ((r == 32 * cb + r32) ? 1.f : 0.f)) * wc; }
                    *(u32x2*)(o + 8 * gq) = (u32x2){cvtpk(v[0], v[1]), cvtpk(v[2], v[3])};
                }
            }
            {
                f32x16 acc = zero16();
#pragma unroll
                for (int ks = 0; ks < 2; ++ks) { acc = MF32(dfrag(Gh, ks), fbp[ks], acc); acc = MF32(ident[ks], fkn[ks], acc); }
                bf16_t* o = Qs + (32 * cb + r32) * 32 + 4 * hi;
#pragma unroll
                for (int gq = 0; gq < 4; ++gq) *(u32x2*)(o + 8 * gq) = (u32x2){cvtpk(acc[4 * gq] * wc, acc[4 * gq + 1] * wc), cvtpk(acc[4 * gq + 2] * wc, acc[4 * gq + 3] * wc)};
            }
        }
    }
}
#undef MF32

__device__ __forceinline__ void seq_wave(const Params& p, int item) {
    unsigned char* ws = p.ws;
    const int lane = threadIdx.x & 63, n = lane & 15, g = lane >> 4;
    const int bh = item >> 2, vb = item & 3, b = bh >> 3, h = bh & 7;
    const size_t ebase = ((size_t)b * LP + LPAD) * 512 + h * 64 + 16 * vb + n;
    const f16_t* VV = (const f16_t*)(ws + O_VV);
    float* YR = (float*)(ws + O_YRAW);
    const bf16_t* Ps = (const bf16_t*)((const unsigned char*)p.out + OUT_PS) + (size_t)bh * NCH * 4096; const bf16_t* Qs = (const bf16_t*)((const unsigned char*)p.out + OUT_QS) + (size_t)bh * NCH * 2048;
    const bf16_t* Qy = (const bf16_t*)((const unsigned char*)p.out + OUT_QY) + (size_t)bh * NCH * 1024; const bf16_t* Py = (const bf16_t*)(ws + O_PY) + (size_t)bh * NCH * 2048;
    f32x4 T[4];
#pragma unroll
    for (int rb = 0; rb < 4; ++rb) T[rb] = (f32x4){0.f, 0.f, 0.f, 0.f};
    struct Ops { u32x2 ps[4][2][2]; u32x4 qs[4]; u32x2 py[2][2][2]; u32x4 qy[2]; f16_t v[8]; };
#define SQ_LOAD(O, ch_) do { const int c_ = (ch_) < NCH ? (ch_) : NCH - 1; \
        const bf16_t* ps_ = Ps + (size_t)c_ * 4096 + n * 64 + 4 * g; const bf16_t* py_ = Py + (size_t)c_ * 2048 + n * 64 + 4 * g; \
        const bf16_t* qs_ = Qs + (size_t)c_ * 2048 + n * 32 + 8 * g; const bf16_t* qy_ = Qy + (size_t)c_ * 1024 + n * 32 + 8 * g; \
        _Pragma("unroll") for (int rb = 0; rb < 4; ++rb) { _Pragma("unroll") for (int ks = 0; ks < 2; ++ks) { O.ps[rb][ks][0] = *(const u32x2*)(ps_ + rb * 1024 + 32 * ks); O.ps[rb][ks][1] = *(const u32x2*)(ps_ + rb * 1024 + 32 * ks + 16); } \
            O.qs[rb] = *(const u32x4*)(qs_ + rb * 512); } \
        _Pragma("unroll") for (int tb = 0; tb < 2; ++tb) { _Pragma("unroll") for (int ks = 0; ks < 2; ++ks) { O.py[tb][ks][0] = *(const u32x2*)(py_ + tb * 1024 + 32 * ks); O.py[tb][ks][1] = *(const u32x2*)(py_ + tb * 1024 + 32 * ks + 16); } \
            O.qy[tb] = *(const u32x4*)(qy_ + tb * 512); } \
        _Pragma("unroll") for (int j = 0; j < 8; ++j) { int pos_ = c_ * C + 8 * g + j; if (pos_ > L - 1) pos_ = L - 1; O.v[j] = VV[ebase + (size_t)pos_ * 512]; } } while (0)
#define SQ_STEP(O, ch_) do { \
        bf16x8 bt[2], bv; \
        _Pragma("unroll") for (int ks = 0; ks < 2; ++ks) { const f32x4 x0 = T[2 * ks], x1 = T[2 * ks + 1]; \
            const u32x4 w_ = (u32x4){pk2(x0[0], x0[1]), pk2(x0[2], x0[3]), pk2(x1[0], x1[1]), pk2(x1[2], x1[3])}; bt[ks] = __builtin_bit_cast(bf16x8, w_); } \
        { float vv[8]; _Pragma("unroll") for (int j = 0; j < 8; ++j) vv[j] = ((ch_) * C + 8 * g + j < L) ? (float)O.v[j] : 0.f; \
          const u32x4 w_ = (u32x4){pk2(vv[0], vv[1]), pk2(vv[2], vv[3]), pk2(vv[4], vv[5]), pk2(vv[6], vv[7])}; bv = __builtin_bit_cast(bf16x8, w_); } \
        f32x4 Tn[4]; \
        _Pragma("unroll") for (int rb = 0; rb < 4; ++rb) { f32x4 acc = (f32x4){0.f, 0.f, 0.f, 0.f}; \
            _Pragma("unroll") for (int ks = 0; ks < 2; ++ks) { const u32x4 a_ = (u32x4){O.ps[rb][ks][0].x, O.ps[rb][ks][0].y, O.ps[rb][ks][1].x, O.ps[rb][ks][1].y}; \
                acc = __builtin_amdgcn_mfma_f32_16x16x32_bf16(__builtin_bit_cast(bf16x8, a_), bt[ks], acc, 0, 0, 0); } \
            acc = __builtin_amdgcn_mfma_f32_16x16x32_bf16(__builtin_bit_cast(bf16x8, O.qs[rb]), bv, acc, 0, 0, 0); Tn[rb] = acc; } \
        _Pragma("unroll") for (int tb = 0; tb < 2; ++tb) { f32x4 acc = (f32x4){0.f, 0.f, 0.f, 0.f}; \
            _Pragma("unroll") for (int ks = 0; ks < 2; ++ks) { const u32x4 a_ = (u32x4){O.py[tb][ks][0].x, O.py[tb][ks][0].y, O.py[tb][ks][1].x, O.py[tb][ks][1].y}; \
                acc = __builtin_amdgcn_mfma_f32_16x16x32_bf16(__builtin_bit_cast(bf16x8, a_), bt[ks], acc, 0, 0, 0); } \
            acc = __builtin_amdgcn_mfma_f32_16x16x32_bf16(__builtin_bit_cast(bf16x8, O.qy[tb]), bv, acc, 0, 0, 0); \
            _Pragma("unroll") for (int r = 0; r < 4; ++r) { const int pos_ = (ch_) * C + 16 * tb + 4 * g + r; if (pos_ < L) YR[ebase + (size_t)pos_ * 512] = acc[r]; } } \
        _Pragma("unroll") for (int rb = 0; rb < 4; ++rb) T[rb] = Tn[rb]; } while (0)
    Ops A, B;
    SQ_LOAD(A, 0);
#pragma nounroll
    for (int ch = 0; ch < NCH; ch += 2) {
        SQ_LOAD(B, ch + 1);
        SQ_STEP(A, ch);
        if (ch + 1 < NCH) { SQ_LOAD(A, ch + 2); SQ_STEP(B, ch + 1); }
    }
#undef SQ_LOAD
#undef SQ_STEP
}
constexpr int SQ_PS = 0, SQ_PY = 9216, SQ_QS = 13824, SQ_QY = 18944, SQ_VT = 21504, SQ_SLOT = 26624, SQ_NSLOT = 5;
static_assert(SQ_NSLOT * SQ_SLOT + 256 <= 153600, "seq ring");
__device__ __forceinline__ void seq_block(const Params& p, CK_LAS unsigned char* lds, int bh) {
    unsigned char* ws = p.ws;
    const int tid = threadIdx.x, lane = tid & 63; const int wave = __builtin_amdgcn_readfirstlane(tid >> 6);
    const int b = bh >> 3, h = bh & 7;
    const size_t erow = ((size_t)b * LP + LPAD) * 512 + h * 64;
    const unsigned char* gPs = (const unsigned char*)p.out + OUT_PS + (size_t)bh * NCH * 8192; const unsigned char* gQs = (const unsigned char*)p.out + OUT_QS + (size_t)bh * NCH * 4096;
    const unsigned char* gQy = (const unsigned char*)p.out + OUT_QY + (size_t)bh * NCH * 2048; const unsigned char* gPy = ws + O_PY + (size_t)bh * NCH * 4096;
    __syncthreads();
    if (wave >= 4) {
        const int lt = tid - 256;
        const f16_t* VV = (const f16_t*)(ws + O_VV) + erow;
        struct Set { u32x4 ps0, ps1, py, qs, qy, v; };
        Set S0, S1, S2, S3;
#define LD_SET(S, ch_) do { const int c_ = (ch_) < NCH ? (ch_) : NCH - 1; \
            S.ps0 = *(const u32x4*)(gPs + (size_t)c_ * 8192 + lt * 16); S.ps1 = *(const u32x4*)(gPs + (size_t)c_ * 8192 + 4096 + lt * 16); \
            S.py = *(const u32x4*)(gPy + (size_t)c_ * 4096 + lt * 16); S.qs = *(const u32x4*)(gQs + (size_t)c_ * 4096 + lt * 16); \
            S.qy = *(const u32x4*)(gQy + (size_t)c_ * 2048 + (lt & 127) * 16); \
            { int pos_ = c_ * C + (lt >> 3); if (pos_ > L - 1) pos_ = L - 1; S.v = *(const u32x4*)(VV + (size_t)pos_ * 512 + (lt & 7) * 8); } } while (0)
#define WR_SET(S, ch_, slot_) do { CK_LAS unsigned char* d_ = lds + (slot_) * SQ_SLOT; \
            *(CK_LAS u32x4*)(d_ + SQ_PS + (lt >> 3) * 144 + (lt & 7) * 16) = S.ps0; *(CK_LAS u32x4*)(d_ + SQ_PS + (32 + (lt >> 3)) * 144 + (lt & 7) * 16) = S.ps1; \
            *(CK_LAS u32x4*)(d_ + SQ_PY + (lt >> 3) * 144 + (lt & 7) * 16) = S.py; *(CK_LAS u32x4*)(d_ + SQ_QS + (lt >> 2) * 80 + (lt & 3) * 16) = S.qs; \
            if (lt < 128) *(CK_LAS u32x4*)(d_ + SQ_QY + (lt >> 2) * 80 + (lt & 3) * 16) = S.qy; \
            { const bool ok_ = (ch_) * C + (lt >> 3) < L; CK_LAS unsigned short* vt_ = (CK_LAS unsigned short*)(d_ + SQ_VT + ((lt & 7) * 8) * 80) + (lt >> 3); \
              const f16x8 hv_ = __builtin_bit_cast(f16x8, S.v); \
              _Pragma("unroll") for (int e_ = 0; e_ < 8; ++e_) vt_[e_ * 40] = ok_ ? (unsigned short)f2bf((float)hv_[e_]) : (unsigned short)0; } } while (0)
        LD_SET(S0, 0); LD_SET(S1, 1); WR_SET(S0, 0, 0); WR_SET(S1, 1, 1);
        LD_SET(S2, 2); LD_SET(S3, 3); LD_SET(S0, 4); LD_SET(S1, 5);
        __syncthreads();
        int slot = 2;
#pragma nounroll
        for (int c = 0; c < NCH + 3; c += 4) {
            WR_SET(S2, c + 2, slot); LD_SET(S2, c + 6); slot = slot == SQ_NSLOT - 1 ? 0 : slot + 1; __syncthreads();
            WR_SET(S3, c + 3, slot); LD_SET(S3, c + 7); slot = slot == SQ_NSLOT - 1 ? 0 : slot + 1; __syncthreads();
            WR_SET(S0, c + 4, slot); LD_SET(S0, c + 8); slot = slot == SQ_NSLOT - 1 ? 0 : slot + 1; __syncthreads();
            WR_SET(S1, c + 5, slot); LD_SET(S1, c + 9); slot = slot == SQ_NSLOT - 1 ? 0 : slot + 1; __syncthreads();
        }
#undef LD_SET
#undef WR_SET
    } else {
        const int n = lane & 15, g = lane >> 4, vb = wave;
        float* YR = (float*)(ws + O_YRAW) + erow + 16 * vb + n;
        f32x4 T[4];
#pragma unroll
        for (int rb = 0; rb < 4; ++rb) T[rb] = (f32x4){0.f, 0.f, 0.f, 0.f};
        const CK_LAS unsigned char* pA = lds + SQ_PS + n * 144 + 8 * g;
        const CK_LAS unsigned char* pY = lds + SQ_PY + n * 144 + 8 * g;
        const CK_LAS unsigned char* pQ = lds + SQ_QS + n * 80 + 16 * g;
        const CK_LAS unsigned char* pZ = lds + SQ_QY + n * 80 + 16 * g;
        const CK_LAS unsigned char* pV = lds + SQ_VT + (16 * vb + n) * 80 + 16 * g;
        __syncthreads();
        int slot = 0;
#pragma nounroll
        for (int c = 0; c < NCH + 3; ++c) {
            if (c < NCH) {
                const int so = slot * SQ_SLOT;
                bf16x8 bt[2];
#pragma unroll
                for (int ks = 0; ks < 2; ++ks) { const f32x4 x0 = T[2 * ks], x1 = T[2 * ks + 1];
                    const u32x4 w = (u32x4){cvtpk(x0[0], x0[1]), cvtpk(x0[2], x0[3]), cvtpk(x1[0], x1[1]), cvtpk(x1[2], x1[3])}; bt[ks] = __builtin_bit_cast(bf16x8, w); }
                const bf16x8 bv = *(const CK_LAS bf16x8*)(pV + so);
#pragma unroll
                for (int rb = 0; rb < 4; ++rb) {
                    f32x4 acc = (f32x4){0.f, 0.f, 0.f, 0.f};
#pragma unroll
                    for (int ks = 0; ks < 2; ++ks) { const u32x2 lo = *(const CK_LAS u32x2*)(pA + so + rb * 2304 + 64 * ks), hh = *(const CK_LAS u32x2*)(pA + so + rb * 2304 + 64 * ks + 32);
                        const u32x4 a = (u32x4){lo.x, lo.y, hh.x, hh.y}; acc = __builtin_amdgcn_mfma_f32_16x16x32_bf16(__builtin_bit_cast(bf16x8, a), bt[ks], acc, 0, 0, 0); }
                    acc = __builtin_amdgcn_mfma_f32_16x16x32_bf16(*(const CK_LAS bf16x8*)(pQ + so + rb * 1280), bv, acc, 0, 0, 0);
                    T[rb] = acc;
                }
#pragma unroll
                for (int tb = 0; tb < 2; ++tb) {
                    f32x4 acc = (f32x4){0.f, 0.f, 0.f, 0.f};
#pragma unroll
                    for (int ks = 0; ks < 2; ++ks) { const u32x2 lo = *(const CK_LAS u32x2*)(pY + so + tb * 2304 + 64 * ks), hh = *(const CK_LAS u32x2*)(pY + so + tb * 2304 + 64 * ks + 32);
                        const u32x4 a = (u32x4){lo.x, lo.y, hh.x, hh.y}; acc = __builtin_amdgcn_mfma_f32_16x16x32_bf16(__builtin_bit_cast(bf16x8, a), bt[ks], acc, 0, 0, 0); }
                    acc = __builtin_amdgcn_mfma_f32_16x16x32_bf16(*(const CK_LAS bf16x8*)(pZ + so + tb * 1280), bv, acc, 0, 0, 0);
#pragma unroll
                    for (int r = 0; r < 4; ++r) { const int pos = c * C + 16 * tb + 4 * g + r; if (pos < L) YR[(size_t)pos * 512] = acc[r]; }
                }
            }
            slot = slot == SQ_NSLOT - 1 ? 0 : slot + 1;
            __syncthreads();
        }
    }
}
}

namespace att {
#define ATT_LAS __attribute__((address_space(3)))
typedef float f32x16 __attribute__((ext_vector_type(16)));
typedef short bf16x8 __attribute__((ext_vector_type(8)));
typedef short s16x4 __attribute__((ext_vector_type(4)));
typedef float f32x2_t __attribute__((ext_vector_type(2)));
typedef __bf16 bf16x2_t __attribute__((ext_vector_type(2)));
constexpr int KROW = 400, VROW = 320, KBUF = 64 * KROW, VBUF = 64 * VROW;
constexpr int L_K = 0, L_V = 2 * KBUF, L_SCR = 2 * KBUF + 2 * VBUF, ATT_LDS = L_SCR + 8 * 256;
__device__ __forceinline__ int crow(int i, int hi) { return (i & 3) + 8 * (i >> 2) + 4 * hi; }
__device__ __forceinline__ unsigned cvtpk(float lo, float hi) { f32x2_t v = {lo, hi}; bf16x2_t b = __builtin_convertvector(v, bf16x2_t); return __builtin_bit_cast(unsigned, b); }
template <int K> __device__ __forceinline__ float swz_xor(float x) { return __builtin_bit_cast(float, __builtin_amdgcn_ds_swizzle(__builtin_bit_cast(int, x), 0x1F | (K << 10))); }
__device__ __forceinline__ float x32_max(float x) { float a = x, b = x; asm volatile("s_nop 1\n\tv_permlane32_swap_b32 %0, %1" : "+v"(a), "+v"(b)); return fmaxf(a, b); }
__device__ __forceinline__ float x32_sum(float x) { float a = x, b = x; asm volatile("s_nop 1\n\tv_permlane32_swap_b32 %0, %1" : "+v"(a), "+v"(b)); return a + b; }
__device__ __forceinline__ s16x4 vtr(const ATT_LAS unsigned char* p) { return __builtin_bit_cast(s16x4, __builtin_amdgcn_ds_read_tr16_b64_v4i16((ATT_LAS s16x4*)p)); }

__device__ __forceinline__ void attn_unit(const Params& p, ATT_LAS unsigned char* lds, int b, int h, int qblk) {
    const int tid = threadIdx.x, lane = tid & 63, r32 = lane & 31, hi = lane >> 5; const int w = __builtin_amdgcn_readfirstlane(tid >> 6);
    unsigned char* ws = p.ws;
    const bf16_t* Q = (const bf16_t*)(ws + O_Q); const bf16_t* Kg = (const bf16_t*)(ws + O_K); const bf16_t* Vg = (const bf16_t*)(ws + O_V);
    const size_t rowbase = (size_t)b * LP;
    const int qrow = 64 + 256 * qblk + 32 * w + r32;
    const int NT = 4 * qblk + 5, jband = 4 * qblk + 1, jdiag = jband + (w >> 1);
    bf16x8 qf[12];
    { const bf16_t* qp = Q + (rowbase + qrow) * 768 + h * DQK + 8 * hi;
#pragma unroll
      for (int s = 0; s < 12; ++s) qf[s] = *(const bf16x8*)(qp + 16 * s); }
    const unsigned char* kbase = (const unsigned char*)(Kg + rowbase * 768 + h * DQK);
    const unsigned char* vbase = (const unsigned char*)(Vg + rowbase * 512 + h * DV);
    const unsigned sr = (unsigned)tid >> 3, sc8 = ((unsigned)tid & 7u) * 16u;
    const unsigned ko = sr * 1536u + sc8, vo = sr * 1024u + sc8, kl = (unsigned)L_K + sr * KROW + sc8, vl = (unsigned)L_V + sr * VROW + sc8;
    u32x4 sk[3], sv[2];
#define ATT_LOAD(j) do { const unsigned char* kb_ = kbase + (size_t)(j) * (64 * 768 * 2) + ko; const unsigned char* vb_ = vbase + (size_t)(j) * (64 * 512 * 2) + vo; \
                         _Pragma("unroll") for (int i_ = 0; i_ < 3; ++i_) sk[i_] = *(const u32x4*)(kb_ + 128 * i_); \
                         _Pragma("unroll") for (int i_ = 0; i_ < 2; ++i_) sv[i_] = *(const u32x4*)(vb_ + 128 * i_); } while (0)
#define ATT_WRITE(buf) do { _Pragma("unroll") for (int i_ = 0; i_ < 3; ++i_) *(ATT_LAS u32x4*)(lds + kl + (buf) * KBUF + 128 * i_) = sk[i_]; \
                            _Pragma("unroll") for (int i_ = 0; i_ < 2; ++i_) *(ATT_LAS u32x4*)(lds + vl + (buf) * VBUF + 128 * i_) = sv[i_]; } while (0)
    ATT_LAS float* scr = (ATT_LAS float*)(lds + L_SCR + w * 256);
    f32x16 o[4];
#pragma unroll
    for (int d = 0; d < 4; ++d)
#pragma unroll
        for (int i = 0; i < 16; ++i) o[d][i] = 0.f;
    float m = -1e30f, lsum = 0.f;
    const ATT_LAS unsigned char* kp0 = lds + L_K + r32 * KROW + hi * 16;
    const ATT_LAS unsigned char* vp0 = lds + L_V + (4 * hi + ((lane & 15) >> 2)) * VROW + (((lane >> 4) & 1) * 16 + (lane & 3) * 4) * 2;
    ATT_LOAD(0); ATT_WRITE(0);
    __syncthreads();
#pragma nounroll
    for (int j = 0; j < NT; ++j) {
        const int buf = j & 1;
        if (j + 1 < NT) ATT_LOAD(j + 1);
        if (j <= jdiag) {
            const ATT_LAS unsigned char* kp = kp0 + buf * KBUF;
            f32x16 p0, p1;
#pragma unroll
            for (int i = 0; i < 16; ++i) { p0[i] = 0.f; p1[i] = 0.f; }
#pragma unroll
            for (int s = 0; s < 12; ++s) {
                const bf16x8 k0 = *(const ATT_LAS bf16x8*)(kp + s * 32), k1 = *(const ATT_LAS bf16x8*)(kp + 32 * KROW + s * 32);
                p0 = __builtin_amdgcn_mfma_f32_32x32x16_bf16(k0, qf[s], p0, 0, 0, 0);
                p1 = __builtin_amdgcn_mfma_f32_32x32x16_bf16(k1, qf[s], p1, 0, 0, 0);
                if ((s & 3) == 3) __builtin_amdgcn_sched_barrier(0);
            }
            if (j == 0 || j >= jband) {
#pragma unroll
                for (int i = 0; i < 16; ++i) { const int kr = 64 * j + crow(i, hi);
                    if (kr < LPAD || kr > qrow) p0[i] = -1e30f;
                    if (kr + 32 < LPAD || kr + 32 > qrow) p1[i] = -1e30f; }
            }
            float mx = fmaxf(p0[0], p1[0]);
#pragma unroll
            for (int i = 1; i < 16; ++i) mx = fmaxf(mx, fmaxf(p0[i], p1[i]));
            mx = x32_max(mx);
            const float mn = fmaxf(m, mx);
            const bool grew = mn > m;
            const float alpha = __builtin_amdgcn_exp2f(m - mn);
            m = mn;
            float rs = 0.f;
#pragma unroll
            for (int i = 0; i < 16; ++i) { p0[i] = __builtin_amdgcn_exp2f(p0[i] - mn); p1[i] = __builtin_amdgcn_exp2f(p1[i] - mn); rs += p0[i] + p1[i]; }
            lsum = lsum * alpha + rs;
            if (__any(grew)) {
                if (hi == 0) scr[r32] = alpha;
#pragma unroll
                for (int g = 0; g < 4; ++g) { const f32x4 a4 = *(const ATT_LAS f32x4*)(scr + 8 * g + 4 * hi);
#pragma unroll
                    for (int d = 0; d < 4; ++d) { o[d][4 * g + 0] *= a4[0]; o[d][4 * g + 1] *= a4[1]; o[d][4 * g + 2] *= a4[2]; o[d][4 * g + 3] *= a4[3]; } }
            }
            u32x4 pw[4];
#pragma unroll
            for (int s = 0; s < 2; ++s) {
                pw[s] = (u32x4){cvtpk(p0[8 * s], p0[8 * s + 1]), cvtpk(p0[8 * s + 2], p0[8 * s + 3]), cvtpk(p0[8 * s + 4], p0[8 * s + 5]), cvtpk(p0[8 * s + 6], p0[8 * s + 7])};
                pw[2 + s] = (u32x4){cvtpk(p1[8 * s], p1[8 * s + 1]), cvtpk(p1[8 * s + 2], p1[8 * s + 3]), cvtpk(p1[8 * s + 4], p1[8 * s + 5]), cvtpk(p1[8 * s + 6], p1[8 * s + 7])};
            }
            const ATT_LAS unsigned char* vp = vp0 + buf * VBUF;
            __builtin_amdgcn_sched_barrier(0);
#pragma unroll
            for (int ks = 0; ks < 4; ++ks) {
                const bf16x8 pa = __builtin_bit_cast(bf16x8, pw[ks]);
#pragma unroll
                for (int d = 0; d < 4; ++d) {
                    const s16x4 lo = vtr(vp + (16 * ks) * VROW + 64 * d), hh = vtr(vp + (16 * ks + 8) * VROW + 64 * d);
                    const bf16x8 vb = (bf16x8){lo[0], lo[1], lo[2], lo[3], hh[0], hh[1], hh[2], hh[3]};
                    o[d] = __builtin_amdgcn_mfma_f32_32x32x16_bf16(pa, vb, o[d], 0, 0, 0);
                }
                __builtin_amdgcn_sched_barrier(0);
            }
        }
        if (j + 1 < NT) ATT_WRITE(buf ^ 1);
        __syncthreads();
    }
#undef ATT_LOAD
#undef ATT_WRITE
    const float ltot = x32_sum(lsum);
    if (hi == 0) scr[32 + r32] = ltot;
    const float* og = p.in[19] + h * DV;
    float gl[4];
#pragma unroll
    for (int d = 0; d < 4; ++d) gl[d] = og[32 * d + r32];
    bf16_t* Y = (bf16_t*)(ws + O_Y) + ((size_t)b * SEQ + 256 * qblk + 32 * w) * DM + 512 + h * DV + r32;
#pragma unroll
    for (int g = 0; g < 4; ++g) {
        const f32x4 l4 = *(const ATT_LAS f32x4*)(scr + 32 + 8 * g + 4 * hi);
#pragma unroll
        for (int e = 0; e < 4; ++e) {
            const int i = 4 * g + e;
            float ss = o[0][i] * o[0][i] + o[1][i] * o[1][i] + o[2][i] * o[2][i] + o[3][i] * o[3][i];
            ss += swz_xor<1>(ss); ss += swz_xor<2>(ss); ss += swz_xor<4>(ss); ss += swz_xor<8>(ss); ss += swz_xor<16>(ss);
            const float inv = 1.f / l4[e];
            const float sc = inv / sqrtf(ss * inv * inv * (1.f / DV) + RMS_EPS);
            bf16_t* yr = Y + (size_t)crow(i, hi) * DM;
#pragma unroll
            for (int d = 0; d < 4; ++d) yr[32 * d] = (bf16_t)f2bf(o[d][i] * sc * gl[d]);
        }
    }
}
}

__device__ __forceinline__ void p5_phase(const Params& p, int gw, int ngw, int) {
    const int lane = lane_id_fresh();
    unsigned char* ws = p.ws;
    const float* YRAW = (const float*)(ws + chk::O_YRAW);
    const f16_t* R = (const f16_t*)(ws + O_R); const f16_t* VV = (const f16_t*)(ws + O_VV); const f16_t* KM = (const f16_t*)(ws + O_KMOD); const bf16_t* G = (const bf16_t*)(ws + O_G);
    bf16_t* Y = (bf16_t*)(ws + O_Y);
    const float* r_k = p.in[12]; const float* ln_w = p.in[13]; const float* ln_b = p.in[14];
    for (int it = gw; it < TR * RH; it += ngw) {
        const int rr = it >> 3, h = it & 7, b = rr / SEQ, s = rr % SEQ;
        const size_t idx = ((size_t)b * LP + 64 + s) * 512 + h * 64 + lane;
        const float y = YRAW[idx];
        const float mean = wave_sum(y) * (1.f / 64.f); const float d = y - mean; const float var = wave_sum(d * d) * (1.f / 64.f);
        const float r = (float)R[idx], k = (float)KM[idx], v = (float)VV[idx];
        const float bonus = wave_sum(r * k * r_k[h * 64 + lane]);
        float yo = d * (1.0f / sqrtf(var + GN_EPS)) * ln_w[h * 64 + lane] + ln_b[h * 64 + lane] + bonus * v;
        yo *= bf2f(G[idx]);
        Y[(size_t)rr * DM + h * 64 + lane] = (bf16_t)f2bf(yo);
    }
}
__device__ __forceinline__ void p9_phase(const Params& p, int gw, int ngw, int) {
    const int lane = lane_id_fresh();
    const float* ssq = (const float*)(p.ws + O_SSQ3); const float* g = p.in[25];
    for (int row = gw; row < TR; row += ngw) {
        const float rs = 1.0f / sqrtf(ssq[row] * (1.f / DM) + RMS_EPS);
        f32x4* o = (f32x4*)(p.out + (size_t)row * DM) + lane;
#pragma unroll
        for (int j = 0; j < 4; ++j) { const f32x4 gv = ((const f32x4*)g)[lane + 64 * j]; f32x4 v = o[64 * j]; v = v * rs * gv; o[64 * j] = v; }
    }
}


#define GAS __attribute__((address_space(1)))
#define LAS __attribute__((address_space(3)))
#define XB_TMO      128
#define XB_XCNT(j)  (256  + 64 * (j))
#define XB_XSUB(j)  (1280 + 64 * (j))
#define XB_XGEN(j)  (2304 + 64 * (j))
#define XB_TOP      3328
#define XB_TOPGEN   3392
#define XCD_BAR_WORDS 3456
#define XB_SPIN_CAP (1u << 22)
__device__ __forceinline__ unsigned xb_ld(unsigned* p)              { return __hip_atomic_load(p, __ATOMIC_RELAXED, __HIP_MEMORY_SCOPE_AGENT); }
__device__ __forceinline__ unsigned xb_add(unsigned* p, unsigned v) { return __hip_atomic_fetch_add(p, v, __ATOMIC_RELAXED, __HIP_MEMORY_SCOPE_AGENT); }
__device__ __forceinline__ unsigned xb_xcc_id() { return (unsigned)__builtin_amdgcn_s_getreg((3 << 11) | 20) & 0xFu; }
#define XB_SPIN(cond, bar) do { unsigned _sp = 0; while (cond) { __builtin_amdgcn_s_sleep(1); \
    if ((++_sp & 255u) == 0u) { if (xb_ld(&(bar)[XB_TMO])) break; if (_sp > XB_SPIN_CAP) { atomicAdd(&(bar)[XB_TMO], 1u); break; } } } } while (0)
struct XcdBarrier { unsigned* bar; unsigned x; volatile LAS unsigned* st; };
__device__ __forceinline__ XcdBarrier xcd_barrier_post(unsigned* bar, volatile LAS unsigned* st) {
    XcdBarrier b; b.bar = bar; b.x = xb_xcc_id(); b.st = st;
    if (threadIdx.x == 0) (void)xb_add(&bar[XB_XCNT(b.x)], 1u);
    return b;
}
__device__ __forceinline__ void xcd_barrier_complete(unsigned* bar, unsigned x, unsigned& nloc, unsigned& nx) {
    const unsigned G = gridDim.x * gridDim.y * gridDim.z;
    unsigned sum, cnt, mine, sp = 0u;
    for (;;) {
        sum = 0u; cnt = 0u; mine = 0u;
#pragma unroll
        for (unsigned j = 0; j < 16; ++j) { const unsigned c = xb_ld(&bar[XB_XCNT(j)]); sum += c; cnt += (c > 0u) ? 1u : 0u; mine = (j == x) ? c : mine; }
        if (sum == G) break;
        __builtin_amdgcn_s_sleep(1);
        if ((++sp & 255u) == 0u) { if (xb_ld(&bar[XB_TMO])) break; if (sp > XB_SPIN_CAP) { atomicAdd(&bar[XB_TMO], 1u); break; } }
    }
    nloc = mine > 0u ? mine : 1u; nx = cnt > 0u ? cnt : 1u;
}
__device__ __forceinline__ void xcd_barrier(const XcdBarrier& b) {
    asm volatile("s_waitcnt vmcnt(0)" ::: "memory");
    __syncthreads();
    if (threadIdx.x == 0) {
        unsigned* bar = b.bar;
        __builtin_amdgcn_s_waitcnt(0);
        unsigned nloc = b.st[0], nx = b.st[1];
        if (nloc == 0u) { xcd_barrier_complete(bar, b.x, nloc, nx); b.st[0] = nloc; b.st[1] = nx; }
        const unsigned old = xb_add(&bar[XB_XSUB(b.x)], 1u);
        const unsigned gen = old / nloc;
        if (old + 1u == (gen + 1u) * nloc) {
            __builtin_amdgcn_fence(__ATOMIC_RELEASE, "agent");
            asm volatile("s_waitcnt vmcnt(0)" ::: "memory");
            const unsigned og = xb_add(&bar[XB_TOP], 1u);
            const unsigned tg = og / nx;
            if (og + 1u == (tg + 1u) * nx) xb_add(&bar[XB_TOPGEN], 1u);
            else XB_SPIN(xb_ld(&bar[XB_TOPGEN]) == tg, bar);
            __builtin_amdgcn_fence(__ATOMIC_ACQUIRE, "agent");
            xb_add(&bar[XB_XGEN(b.x)], 1u);
            asm volatile("s_waitcnt vmcnt(0)" ::: "memory");
        } else {
            XB_SPIN(xb_ld(&bar[XB_XGEN(b.x)]) == gen, bar);
            __builtin_amdgcn_fence(__ATOMIC_ACQUIRE, "agent");
            asm volatile("s_waitcnt vmcnt(0)" ::: "memory");
        }
    }
    __syncthreads();
}

#ifndef PH_MASK
#define PH_MASK 0xFFFF
#endif
#define PH(k) ((PH_MASK >> (k)) & 1)
#ifndef PROBE_PHASE
#define PROBE_PHASE -1
#endif
#define PROBE_EXTRA 4
#define NREP(k) ((PH(k) ? 1 : 0) + ((PROBE_PHASE == (k)) ? PROBE_EXTRA : 0))
constexpr int LDS_BYTES = 153600;
constexpr int LDS_MISC = LDS_BYTES - 256;
__global__ void __launch_bounds__(512, 2) mega_fwd(Params p) {
    extern __shared__ __attribute__((aligned(16))) unsigned char lds[];
    const int tid = threadIdx.x, lane = tid & 63; const int wave = __builtin_amdgcn_readfirstlane(tid >> 6);
    const int G = gridDim.x, gw = blockIdx.x * 8 + wave, ngw = G * 8;
    unsigned char* ws = p.ws;
    PG8_LAS unsigned char* ldsg = (PG8_LAS unsigned char*)lds;
    unsigned* ctl = (unsigned*)(ws + O_CTL);
    volatile LAS unsigned* misc = (volatile LAS unsigned*)(lds + LDS_MISC);
    if (tid < 2) misc[tid] = 0u;
    __syncthreads();
    const XcdBarrier xbar = xcd_barrier_post(ctl + 1024, misc);
#define GRID_SYNC() xcd_barrier(xbar)
#ifndef PROBE_SEG
#define PROBE_SEG -1
#endif
#define STAMP(i) do { if (PROBE_SEG >= 0 && blockIdx.x == 0 && tid == 0) misc[16 + (i)] = (unsigned)__builtin_amdgcn_s_memrealtime(); } while (0)
    STAMP(0);
    for (int rep_ = 0; rep_ < NREP(0); ++rep_) p0_phase(p, (float*)lds, gw, ngw, lane, wave);
    if (blockIdx.x == 0 && tid < 64) ctl[tid] = 0u;
    GRID_SYNC();
    STAMP(1);
    for (int rep_ = 0; rep_ < NREP(1); ++rep_) { pg8::Gemm g{(const bf16_t*)(ws + O_U1), (const bf16_t*)(ws + O_WIN), DM, DM, DM}; pg8::StaticOrder S; S.init(TP, NINP, G, blockIdx.x);
      pg8::Epi8<FP> E{FP{(bf16_t*)(ws + O_P)}}; pg8::gemm_phase<pg8::Epi8<FP>, true>(ldsg, g, S, E); }
    GRID_SYNC();
    STAMP(2);
    for (int rep_ = 0; rep_ < NREP(2); ++rep_) for (int row = gw; row < TP; row += ngw) p2_row(p, row, lane);
    GRID_SYNC();
    STAMP(3);
    for (int rep_ = 0; rep_ < NREP(3); ++rep_) { pg8::Gemm g{(const bf16_t*)(ws + O_CQKV), (const bf16_t*)(ws + O_WUQ), 640, QL, QL}; pg8::StaticOrder S; S.init(TP, 768, G, blockIdx.x);
      pg8::Epi8<FQ> E{FQ{(bf16_t*)(ws + O_Q), (const float*)(ws + O_RSTDQ), (const float*)(ws + O_ROPE)}}; pg8::gemm_phase<pg8::Epi8<FQ>, true>(ldsg, g, S, E); }
    for (int rep_ = 0; rep_ < NREP(4); ++rep_) { pg8::Gemm g{(const bf16_t*)(ws + O_CQKV) + 384, (const bf16_t*)(ws + O_WUKV), 640, KVL, KVL}; pg8::StaticOrder S; S.init(TP, 1024, G, blockIdx.x);
      pg8::Epi8<FKV> E{FKV{(bf16_t*)(ws + O_K), (bf16_t*)(ws + O_V), (const float*)(ws + O_RSTDKV)}}; pg8::gemm_phase<pg8::Epi8<FKV>, true>(ldsg, g, S, E); }
    if (PH(5)) { pg8::Gemm g{(const bf16_t*)(ws + O_LIN), (const bf16_t*)(ws + O_LWA), 384, 256, 256}; pg8::StaticOrder S; S.init(TP, 1024, G, blockIdx.x);
      pg8::Epi8<FLwa> E{FLwa{(f16_t*)(ws + O_EW), (f16_t*)(ws + O_KMOD), (const f16_t*)(ws + O_KK), (f16_t*)(ws + O_B), p.in[5], p.in[7], p.in[11]}}; pg8::gemm_phase<pg8::Epi8<FLwa>, true>(ldsg, g, S, E); }
    for (int rep_ = 0; rep_ < NREP(6); ++rep_) { pg8::Gemm g{(const bf16_t*)(ws + O_LIN) + 128, (const bf16_t*)(ws + O_LG), 384, 256, 256}; pg8::StaticOrder S; S.init(TP, 512, G, blockIdx.x);
      pg8::Epi8<FG> E{FG{(bf16_t*)(ws + O_G)}}; pg8::gemm_phase<pg8::Epi8<FG>, true>(ldsg, g, S, E); }
    GRID_SYNC();
    STAMP(4);
    if (PH(7)) {
        for (int rep_ = 0; rep_ < 1 + ((PROBE_PHASE == 20) ? PROBE_EXTRA : 0); ++rep_)
            if (wave < chk::PRE_WAVES) for (int u = blockIdx.x * chk::PRE_WAVES + wave; u < chk::NCHH; u += G * chk::PRE_WAVES) chk::pre_mfma(p, (CK_LAS unsigned char*)lds + wave * chk::PRE_LDS, u);
        GRID_SYNC();
        STAMP(5);
        if (blockIdx.x < NB * RH) chk::seq_block(p, (CK_LAS unsigned char*)lds, blockIdx.x);
        if (PROBE_SEG >= 0) { __syncthreads(); STAMP(6); }
    }
    if (PH(8)) {
        volatile LAS unsigned* bc = misc + 8;
        const int xg = (int)(blockIdx.x & 7);
        for (;;) {
            __syncthreads();
            if (tid == 0) bc[0] = atomicAdd(ctl + xg, 1u);
            __syncthreads();
            const unsigned u = bc[0];
            if (u >= 64u) break;
            const int qblk = 15 - (int)(u >> 2), bh = xg + 8 * (int)(u & 3);
            att::attn_unit(p, ldsg, bh >> 2, bh & 3, qblk);
        }
    }
    GRID_SYNC();
    STAMP(7);
    for (int rep_ = 0; rep_ < NREP(9); ++rep_) p5_phase(p, gw, ngw, lane);
    GRID_SYNC();
    STAMP(8);
    if (PH(10)) { pg8::Gemm g{(const bf16_t*)(ws + O_Y), (const bf16_t*)(ws + O_WOUT), DM, DM, DM}; pg8::StaticOrder S; S.init(TR, DM, G, blockIdx.x);
      pg8::Epi8<FOut> E{FOut{p.in[0], p.out, (bf16_t*)(ws + O_H2B), (float*)(ws + O_SSQ2)}}; pg8::gemm_phase<pg8::Epi8<FOut>, true>(ldsg, g, S, E); }
    GRID_SYNC();
    STAMP(9);
    for (int rep_ = 0; rep_ < NREP(11); ++rep_) { pg8::Gemm g{(const bf16_t*)(ws + O_H2B), (const bf16_t*)(ws + O_WGU), DM, DM, DM}; pg8::StaticOrder S; S.init(TR, 2 * DFF, G, blockIdx.x);
      pg8::Epi8<FAct> E{FAct{(bf16_t*)(ws + O_ACT), (const float*)(ws + O_SSQ2)}}; pg8::gemm_phase<pg8::Epi8<FAct>, true>(ldsg, g, S, E); }
    GRID_SYNC();
    STAMP(10);
    if (PH(12)) { pg8::Gemm g{(const bf16_t*)(ws + O_ACT), (const bf16_t*)(ws + O_WDN), DFF, DFF, DFF}; pg8::StaticOrder S; S.init(TR, DM, G, blockIdx.x);
      pg8::Epi8<FDown> E{FDown{p.out, (float*)(ws + O_SSQ3)}}; pg8::gemm_phase<pg8::Epi8<FDown>, true>(ldsg, g, S, E); }
    GRID_SYNC();
    STAMP(11);
    if (PH(13)) p9_phase(p, gw, ngw, lane);
    if (PROBE_SEG >= 0 && blockIdx.x == 0) {
        __syncthreads();
        if (tid == 0) { const unsigned long long t1 = __builtin_amdgcn_s_memrealtime(); misc[16 + 12] = (unsigned)t1;
            const unsigned d = misc[16 + PROBE_SEG + 1] - misc[16 + PROBE_SEG];
            while (__builtin_amdgcn_s_memrealtime() - t1 < 9ull * d) __builtin_amdgcn_s_sleep(8); }
    }
}

extern "C" void kernel_launch(void* const* d_in, const int* in_sizes, int n_in, void* d_out, int out_size, void* d_ws, size_t ws_size, hipStream_t stream) {
    static int grid_blocks = 0;
    if (grid_blocks == 0) {
        if (n_in != 26 || out_size != TR * DM || ws_size < 512 * MiB) { fprintf(stderr, "kernel_launch: unexpected sizes n_in=%d out=%d ws=%zu\n", n_in, out_size, ws_size); grid_blocks = -1; return; }
        int dev = 0, cus = 0, per_cu = 0;
        (void)hipGetDevice(&dev); (void)hipDeviceGetAttribute(&cus, hipDeviceAttributeMultiprocessorCount, dev);
        (void)hipFuncSetAttribute((const void*)mega_fwd, hipFuncAttributeMaxDynamicSharedMemorySize, LDS_BYTES);
        (void)hipOccupancyMaxActiveBlocksPerMultiprocessor(&per_cu, (const void*)mega_fwd, 512, LDS_BYTES);
        if (per_cu < 1) { fprintf(stderr, "kernel_launch: occupancy query says %d blocks per CU\n", per_cu); per_cu = 1; }
        if (per_cu > 1) per_cu = 1;
        grid_blocks = cus * per_cu;
    }
    if (grid_blocks < 0) return;
    Params p{};
    for (int i = 0; i < 26; ++i) p.in[i] = (const float*)d_in[i];
    p.out = (float*)d_out; p.ws = (unsigned char*)d_ws;
    (void)hipMemsetAsync((unsigned char*)d_ws + O_CTL + 4096, 0, XCD_BAR_WORDS * 4, stream);
    hipLaunchKernelGGL(mega_fwd, dim3(grid_blocks), dim3(512), LDS_BYTES, stream, p);
    hipError_t e = hipPeekAtLastError();
    if (e != hipSuccess) fprintf(stderr, "launch failed: %s (grid %d)\n", hipGetErrorString(e), grid_blocks);
}
```

```cpp
#include <hip/hip_runtime.h>
#include <hip/hip_cooperative_groups.h>
namespace cg = cooperative_groups;
#include <cstdio>
#include <cstdint>

typedef unsigned short bf16_t;
typedef _Float16 f16_t;
typedef float f32x4 __attribute__((ext_vector_type(4)));
typedef unsigned u32x4 __attribute__((ext_vector_type(4)));
typedef unsigned u32x2 __attribute__((ext_vector_type(2)));

constexpr int NB = 8, SEQ = 4096, DM = 1024, NMETA = 16, L = SEQ + NMETA;
constexpr int LPAD = 48, LP = L + LPAD;
constexpr int TP = NB * LP;
constexpr int TR = NB * SEQ;
constexpr int NIN = 2528, NINP = 2560, RW = 512, RCOLS = 1824;
constexpr int QL = 384, KVL = 256, DQK = 192, DV = 128, NH = 4, RH = 8, RN = 64;
constexpr int DFF = 2816;
constexpr float RMS_EPS = 1e-6f, GN_EPS = 64e-5f;
constexpr float QSCALE = 0.07216878364870323f * 1.4426950408889634f;

constexpr size_t MiB = 1u << 20;
constexpr size_t al256(size_t x) { return (x + 255) & ~(size_t)255; }
constexpr size_t O_WIN = 0;
constexpr size_t O_WUQ = O_WIN + al256((size_t)NINP * DM * 2);
constexpr size_t O_WUKV = O_WUQ + al256((size_t)768 * QL * 2);
constexpr size_t O_LWA = O_WUKV + al256((size_t)1024 * KVL * 2);
constexpr size_t O_LG = O_LWA + al256((size_t)1024 * 256 * 2);
constexpr size_t O_WOUT = O_LG + al256((size_t)512 * 256 * 2);
constexpr size_t O_WGU = O_WOUT + al256((size_t)DM * DM * 2);
constexpr size_t O_WDN = O_WGU + al256((size_t)2 * DFF * DM * 2);
constexpr size_t O_ROPE = O_WDN + al256((size_t)DM * DFF * 2);
constexpr size_t O_RSTDQ = O_ROPE + al256((size_t)L * 32 * 8);
constexpr size_t O_RSTDKV = O_RSTDQ + al256((size_t)TP * 4);
constexpr size_t O_SSQ2 = O_RSTDKV + al256((size_t)TP * 4);
constexpr size_t O_SSQ3 = O_SSQ2 + al256((size_t)TR * 4);
constexpr size_t O_CTL = O_SSQ3 + al256((size_t)TR * 4);
constexpr size_t O_WEND = O_CTL + 65536;
static_assert(O_WEND <= 32 * MiB, "weight region");
constexpr size_t ROWB = (size_t)TP * 512 * 2;
constexpr size_t O_P = 32 * MiB;
constexpr size_t O_Q = O_P;
constexpr size_t O_V = O_Q + al256((size_t)TP * 768 * 2);
constexpr size_t O_EW = O_V + ROWB;
constexpr size_t O_B = O_EW + ROWB;
static_assert(O_B + ROWB <= O_P + al256((size_t)TP * NIN * 2), "aliases inside P");
constexpr size_t O_U1 = 193 * MiB;
constexpr size_t O_R = O_U1;
constexpr size_t O_VV = O_R + ROWB;
static_assert(O_P + al256((size_t)TP * NIN * 2) <= O_U1 && O_VV + ROWB <= 258 * MiB, "U1 region");
constexpr size_t O_KK = 258 * MiB;
constexpr size_t O_KMOD = O_KK + ROWB;
constexpr size_t O_LIN = O_KMOD + ROWB;
constexpr size_t O_CQKV = O_LIN + al256((size_t)TP * 384 * 2);
constexpr size_t O_K = O_CQKV + al256((size_t)TP * 640 * 2);
constexpr size_t O_G = O_K + al256((size_t)TP * 768 * 2);
constexpr size_t O_END1 = O_G + ROWB;
static_assert(O_END1 <= 512 * MiB, "ws");
constexpr size_t O_Y = O_LIN;
static_assert(O_Y + (size_t)TR * DM * 2 <= O_K, "Y alias");
constexpr size_t O_H2B = O_P;
constexpr size_t O_ACT = O_P + 64 * MiB;
static_assert(O_ACT + (size_t)TR * DFF * 2 <= O_Y, "ACT alias");
static_assert((size_t)TP * 512 * 4 <= (size_t)TR * DM * 4, "YRAW in d_out");

struct Params {
    const float* in[26];
    float* out;
    unsigned char* ws;
};

__device__ __forceinline__ unsigned f2bf(float f) { unsigned u = __builtin_bit_cast(unsigned, f); return (u + 0x7fffu + ((u >> 16) & 1u)) >> 16; }
__device__ __forceinline__ float bf2f(unsigned h) { return __builtin_bit_cast(float, h << 16); }
__device__ __forceinline__ unsigned pk2(float lo, float hi) { return f2bf(lo) | (f2bf(hi) << 16); }
__device__ __forceinline__ float wave_sum(float v) {
#pragma unroll
    for (int o = 1; o < 64; o <<= 1) v += __shfl_xor(v, o);
    return v;
}
__device__ __forceinline__ int lane_id_fresh() { int l; asm volatile("v_mbcnt_lo_u32_b32 %0, -1, 0\n\tv_mbcnt_hi_u32_b32 %0, -1, %0" : "=v"(l)); return l; }
__device__ __forceinline__ float sigmoidf_(float x) { return 1.f / (1.f + __expf(-x)); }
__device__ __forceinline__ int row_pos(int row) { int p = row % LP - LPAD; return p < 0 ? 0 : p; }

__constant__ double c_inv_freq[32] = {
    1.0, 0.7498942093324559, 0.5623413251903491, 0.4216965034285822, 0.31622776601683794, 0.23713737056616552, 0.1778279410038923, 0.1333521432163324,
    0.1, 0.07498942093324558, 0.05623413251903491, 0.04216965034285822, 0.03162277660168379, 0.023713737056616554, 0.01778279410038923, 0.01333521432163324,
    0.01, 0.007498942093324559, 0.005623413251903491, 0.004216965034285823, 0.0031622776601683794, 0.0023713737056616554, 0.0017782794100389228, 0.001333521432163324,
    0.001, 0.0007498942093324559, 0.0005623413251903491, 0.0004216965034285822, 0.00031622776601683794, 0.00023713737056616554, 0.00017782794100389227, 0.0001333521432163324};

__device__ __forceinline__ void sincos_d(double a, float& s, float& c) {
    const double q = __builtin_rint(a * 0.6366197723675814);
    double r = __builtin_fma(-q, 1.5707963267948966, a);
    r = __builtin_fma(-q, 6.123233995736766e-17, r);
    const double r2 = r * r;
    double sp = -1.0 / 1307674368000.0;
    sp = sp * r2 + 1.0 / 6227020800.0; sp = sp * r2 - 1.0 / 39916800.0; sp = sp * r2 + 1.0 / 362880.0; sp = sp * r2 - 1.0 / 5040.0; sp = sp * r2 + 1.0 / 120.0; sp = sp * r2 - 1.0 / 6.0;
    const double sn = r + r * r2 * sp;
    double cp = 1.0 / 87178291200.0;
    cp = cp * r2 - 1.0 / 479001600.0; cp = cp * r2 + 1.0 / 3628800.0; cp = cp * r2 - 1.0 / 40320.0; cp = cp * r2 + 1.0 / 720.0; cp = cp * r2 - 1.0 / 24.0; cp = cp * r2 + 0.5;
    const double cs = 1.0 - r2 * cp;
    const int qi = ((int)q) & 3;
    const double ss = (qi == 0) ? sn : (qi == 1) ? cs : (qi == 2) ? -sn : -cs;
    const double cc = (qi == 0) ? cs : (qi == 1) ? -sn : (qi == 2) ? -cs : sn;
    s = (float)ss; c = (float)cc;
}

struct SrcWin { const float* w; __device__ float operator()(int k, int n) const {
        if (n >= NIN) return 0.f; int ns = n;
        if (n >= 2464) { const int j = n - 2464; ns = 2464 + (j >> 1) + 32 * (j & 1); }
        return w[(size_t)k * NIN + ns]; } };
struct SrcWuq { const float* w; const float* g; __device__ float operator()(int k, int n) const {
        const int h = n / DQK, c = n % DQK; int cs = c; if (c >= 128) { const int j = c - 128; cs = 128 + (j >> 1) + 32 * (j & 1); }
        return w[(size_t)k * 768 + h * DQK + cs] * g[k]; } };
struct SrcWukv { const float* w; const float* g; __device__ float operator()(int k, int n) const { return w[(size_t)k * 1024 + n] * g[k]; } };
struct SrcLwa { const float* w2; const float* a2; __device__ float operator()(int k, int n) const {
        if (n < 512) return k < 64 ? w2[(size_t)k * 512 + n] : 0.f;
        return (k >= 64 && k < 128) ? a2[(size_t)(k - 64) * 512 + (n - 512)] : 0.f; } };
struct SrcLg { const float* g2; __device__ float operator()(int k, int n) const { return k < 160 ? g2[(size_t)k * 512 + n] : 0.f; } };
struct SrcWout { const float* w; __device__ float operator()(int k, int n) const { return w[(size_t)k * DM + n]; } };
struct SrcWgu { const float* wg; const float* wu; const float* g; __device__ float operator()(int k, int n) const {
        const int j = n >> 8, c = n & 255; const float v = c < 128 ? wg[(size_t)k * DFF + 128 * j + c] : wu[(size_t)k * DFF + 128 * j + (c - 128)];
        return v * g[k]; } };
struct SrcWdn { const float* w; __device__ float operator()(int k, int n) const { return w[(size_t)k * DM + n]; } };

template <class F>
__device__ __forceinline__ void wconv_item(const F& f, bf16_t* WT, int K, int nblk, int item, float* scr, int lane) {
    const int kb = item / nblk, nb = item % nblk, k0 = 64 * kb, n0 = 32 * nb;
#pragma unroll 8
    for (int i = 0; i < 32; ++i) { const int kk = 2 * i + (lane >> 5); scr[kk * 33 + (lane & 31)] = f(k0 + kk, n0 + (lane & 31)); }
    asm volatile("s_waitcnt lgkmcnt(0)" ::: "memory");
    const int c = lane & 7;
#pragma unroll
    for (int j = 0; j < 4; ++j) { const int n = (lane >> 3) + 8 * j; const float* s = scr + (8 * c) * 33 + n;
        u32x4 o; o.x = pk2(s[0 * 33], s[1 * 33]); o.y = pk2(s[2 * 33], s[3 * 33]); o.z = pk2(s[4 * 33], s[5 * 33]); o.w = pk2(s[6 * 33], s[7 * 33]);
        *(u32x4*)(WT + (size_t)(n0 + n) * K + k0 + 8 * c) = o; }
    asm volatile("s_waitcnt lgkmcnt(0)" ::: "memory");
}

__device__ __forceinline__ void p0_phase(const Params& p, float* scr_all, int gw, int ngw, int lane, int wave_in_block) {
    float* scr = scr_all + wave_in_block * (64 * 33);
    unsigned char* ws = p.ws;
    constexpr int I0 = (DM / 64) * (NINP / 32), I1 = (QL / 64) * (768 / 32), I2 = (KVL / 64) * (1024 / 32), I3 = (256 / 64) * (1024 / 32), I4 = (256 / 64) * (512 / 32),
                  I5 = (DM / 64) * (DM / 32), I6 = (DM / 64) * (2 * DFF / 32), I7 = (DFF / 64) * (DM / 32);
    constexpr int NIT = I0 + I1 + I2 + I3 + I4 + I5 + I6 + I7;
    for (int it = gw; it < NIT; it += ngw) {
        int r = it;
        if (r < I0) { wconv_item(SrcWin{p.in[3]}, (bf16_t*)(ws + O_WIN), DM, NINP / 32, r, scr, lane); continue; } r -= I0;
        if (r < I1) { wconv_item(SrcWuq{p.in[16], p.in[15]}, (bf16_t*)(ws + O_WUQ), QL, 768 / 32, r, scr, lane); continue; } r -= I1;
        if (r < I2) { wconv_item(SrcWukv{p.in[18], p.in[17]}, (bf16_t*)(ws + O_WUKV), KVL, 1024 / 32, r, scr, lane); continue; } r -= I2;
        if (r < I3) { wconv_item(SrcLwa{p.in[6], p.in[8]}, (bf16_t*)(ws + O_LWA), 256, 1024 / 32, r, scr, lane); continue; } r -= I3;
        if (r < I4) { wconv_item(SrcLg{p.in[9]}, (bf16_t*)(ws + O_LG), 256, 512 / 32, r, scr, lane); continue; } r -= I4;
        if (r < I5) { wconv_item(SrcWout{p.in[20]}, (bf16_t*)(ws + O_WOUT), DM, DM / 32, r, scr, lane); continue; } r -= I5;
        if (r < I6) { wconv_item(SrcWgu{p.in[22], p.in[23], p.in[21]}, (bf16_t*)(ws + O_WGU), DM, 2 * DFF / 32, r, scr, lane); continue; } r -= I6;
        wconv_item(SrcWdn{p.in[24]}, (bf16_t*)(ws + O_WDN), DFF, DM / 32, r, scr, lane);
    }
    const float* x = p.in[0]; const float* meta = p.in[1]; const float* g1 = p.in[2];
    bf16_t* U1 = (bf16_t*)(ws + O_U1);
    for (int row = gw; row < TP; row += ngw) {
        const int b = row / LP, pr = row % LP - LPAD;
        u32x2* o = (u32x2*)(U1 + (size_t)row * DM) + lane;
        if (pr < 0) {
#pragma unroll
            for (int j = 0; j < 4; ++j) o[64 * j] = (u32x2){0u, 0u};
            continue;
        }
        const float* src = pr < NMETA ? meta + (size_t)pr * DM : x + ((size_t)b * SEQ + (pr - NMETA)) * DM;
        const f32x4* xr = (const f32x4*)src + lane;
        f32x4 v[4]; float s = 0.f;
#pragma unroll
        for (int j = 0; j < 4; ++j) { v[j] = xr[64 * j]; s += (v[j].x * v[j].x + v[j].y * v[j].y) + (v[j].z * v[j].z + v[j].w * v[j].w); }
        const float rstd = 1.0f / sqrtf(wave_sum(s) * (1.f / DM) + RMS_EPS);
#pragma unroll
        for (int j = 0; j < 4; ++j) { const f32x4 g = ((const f32x4*)g1)[lane + 64 * j];
            o[64 * j] = (u32x2){pk2(v[j].x * rstd * g.x, v[j].y * rstd * g.y), pk2(v[j].z * rstd * g.z, v[j].w * rstd * g.w)}; }
    }
    float* rope = (float*)(ws + O_ROPE);
    for (int i = gw * 64 + lane; i < L * 32; i += ngw * 64) {
        const int pos = i >> 5, f = i & 31; float s, c; sincos_d((double)pos * c_inv_freq[f], s, c);
        rope[2 * i] = c; rope[2 * i + 1] = s;
    }
    float* ssq = (float*)(ws + O_SSQ2);
    for (int i = gw * 64 + lane; i < (int)((O_CTL - O_SSQ2) / 4); i += ngw * 64) ssq[i] = 0.f;
}

typedef _Float16 f16x8 __attribute__((ext_vector_type(8)));
template <int CTRL> __device__ __forceinline__ float dpp2(float x) { return __builtin_bit_cast(float, __builtin_amdgcn_update_dpp(0, __builtin_bit_cast(int, x), CTRL, 0xF, 0xF, true)); }
__device__ __forceinline__ void unpack8(const u32x4& a, float (&v)[8]) {
    v[0] = bf2f(a.x & 0xffffu); v[1] = bf2f(a.x >> 16); v[2] = bf2f(a.y & 0xffffu); v[3] = bf2f(a.y >> 16); v[4] = bf2f(a.z & 0xffffu); v[5] = bf2f(a.z >> 16); v[6] = bf2f(a.w & 0xffffu); v[7] = bf2f(a.w >> 16); }
__device__ __forceinline__ u32x4 packbf8(const float (&o)[8]) { return (u32x4){pk2(o[0], o[1]), pk2(o[2], o[3]), pk2(o[4], o[5]), pk2(o[6], o[7])}; }
__device__ __forceinline__ void p2_phase(const Params& p, int gw, int ngw) {
    const int lane = lane_id_fresh();
    unsigned char* ws = p.ws;
    const bf16_t* P = (const bf16_t*)(ws + O_P);
    f16_t* R = (f16_t*)(ws + O_R); f16_t* VV = (f16_t*)(ws + O_VV); f16_t* KK = (f16_t*)(ws + O_KK); f16_t* KM = (f16_t*)(ws + O_KMOD);
    bf16_t* LIN = (bf16_t*)(ws + O_LIN); bf16_t* CQKV = (bf16_t*)(ws + O_CQKV); bf16_t* Kb = (bf16_t*)(ws + O_K);
    float mu[4][8], kkw[8];
#pragma unroll
    for (int it = 0; it < 4; ++it) { const int c0 = 8 * (lane + 64 * it); const bool sh = c0 < RCOLS;
        const f32x4 a = sh ? *(const f32x4*)(p.in[4] + c0) : (f32x4){0.f, 0.f, 0.f, 0.f}, b = sh ? *(const f32x4*)(p.in[4] + c0 + 4) : (f32x4){0.f, 0.f, 0.f, 0.f};
#pragma unroll
        for (int j = 0; j < 4; ++j) { mu[it][j] = a[j]; mu[it][4 + j] = b[j]; } }
    { const f32x4 a = *(const f32x4*)(p.in[10] + 8 * lane), b = *(const f32x4*)(p.in[10] + 8 * lane + 4);
#pragma unroll
      for (int j = 0; j < 4; ++j) { kkw[j] = a[j]; kkw[4 + j] = b[j]; } }
#pragma nounroll
    for (int row = gw; row < TP; row += ngw) {
        const bf16_t* cur = P + (size_t)row * NIN + 8 * lane; const bf16_t* prv = row > 0 ? cur - NIN : cur;
        const bool has_prev = row > 0, act4 = lane < 60;
        u32x4 cv[5], pv[4];
#pragma unroll
        for (int it = 0; it < 4; ++it) { cv[it] = *(const u32x4*)(cur + 512 * it); pv[it] = *(const u32x4*)(prv + 512 * it); }
        cv[4] = act4 ? *(const u32x4*)(cur + 2048) : (u32x4){0u, 0u, 0u, 0u};
        float x[5][8];
#pragma unroll
        for (int it = 0; it < 5; ++it) unpack8(cv[it], x[it]);
#pragma unroll
        for (int it = 0; it < 4; ++it) { float q[8]; unpack8(pv[it], q);
#pragma unroll
            for (int j = 0; j < 8; ++j) { const float pq = has_prev ? q[j] : 0.f; x[it][j] = x[it][j] + (pq - x[it][j]) * mu[it][j]; } }
        const size_t r512 = (size_t)row * 512 + 8 * lane;
        { f16x8 o;
#pragma unroll
          for (int j = 0; j < 8; ++j) o[j] = (f16_t)x[0][j];
          *(f16x8*)(R + r512) = o; }
        { float kkv[8], ss = 0.f;
#pragma unroll
          for (int j = 0; j < 8; ++j) { kkv[j] = x[1][j] * kkw[j]; ss += kkv[j] * kkv[j]; }
          ss += dpp2<0xB1>(ss); ss += dpp2<0x4E>(ss); ss += dpp2<0x141>(ss);
          const float inv = 1.f / fmaxf(sqrtf(ss), 1e-12f);
          f16x8 o, o2;
#pragma unroll
          for (int j = 0; j < 8; ++j) { o[j] = (f16_t)x[1][j]; o2[j] = (f16_t)(kkv[j] * inv); }
          *(f16x8*)(KM + r512) = o; *(f16x8*)(KK + r512) = o2; }
        { f16x8 o;
#pragma unroll
          for (int j = 0; j < 8; ++j) o[j] = (f16_t)x[2][j];
          *(f16x8*)(VV + r512) = o; }
        float ssq_q = 0.f, ssq_kv = 0.f;
        { float o[8];
          if (lane < 8) {
#pragma unroll
              for (int j = 0; j < 8; ++j) o[j] = tanhf(x[3][j]);
          } else if (lane < 16) {
#pragma unroll
              for (int j = 0; j < 8; ++j) o[j] = x[3][j];
          } else if (lane < 36) {
#pragma unroll
              for (int j = 0; j < 8; ++j) o[j] = sigmoidf_(x[3][j]);
          } else {
#pragma unroll
              for (int j = 0; j < 8; ++j) { o[j] = x[3][j]; ssq_q += o[j] * o[j]; }
          }
          bf16_t* dst = lane < 36 ? LIN + (size_t)row * 384 + 8 * lane : CQKV + (size_t)row * 640 + 8 * (lane - 36);
          *(u32x4*)dst = packbf8(o);
          if (lane < 12) *(u32x4*)(LIN + (size_t)row * 384 + 288 + 8 * lane) = (u32x4){0u, 0u, 0u, 0u}; }
        if (lane < 52) {
#pragma unroll
            for (int j = 0; j < 8; ++j) { const float t = x[4][j] * x[4][j]; if (lane < 20) ssq_q += t; else ssq_kv += t; }
            *(u32x4*)(CQKV + (size_t)row * 640 + 224 + 8 * lane) = packbf8(x[4]);
        } else if (act4) {
            const float* t = (const float*)(ws + O_ROPE) + ((size_t)row_pos(row) * 32 + 4 * (lane - 52)) * 2;
            const f32x4 t0 = *(const f32x4*)t, t1 = *(const f32x4*)(t + 4);
            float o[8];
            o[0] = x[4][0] * t0[0] - x[4][1] * t0[1]; o[1] = x[4][1] * t0[0] + x[4][0] * t0[1]; o[2] = x[4][2] * t0[2] - x[4][3] * t0[3]; o[3] = x[4][3] * t0[2] + x[4][2] * t0[3];
            o[4] = x[4][4] * t1[0] - x[4][5] * t1[1]; o[5] = x[4][5] * t1[0] + x[4][4] * t1[1]; o[6] = x[4][6] * t1[2] - x[4][7] * t1[3]; o[7] = x[4][7] * t1[2] + x[4][6] * t1[3];
            const u32x4 w = packbf8(o);
#pragma unroll
            for (int h = 0; h < NH; ++h) *(u32x4*)(Kb + (size_t)row * 768 + h * DQK + 128 + 8 * (lane - 52)) = w;
        }
        ssq_q = wave_sum(ssq_q); ssq_kv = wave_sum(ssq_kv);
        if (lane == 0) { ((float*)(ws + O_RSTDQ))[row] = 1.0f / sqrtf(ssq_q * (1.f / QL) + RMS_EPS); ((float*)(ws + O_RSTDKV))[row] = 1.0f / sqrtf(ssq_kv * (1.f / KVL) + RMS_EPS); }
    }
}

namespace pg8 {
#define PG8_LAS __attribute__((address_space(3)))
typedef short bf16x8 __attribute__((ext_vector_type(8)));
constexpr int BM = 256, BK = 64, HALF = 128, HTB = HALF * BK * 2, STAGE_BYTES = 8 * HTB, NXCD = 8, WGM = 8;
__host__ __device__ __forceinline__ int lds_byte(int r, int c) { const int st = (r >> 4) * 2 + (c >> 5), rr = r & 15, cc = c & 31, ob = rr * 64 + cc * 2; return st * 1024 + (ob ^ (((ob >> 9) & 1) << 5)); }
__host__ __device__ __forceinline__ void stage_rc(int b, int& R, int& C) { const int st = b / 1024, sb = b % 1024, swz = sb ^ (((sb >> 9) & 1) << 5); R = (st >> 1) * 16 + swz / 64; C = (st & 1) * 32 + (swz % 64) / 2; }
__host__ __device__ __forceinline__ int perm32(int rho) { const int n = rho >> 4, i = rho & 15; return 8 * (i >> 2) + 4 * n + (i & 3); }
struct Unit { int pm, pn; };
struct Gemm { const bf16_t* A; const bf16_t* Bt; int lda, ldb, K; };
struct StaticOrder {
    int nM, nN, nwg, G, c;
    __host__ __device__ void init(int M, int N, int G_, int c_) { nM = M / BM; nN = N / BM; nwg = nM * nN; G = G_; c = c_; }
    __host__ __device__ bool next(int i, Unit& u) const {
        const long L = (long)i * G + c; if (L >= nwg) return false;
        int wgid = (int)L; { const int q = nwg / NXCD, r = nwg % NXCD, xcd = wgid % NXCD, off = wgid / NXCD; wgid = (xcd < r ? xcd * (q + 1) : r * (q + 1) + (xcd - r) * q) + off; }
        const int nig = WGM * nN, gid = wgid / nig, fm = gid * WGM, gsz = (nM - fm) < WGM ? (nM - fm) : WGM;
        u.pm = fm + ((wgid % nig) % gsz); u.pn = (wgid % nig) / gsz; return true;
    }
};
template <class F> struct Epi8 {
    F f;
    __device__ __forceinline__ void operator()(const f32x4 (&acc)[2][2][4][2], const Unit& u, int wr, int wc, int fr, int fq) const {
        const int col = u.pn * BM + wc * 32 + 8 * fq;
#pragma unroll
        for (int ai = 0; ai < 2; ++ai)
#pragma unroll
            for (int m = 0; m < 4; ++m) f(u.pm * BM + ai * HALF + wr * 64 + m * 16 + fr, col, acc[ai][0][m][0], acc[ai][0][m][1], acc[ai][1][m][0], acc[ai][1][m][1]);
    }
};

template <class Epi, bool ALIGN_EPI>
__device__ __forceinline__ void gemm_phase(PG8_LAS unsigned char* lds, const Gemm g, const StaticOrder& S, const Epi& E) {
    const int tid = threadIdx.x, wid = __builtin_amdgcn_readfirstlane(tid >> 6), lane = tid & 63, wr = wid >> 2, wc = wid & 3, fr = lane & 15, fq = lane >> 4;
    const int K = g.K, nt = K / BK;
    unsigned voffA[2], voffB[2];
#pragma unroll
    for (int i = 0; i < 2; ++i) { int R, C; stage_rc(tid * 16 + i * 8192, R, C); const int Rb = (R & ~31) + perm32(R & 31);
        voffA[i] = (unsigned)(R * g.lda + C) * 2u; voffB[i] = (unsigned)(Rb * g.ldb + C) * 2u; }
    const size_t kstep = (size_t)(BK * 2);
    const size_t hstepA = (size_t)HALF * g.lda * 2, hstepB = (size_t)HALF * g.ldb * 2;
    const size_t tstepA = 2 * hstepA, tstepB = 2 * hstepB;
    const unsigned ldsw = (unsigned)wid * 1024u;
    const int aoff = lds_byte(wr * 64 + fr, fq * 8), boff = lds_byte(wc * 32 + fr, fq * 8);
#define PG8_SA(b, h) (((b) * 2 + (h)) * HTB)
#define PG8_SB(b, h) ((4 + (b) * 2 + (h)) * HTB)
#define PG8_STAGE(bufoff, gbase, voff) do { _Pragma("unroll") for (int _i = 0; _i < 2; ++_i) \
        __builtin_amdgcn_global_load_lds((const unsigned*)((const char*)(gbase) + (voff)[_i]), (PG8_LAS unsigned*)(lds + (bufoff) + ldsw + _i * 8192), 16, 0, 0); } while (0)
#define PG8_LDA(dst, b, h) do { _Pragma("unroll") for (int m = 0; m < 4; ++m) _Pragma("unroll") for (int k = 0; k < 2; ++k) dst[m][k] = *(const PG8_LAS bf16x8*)(lds + PG8_SA(b, h) + aoff + m * 2048 + k * 1024); } while (0)
#define PG8_LDB(dst, b, h) do { _Pragma("unroll") for (int n = 0; n < 2; ++n) _Pragma("unroll") for (int k = 0; k < 2; ++k) dst[n][k] = *(const PG8_LAS bf16x8*)(lds + PG8_SB(b, h) + boff + n * 2048 + k * 1024); } while (0)
#define PG8_MMA(ai, bj, At, Bt) do { __builtin_amdgcn_s_setprio(1); _Pragma("unroll") for (int m = 0; m < 4; ++m) _Pragma("unroll") for (int n = 0; n < 2; ++n) _Pragma("unroll") for (int k = 0; k < 2; ++k) \
        acc[ai][bj][m][n] = __builtin_amdgcn_mfma_f32_16x16x32_bf16(Bt[n][k], At[m][k], acc[ai][bj][m][n], 0, 0, 0); __builtin_amdgcn_s_setprio(0); } while (0)
#define PG8_WAIT_V(n) asm volatile("s_waitcnt vmcnt(" #n ")" ::: "memory")
#define PG8_WAIT_L(n) asm volatile("s_waitcnt lgkmcnt(" #n ")" ::: "memory")
#define PG8_BAR __builtin_amdgcn_s_barrier()
#define PG8_SCHED __builtin_amdgcn_sched_barrier(0)
    Unit cur, nxt; int ui = 0;
    if (!S.next(0, cur)) return;
    f32x4 acc[2][2][4][2];
#pragma unroll
    for (int a = 0; a < 2; ++a)
#pragma unroll
        for (int b = 0; b < 2; ++b)
#pragma unroll
            for (int m = 0; m < 4; ++m)
#pragma unroll
                for (int n = 0; n < 2; ++n) acc[a][b][m][n] = (f32x4){0.f, 0.f, 0.f, 0.f};
    bf16x8 At[4][2], B0[2][2], B1[2][2];
    const char* cA = (const char*)g.A + (size_t)cur.pm * tstepA; const char* cB = (const char*)g.Bt + (size_t)cur.pn * tstepB;
    PG8_STAGE(PG8_SB(0, 0), cB, voffB); PG8_STAGE(PG8_SB(0, 1), cB + hstepB, voffB); PG8_STAGE(PG8_SA(0, 0), cA, voffA); PG8_STAGE(PG8_SA(0, 1), cA + hstepA, voffA);
    if (wr == 1) PG8_BAR;
    PG8_WAIT_V(2); PG8_BAR;
    PG8_STAGE(PG8_SB(1, 0), cB + kstep, voffB); PG8_STAGE(PG8_SA(1, 0), cA + kstep, voffA); PG8_STAGE(PG8_SB(1, 1), cB + hstepB + kstep, voffB);
    PG8_WAIT_V(6); PG8_BAR;
#pragma nounroll
    for (;;) {
        const bool has_next = S.next(ui + 1, nxt);
        const char* nA = has_next ? (const char*)g.A + (size_t)nxt.pm * tstepA : cA; const char* nB = has_next ? (const char*)g.Bt + (size_t)nxt.pn * tstepB : cB;
#pragma nounroll
        for (int t = 0; t < nt; t += 2) {
            const bool last = (t == nt - 2);
            const char* a1 = cA + (size_t)(t + 1) * kstep;
            const char* a2 = last ? nA : cA + (size_t)(t + 2) * kstep; const char* b2 = last ? nB : cB + (size_t)(t + 2) * kstep;
            const char* a3 = a2 + kstep; const char* b3 = b2 + kstep;
            PG8_LDB(B0, 0, 0); PG8_LDB(B1, 0, 1); PG8_SCHED; PG8_LDA(At, 0, 0); PG8_STAGE(PG8_SA(1, 1), a1 + hstepA, voffA);
            PG8_WAIT_V(8); PG8_WAIT_L(0); PG8_BAR; PG8_MMA(0, 0, At, B0); PG8_MMA(0, 1, At, B1); PG8_BAR; PG8_SCHED;
            PG8_LDA(At, 0, 1); PG8_STAGE(PG8_SB(0, 0), b2, voffB); PG8_STAGE(PG8_SB(0, 1), b2 + hstepB, voffB); PG8_STAGE(PG8_SA(0, 0), a2, voffA);
            PG8_WAIT_V(8); PG8_WAIT_L(0); PG8_BAR; PG8_MMA(1, 0, At, B0); PG8_MMA(1, 1, At, B1); PG8_BAR; PG8_SCHED;
            PG8_LDB(B0, 1, 0); PG8_LDB(B1, 1, 1); PG8_SCHED; PG8_LDA(At, 1, 0); PG8_STAGE(PG8_SA(0, 1), a2 + hstepA, voffA);
            PG8_WAIT_V(8); PG8_WAIT_L(0); PG8_BAR; PG8_MMA(0, 0, At, B0); PG8_MMA(0, 1, At, B1); PG8_BAR; PG8_SCHED;
            PG8_LDA(At, 1, 1); PG8_STAGE(PG8_SB(1, 0), b3, voffB); PG8_STAGE(PG8_SB(1, 1), b3 + hstepB, voffB); PG8_STAGE(PG8_SA(1, 0), a3, voffA);
            PG8_WAIT_V(8); PG8_WAIT_L(0); PG8_BAR; PG8_MMA(1, 0, At, B0); PG8_MMA(1, 1, At, B1); PG8_BAR; PG8_SCHED;
        }
        if constexpr (ALIGN_EPI) { if (wr == 0) PG8_BAR; }
        E(acc, cur, wr, wc, fr, fq);
        if (!has_next) break;
#pragma unroll
        for (int a = 0; a < 2; ++a)
#pragma unroll
            for (int b = 0; b < 2; ++b)
#pragma unroll
                for (int m = 0; m < 4; ++m)
#pragma unroll
                    for (int n = 0; n < 2; ++n) acc[a][b][m][n] = (f32x4){0.f, 0.f, 0.f, 0.f};
        cur = nxt; cA = nA; cB = nB; ++ui;
        if constexpr (ALIGN_EPI) { if (wr == 1) PG8_BAR; }
    }
    PG8_WAIT_V(0);
    if constexpr (!ALIGN_EPI) { if (wr == 0) PG8_BAR; }
    PG8_BAR;
#undef PG8_SA
#undef PG8_SB
#undef PG8_STAGE
#undef PG8_LDA
#undef PG8_LDB
#undef PG8_MMA
#undef PG8_WAIT_V
#undef PG8_WAIT_L
#undef PG8_BAR
#undef PG8_SCHED
}
}

__device__ __forceinline__ u32x4 pack8(const f32x4& a0, const f32x4& a1) { u32x4 w; w.x = pk2(a0[0], a0[1]); w.y = pk2(a0[2], a0[3]); w.z = pk2(a1[0], a1[1]); w.w = pk2(a1[2], a1[3]); return w; }
struct FP {
    bf16_t* P;
    __device__ __forceinline__ void operator()(int row, int col, const f32x4& a0, const f32x4& a1, const f32x4& b0, const f32x4& b1) const {
        if (col < NIN) *(u32x4*)(P + (size_t)row * NIN + col) = pack8(a0, a1);
        if (col + 128 < NIN) *(u32x4*)(P + (size_t)row * NIN + col + 128) = pack8(b0, b1);
    }
};
struct FQ {
    bf16_t* Q; const float* rstd; const float* rope;
    __device__ __forceinline__ void one(int row, int col, float rs, f32x4 a0, f32x4 a1) const {
        a0 = a0 * rs; a1 = a1 * rs;
        const int c = col % DQK;
        if (c >= 128) { const f32x4* t = (const f32x4*)(rope + ((size_t)row_pos(row) * 32 + ((c - 128) >> 1)) * 2); const f32x4 t0 = t[0], t1 = t[1];
            f32x4 o0, o1;
            o0[0] = a0[0] * t0[0] - a0[1] * t0[1]; o0[1] = a0[1] * t0[0] + a0[0] * t0[1]; o0[2] = a0[2] * t0[2] - a0[3] * t0[3]; o0[3] = a0[3] * t0[2] + a0[2] * t0[3];
            o1[0] = a1[0] * t1[0] - a1[1] * t1[1]; o1[1] = a1[1] * t1[0] + a1[0] * t1[1]; o1[2] = a1[2] * t1[2] - a1[3] * t1[3]; o1[3] = a1[3] * t1[2] + a1[2] * t1[3];
            a0 = o0; a1 = o1; }
        *(u32x4*)(Q + (size_t)row * 768 + col) = pack8(a0, a1);
    }
    __device__ __forceinline__ void operator()(int row, int col, const f32x4& a0, const f32x4& a1, const f32x4& b0, const f32x4& b1) const {
        const float rs = rstd[row] * QSCALE; one(row, col, rs, a0, a1); one(row, col + 128, rs, b0, b1); }
};
struct FKV {
    bf16_t* K; bf16_t* V; const float* rstd;
    __device__ __forceinline__ void one(int row, int col, float rs, const f32x4& a0, const f32x4& a1) const {
        const int h = col >> 8, c = col & 255; const u32x4 w = pack8(a0 * rs, a1 * rs);
        if (c < 128) *(u32x4*)(K + (size_t)row * 768 + h * DQK + c) = w; else *(u32x4*)(V + (size_t)row * 512 + h * DV + (c - 128)) = w; }
    __device__ __forceinline__ void operator()(int row, int col, const f32x4& a0, const f32x4& a1, const f32x4& b0, const f32x4& b1) const {
        const float rs = rstd[row]; one(row, col, rs, a0, a1); one(row, col + 128, rs, b0, b1); }
};
struct FLwa {
    f16_t* EW; f16_t* KMOD; const f16_t* KK; f16_t* Bv; const float* w0; const float* a0p; const float* k_a;
    __device__ __forceinline__ void one(int row, int col, const f32x4& a0, const f32x4& a1) const {
        float v[8] = {a0[0], a0[1], a0[2], a0[3], a1[0], a1[1], a1[2], a1[3]};
        if (col < 512) {
            f16x8 o;
#pragma unroll
            for (int j = 0; j < 8; ++j) { const float xx = w0[col + j] + v[j]; const float sp = (-xx > 20.f) ? -xx : __logf(1.f + __expf(-xx)); o[j] = (f16_t)__expf(-sp - 0.5f); }
            *(f16x8*)(EW + (size_t)row * 512 + col) = o;
        } else {
            const int c = col - 512; const size_t idx = (size_t)row * 512 + c;
            const f16x8 kv = *(const f16x8*)(KMOD + idx), kkv = *(const f16x8*)(KK + idx); f16x8 ko, bo;
#pragma unroll
            for (int j = 0; j < 8; ++j) { const float a = sigmoidf_(a0p[c + j] + v[j]); ko[j] = (f16_t)((float)kv[j] * (1.f + (a - 1.f) * k_a[c + j])); bo[j] = (f16_t)((float)kkv[j] * a); }
            *(f16x8*)(KMOD + idx) = ko; *(f16x8*)(Bv + idx) = bo;
        }
    }
    __device__ __forceinline__ void operator()(int row, int col, const f32x4& a0, const f32x4& a1, const f32x4& b0, const f32x4& b1) const { one(row, col, a0, a1); one(row, col + 128, b0, b1); }
};
struct FG { bf16_t* G;
    __device__ __forceinline__ void operator()(int row, int col, const f32x4& a0, const f32x4& a1, const f32x4& b0, const f32x4& b1) const {
        *(u32x4*)(G + (size_t)row * 512 + col) = pack8(a0, a1); *(u32x4*)(G + (size_t)row * 512 + col + 128) = pack8(b0, b1); } };
struct FOut {
    const float* x; float* H2; bf16_t* H2B; float* ssq;
    __device__ __forceinline__ float one(size_t idx, const f32x4& a0, const f32x4& a1) const {
        const f32x4 h0 = *(const f32x4*)(x + idx) + a0, h1 = *(const f32x4*)(x + idx + 4) + a1;
        *(f32x4*)(H2 + idx) = h0; *(f32x4*)(H2 + idx + 4) = h1; *(u32x4*)(H2B + idx) = pack8(h0, h1);
        return (h0[0] * h0[0] + h0[1] * h0[1]) + (h0[2] * h0[2] + h0[3] * h0[3]) + (h1[0] * h1[0] + h1[1] * h1[1]) + (h1[2] * h1[2] + h1[3] * h1[3]); }
    __device__ __forceinline__ void operator()(int row, int col, const f32x4& a0, const f32x4& a1, const f32x4& b0, const f32x4& b1) const {
        float s = one((size_t)row * DM + col, a0, a1) + one((size_t)row * DM + col + 128, b0, b1);
        s += __shfl_xor(s, 16); s += __shfl_xor(s, 32);
        if ((threadIdx.x & 63) < 16) atomicAdd(ssq + row, s); }
};
struct FAct {
    bf16_t* ACT; const float* ssq;
    __device__ __forceinline__ void operator()(int row, int col, const f32x4& a0, const f32x4& a1, const f32x4& b0, const f32x4& b1) const {
        const float rs = 1.0f / sqrtf(ssq[row] * (1.f / DM) + RMS_EPS);
        f32x4 o0, o1;
#pragma unroll
        for (int j = 0; j < 4; ++j) { const float g0 = a0[j] * rs, g1 = a1[j] * rs; o0[j] = g0 * sigmoidf_(g0) * (b0[j] * rs); o1[j] = g1 * sigmoidf_(g1) * (b1[j] * rs); }
        *(u32x4*)(ACT + (size_t)row * DFF + (col >> 8) * 128 + (col & 127)) = pack8(o0, o1); }
};
struct FDown {
    float* H; float* ssq;
    __device__ __forceinline__ float one(size_t idx, const f32x4& a0, const f32x4& a1) const {
        const f32x4 h0 = *(const f32x4*)(H + idx) + a0, h1 = *(const f32x4*)(H + idx + 4) + a1; *(f32x4*)(H + idx) = h0; *(f32x4*)(H + idx + 4) = h1;
        return (h0[0] * h0[0] + h0[1] * h0[1]) + (h0[2] * h0[2] + h0[3] * h0[3]) + (h1[0] * h1[0] + h1[1] * h1[1]) + (h1[2] * h1[2] + h1[3] * h1[3]); }
    __device__ __forceinline__ void operator()(int row, int col, const f32x4& a0, const f32x4& a1, const f32x4& b0, const f32x4& b1) const {
        float s = one((size_t)row * DM + col, a0, a1) + one((size_t)row * DM + col + 128, b0, b1);
        s += __shfl_xor(s, 16); s += __shfl_xor(s, 32);
        if ((threadIdx.x & 63) < 16) atomicAdd(ssq + row, s); }
};

__device__ __forceinline__ void scan_simple_unit(const Params& p, int unit, int t256) {
    unsigned char* ws = p.ws;
    const f16_t* R = (const f16_t*)(ws + O_R); const f16_t* VV = (const f16_t*)(ws + O_VV); const f16_t* KK = (const f16_t*)(ws + O_KK); const f16_t* KM = (const f16_t*)(ws + O_KMOD);
    const f16_t* EW = (const f16_t*)(ws + O_EW); const f16_t* Bv = (const f16_t*)(ws + O_B);
    float* YRAW = p.out;
    const int bh = unit >> 2, quarter = unit & 3, b = bh >> 3, h = bh & 7;
    const int il = t256 >> 4, c = t256 & 15, i = 16 * quarter + il;
    float S[4] = {0.f, 0.f, 0.f, 0.f};
    const size_t base = ((size_t)b * LP + LPAD) * 512 + h * 64;
    for (int t = 0; t < L; ++t) {
        const size_t o = base + (size_t)t * 512 + 4 * c;
        float w[4], kk[4], bb[4], k[4], r[4];
#pragma unroll
        for (int j = 0; j < 4; ++j) { w[j] = __expf(-(float)EW[o + j]); kk[j] = (float)KK[o + j]; bb[j] = (float)Bv[o + j]; k[j] = (float)KM[o + j]; r[j] = (float)R[o + j]; }
        const float v = (float)VV[base + (size_t)t * 512 + i];
        float sa = 0.f;
#pragma unroll
        for (int j = 0; j < 4; ++j) sa += S[j] * kk[j];
        sa += __shfl_xor(sa, 1); sa += __shfl_xor(sa, 2); sa += __shfl_xor(sa, 4); sa += __shfl_xor(sa, 8);
        sa = -sa;
        float y = 0.f;
#pragma unroll
        for (int j = 0; j < 4; ++j) { S[j] = S[j] * w[j] + sa * bb[j] + v * k[j]; y += S[j] * r[j]; }
        y += __shfl_xor(y, 1); y += __shfl_xor(y, 2); y += __shfl_xor(y, 4); y += __shfl_xor(y, 8);
        if (c == 0) YRAW[base + (size_t)t * 512 + i] = y;
    }
}

__device__ __forceinline__ void attn_simple_unit(const Params& p, float* sm, int unit, int tid) {
    float* Qs = sm;
    float* Ks = Qs + 64 * 192;
    float* Vs = Ks + 64 * 193;
    float* Ps = Vs + 64 * 128;
    unsigned char* ws = p.ws;
    const bf16_t* Q = (const bf16_t*)(ws + O_Q); const bf16_t* Kb = (const bf16_t*)(ws + O_K); const bf16_t* V = (const bf16_t*)(ws + O_V);
    bf16_t* Y = (bf16_t*)(ws + O_Y); const float* og = p.in[19];
    const int qt = unit & 63, h = (unit >> 6) & 3, b = unit >> 8;
    const size_t rb = (size_t)b * LP;
    const int qrow0 = 64 + 64 * qt;
    __syncthreads();
    for (int i = tid; i < 64 * 192; i += 512) { const int r = i / 192, d = i % 192; Qs[i] = bf2f(Q[(rb + qrow0 + r) * 768 + h * DQK + d]); }
    const int qi = (tid & 255) >> 2, sub = tid & 3; const bool act = tid < 256;
    float m = -1e30f, l = 0.f; float o[32];
#pragma unroll
    for (int j = 0; j < 32; ++j) o[j] = 0.f;
    const int nkt = qt + 2;
    for (int kt = 0; kt < nkt; ++kt) {
        __syncthreads();
        for (int i = tid; i < 64 * 192; i += 512) { const int r = i / 192, d = i % 192; Ks[r * 193 + d] = bf2f(Kb[(rb + 64 * kt + r) * 768 + h * DQK + d]); }
        for (int i = tid; i < 64 * 128; i += 512) { const int r = i >> 7, d = i & 127; Vs[i] = bf2f(V[(rb + 64 * kt + r) * 512 + h * DV + d]); }
        __syncthreads();
        float scale = 1.f;
        if (act) {
            float sc[16]; float mx = -1e30f;
#pragma unroll
            for (int kk = 0; kk < 16; ++kk) {
                const int key = sub + 4 * kk; float s = 0.f;
                for (int d = 0; d < 192; ++d) s += Qs[qi * 192 + d] * Ks[key * 193 + d];
                const int krow = 64 * kt + key;
                if (krow < LPAD || krow > qrow0 + qi) s = -1e30f;
                sc[kk] = s; mx = fmaxf(mx, s);
            }
            mx = fmaxf(mx, __shfl_xor(mx, 1)); mx = fmaxf(mx, __shfl_xor(mx, 2));
            const float mn = fmaxf(m, mx); scale = exp2f(m - mn);
            float ps = 0.f;
#pragma unroll
            for (int kk = 0; kk < 16; ++kk) { const float pv = (sc[kk] <= -1e29f) ? 0.f : exp2f(sc[kk] - mn); Ps[qi * 65 + sub + 4 * kk] = pv; ps += pv; }
            ps += __shfl_xor(ps, 1); ps += __shfl_xor(ps, 2);
            l = l * scale + ps; m = mn;
        }
        __syncthreads();
        if (act) {
#pragma unroll
            for (int j = 0; j < 32; ++j) o[j] *= scale;
            for (int key = 0; key < 64; ++key) { const float pv = Ps[qi * 65 + key];
#pragma unroll
                for (int j = 0; j < 32; ++j) o[j] += pv * Vs[key * 128 + sub * 32 + j]; }
        }
    }
    if (act) {
        const float il = 1.f / l; float ss = 0.f;
#pragma unroll
        for (int j = 0; j < 32; ++j) { o[j] *= il; ss += o[j] * o[j]; }
        ss += __shfl_xor(ss, 1); ss += __shfl_xor(ss, 2);
        const float rs = 1.0f / sqrtf(ss * (1.f / DV) + RMS_EPS);
        const size_t yrow = (size_t)b * SEQ + 64 * qt + qi;
#pragma unroll
        for (int j = 0; j < 32; ++j) Y[yrow * DM + 512 + h * DV + sub * 32 + j] = (bf16_t)f2bf(o[j] * rs * og[h * DV + sub * 32 + j]);
    }
}

namespace scan {
#define SC_LAS __attribute__((address_space(3)))
constexpr int TS = 32, STEP_F = 5 * 64 + 16, BUF_F = TS * STEP_F, NCH = (L + TS - 1) / TS;
constexpr int SCAN_LDS = 2 * BUF_F * 4;
typedef _Float16 h8 __attribute__((ext_vector_type(8)));
typedef _Float16 h2 __attribute__((ext_vector_type(2)));
template <int CTRL> __device__ __forceinline__ float dppf(float x) { return __builtin_bit_cast(float, __builtin_amdgcn_update_dpp(0, __builtin_bit_cast(int, x), CTRL, 0xF, 0xF, true)); }
__device__ __forceinline__ float row_sum16(float x) { x += dppf<0xB1>(x); x += dppf<0x4E>(x); x += dppf<0x141>(x); x += dppf<0x140>(x); return x; }

__device__ __forceinline__ void scan_unit(const Params& p, SC_LAS float* lds, int unit) {
    unsigned char* ws = p.ws;
    const int tid = threadIdx.x, lane = tid & 63; const int wave = __builtin_amdgcn_readfirstlane(tid >> 6);
    const int bh = unit >> 2, quarter = unit & 3, b = bh >> 3, h = bh & 7;
    const size_t ebase = ((size_t)b * LP + LPAD) * 512 + h * 64;
    __syncthreads();
    if (wave >= 4) {
        const f16_t* src[5] = {(const f16_t*)(ws + O_EW), (const f16_t*)(ws + O_KK), (const f16_t*)(ws + O_B), (const f16_t*)(ws + O_KMOD), (const f16_t*)(ws + O_R)};
        const f16_t* VV = (const f16_t*)(ws + O_VV);
        const int t2 = tid - 256, tt = t2 >> 3, c8 = (t2 & 7) * 8, pr = t2 & 7;
#pragma nounroll
        for (int ch = 0; ch <= NCH; ++ch) {
            if (ch < NCH) {
                const int t = ch * TS + tt;
                if (t < L) {
                    SC_LAS float* dst = lds + (ch & 1) * BUF_F + tt * STEP_F;
                    const size_t e = ebase + (size_t)t * 512;
#pragma unroll
                    for (int a = 0; a < 5; ++a) {
                        const h8 v = *(const h8*)(src[a] + e + c8);
                        f32x4 lo, hi;
#pragma unroll
                        for (int j = 0; j < 4; ++j) { lo[j] = (float)v[j]; hi[j] = (float)v[4 + j]; }
                        if (a == 0) {
#pragma unroll
                            for (int j = 0; j < 4; ++j) { lo[j] = __expf(-lo[j]); hi[j] = __expf(-hi[j]); }
                        }
                        *(SC_LAS f32x4*)(dst + a * 64 + c8) = lo; *(SC_LAS f32x4*)(dst + a * 64 + c8 + 4) = hi;
                    }
                    const h2 vv = *(const h2*)(VV + e + 16 * quarter + 2 * pr);
                    dst[320 + 2 * pr] = (float)vv[0]; dst[320 + 2 * pr + 1] = (float)vv[1];
                }
            }
            __syncthreads();
        }
    } else {
        const int g = lane >> 4, c = lane & 15, i = 16 * quarter + 4 * wave + g;
        float* yout = p.out + ebase + i;
        typedef float f2 __attribute__((ext_vector_type(2)));
        f2 S01 = {0.f, 0.f}, S23 = {0.f, 0.f};
        __syncthreads();
#pragma nounroll
        for (int ch = 0; ch < NCH; ++ch) {
            const SC_LAS float* st = lds + (ch & 1) * BUF_F + 4 * c;
            const SC_LAS float* sv = lds + (ch & 1) * BUF_F + 320 + 4 * wave + g;
            const int n = (L - ch * TS) < TS ? (L - ch * TS) : TS;
            float* yo = yout + (size_t)(ch * TS + c) * 512;
#pragma nounroll
            for (int tb = 0; tb < n; tb += 16) {
                float ykeep = 0.f;
#pragma unroll
                for (int tt = 0; tt < 16; ++tt) {
                    const f32x4 w4 = *(const SC_LAS f32x4*)(st + tt * STEP_F), kk4 = *(const SC_LAS f32x4*)(st + tt * STEP_F + 64), b4 = *(const SC_LAS f32x4*)(st + tt * STEP_F + 128),
                                k4 = *(const SC_LAS f32x4*)(st + tt * STEP_F + 192), r4 = *(const SC_LAS f32x4*)(st + tt * STEP_F + 256);
                    const float v = sv[tt * STEP_F];
                    f2 pa = S01 * (f2){kk4[0], kk4[1]}; pa = S23 * (f2){kk4[2], kk4[3]} + pa;
                    const float sa = -row_sum16(pa.x + pa.y);
                    const f2 sa2 = {sa, sa}, v2 = {v, v};
                    f2 t01 = v2 * (f2){k4[0], k4[1]}, t23 = v2 * (f2){k4[2], k4[3]};
                    t01 = sa2 * (f2){b4[0], b4[1]} + t01; t23 = sa2 * (f2){b4[2], b4[3]} + t23;
                    S01 = S01 * (f2){w4[0], w4[1]} + t01; S23 = S23 * (f2){w4[2], w4[3]} + t23;
                    f2 py = S01 * (f2){r4[0], r4[1]}; py = S23 * (f2){r4[2], r4[3]} + py;
                    const float y = row_sum16(py.x + py.y);
                    ykeep = (c == tt) ? y : ykeep;
                }
                yo[(size_t)tb * 512] = ykeep;
                st += 16 * STEP_F; sv += 16 * STEP_F;
            }
            __syncthreads();
        }
    }
}
}

namespace chk {
#define CK_LAS __attribute__((address_space(3)))
constexpr int C = 32, NCH = (L + C - 1) / C, NCHH = NB * RH * NCH;
constexpr size_t OUT_PS = 0, OUT_QS = OUT_PS + (size_t)NCHH * 8192, OUT_QY = OUT_QS + (size_t)NCHH * 4096, OUT_END = OUT_QY + (size_t)NCHH * 2048;
static_assert(OUT_END <= (size_t)TR * DM * 4, "chunk matrices fit d_out");
constexpr size_t O_PY = O_END1;
static_assert(O_PY + (size_t)NCHH * 4096 <= 512 * MiB, "Py fits the ws tail");
constexpr size_t O_YRAW = O_EW;
static_assert(O_B == O_EW + ROWB, "YRAW overlay");
typedef short bf16x8 __attribute__((ext_vector_type(8)));

__device__ __forceinline__ void pre_simple(const Params& p, float* sm, int ch_head) {
    unsigned char* ws = p.ws;
    const int tid = threadIdx.x;
    const int bh = ch_head / NCH, ch = ch_head % NCH, b = bh >> 3, h = bh & 7;
    const size_t ebase = ((size_t)b * LP + LPAD) * 512 + h * 64;
    const f16_t* EW = (const f16_t*)(ws + O_EW); const f16_t* KK = (const f16_t*)(ws + O_KK); const f16_t* Bv = (const f16_t*)(ws + O_B); const f16_t* KM = (const f16_t*)(ws + O_KMOD); const f16_t* R = (const f16_t*)(ws + O_R);
    float* At = sm; float* Rt = At + 2048; float* Bt = Rt + 2048; float* Kt = Bt + 2048;
    float* Lm = Kt + 2048; float* Gak = Lm + 1024; float* Gbr = Gak + 1024; float* Gkr = Gbr + 1024;
    float* NT = Gkr + 1024; float* Ah = NT + 1024; float* Gh = Ah + 2048; float* WC = Gh + 1024;
    __syncthreads();
    if (tid < 64) {
        float W = 1.f;
        for (int t = 0; t < C; ++t) {
            const int pos = ch * C + t; float w = 1.f, kk = 0.f, bb = 0.f, k = 0.f, r = 0.f;
            if (pos < L) { const size_t e = ebase + (size_t)pos * 512 + tid; w = __expf(-(float)EW[e]); kk = (float)KK[e]; bb = (float)Bv[e]; k = (float)KM[e]; r = (float)R[e]; }
            const float Wp = W; W *= w; const float iw = 1.f / W;
            At[t * 64 + tid] = -kk * Wp; Rt[t * 64 + tid] = r * W; Bt[t * 64 + tid] = bb * iw; Kt[t * 64 + tid] = k * iw;
        }
        WC[tid] = W;
    }
    __syncthreads();
    for (int e = tid; e < 1024; e += 512) { const int s = e >> 5, t = e & 31; float gab = 0.f, gak = 0.f, gbr = 0.f, gkr = 0.f;
        for (int j = 0; j < 64; ++j) { const float a = At[t * 64 + j], r = Rt[t * 64 + j], bb = Bt[s * 64 + j], k = Kt[s * 64 + j]; gab += bb * a; gak += k * a; gbr += bb * r; gkr += k * r; }
        Lm[t * 32 + s] = s < t ? gab : 0.f; Gak[s * 32 + t] = s < t ? gak : 0.f; Gbr[s * 32 + t] = s <= t ? gbr : 0.f; Gkr[s * 32 + t] = s <= t ? gkr : 0.f; }
    __syncthreads();
    if (tid < 32) {
        for (int t = 0; t < C; ++t) { float x = (t == tid) ? 1.f : 0.f; for (int s = 0; s < t; ++s) x += Lm[t * 32 + s] * NT[s * 32 + tid]; NT[t * 32 + tid] = x; }
    }
    __syncthreads();
    for (int e = tid; e < 2048; e += 512) { const int t = e >> 6, j = e & 63; float x = 0.f; for (int s = 0; s < C; ++s) x += NT[t * 32 + s] * At[s * 64 + j]; Ah[e] = x; }
    for (int e = tid; e < 1024; e += 512) { const int t = e >> 5, s2 = e & 31; float x = 0.f; for (int s = 0; s < C; ++s) x += NT[t * 32 + s] * Gak[s2 * 32 + s]; Gh[e] = x; }
    __syncthreads();
    bf16_t* Ps = (bf16_t*)((unsigned char*)p.out + OUT_PS) + (size_t)ch_head * 4096; bf16_t* Qs = (bf16_t*)((unsigned char*)p.out + OUT_QS) + (size_t)ch_head * 2048;
    bf16_t* Qy = (bf16_t*)((unsigned char*)p.out + OUT_QY) + (size_t)ch_head * 1024; bf16_t* Py = (bf16_t*)(ws + O_PY) + (size_t)ch_head * 2048;
    for (int e = tid; e < 4096; e += 512) { const int j = e >> 6, j2 = e & 63; float x = (j == j2) ? 1.f : 0.f; for (int s = 0; s < C; ++s) x += Bt[s * 64 + j] * Ah[s * 64 + j2]; Ps[e] = (bf16_t)f2bf(x * WC[j]); }
    for (int e = tid; e < 2048; e += 512) { const int j = e >> 5, s2 = e & 31; float x = Kt[s2 * 64 + j]; for (int s = 0; s < C; ++s) x += Bt[s * 64 + j] * Gh[s * 32 + s2]; Qs[e] = (bf16_t)f2bf(x * WC[j]); }
    for (int e = tid; e < 2048; e += 512) { const int t = e >> 6, j = e & 63; float x = Rt[e]; for (int s = 0; s < C; ++s) x += Gbr[s * 32 + t] * Ah[s * 64 + j]; Py[e] = (bf16_t)f2bf(x); }
    for (int e = tid; e < 1024; e += 512) { const int t = e >> 5, s2 = e & 31; float x = Gkr[s2 * 32 + t]; for (int s = 0; s < C; ++s) x += Gbr[s * 32 + t] * Gh[s * 32 + s2]; Qy[e] = (bf16_t)f2bf(x); }
}

typedef float f32x16 __attribute__((ext_vector_type(16)));
typedef short s16x4 __attribute__((ext_vector_type(4)));
constexpr int TMS = 144, TMB = 32 * TMS;
constexpr int L_TM = 0, L_LF = 4 * TMB, L_NT = L_LF + 4096, NTS = 80, L_WC = L_NT + 32 * NTS, PRE_LDS = L_WC + 256;
constexpr int PRE_WAVES = 6;
static_assert(PRE_WAVES * PRE_LDS + 256 <= 153600, "precompute LDS");
__device__ __forceinline__ int crow(int i, int hi) { return (i & 3) + 8 * (i >> 2) + 4 * hi; }
__device__ __forceinline__ unsigned cvtpk(float lo, float hi) { typedef float f2_ __attribute__((ext_vector_type(2))); typedef __bf16 b2_ __attribute__((ext_vector_type(2))); f2_ v = {lo, hi}; b2_ b = __builtin_convertvector(v, b2_); return __builtin_bit_cast(unsigned, b); }
__device__ __forceinline__ s16x4 trd(const CK_LAS unsigned char* p) { return __builtin_bit_cast(s16x4, __builtin_amdgcn_ds_read_tr16_b64_v4i16((CK_LAS s16x4*)p)); }
__device__ __forceinline__ bf16x8 dfrag(const f32x16& x, int s) {
    const u32x4 w = (u32x4){cvtpk(x[8 * s], x[8 * s + 1]), cvtpk(x[8 * s + 2], x[8 * s + 3]), cvtpk(x[8 * s + 4], x[8 * s + 5]), cvtpk(x[8 * s + 6], x[8 * s + 7])};
    return __builtin_bit_cast(bf16x8, w);
}
__device__ __forceinline__ f32x16 zero16() { f32x16 z; _Pragma("unroll") for (int i = 0; i < 16; ++i) z[i] = 0.f; return z; }
#define MF32(a, b, c) __builtin_amdgcn_mfma_f32_32x32x16_bf16((a), (b), (c), 0, 0, 0)

__device__ __forceinline__ void pre_mfma(const Params& p, CK_LAS unsigned char* lw, int ch_head) {
    unsigned char* ws = p.ws;
    const int lane = threadIdx.x & 63, r32 = lane & 31, hi = lane >> 5;
    const int bh = ch_head / NCH, ch = ch_head % NCH, b = bh >> 3, h = bh & 7;
    {
        const size_t e0 = ((size_t)b * LP + LPAD + (size_t)ch * C) * 512 + h * 64 + lane;
        const f16_t* EW = (const f16_t*)(ws + O_EW) + e0; const f16_t* KK = (const f16_t*)(ws + O_KK) + e0; const f16_t* Bv = (const f16_t*)(ws + O_B) + e0;
        const f16_t* KM = (const f16_t*)(ws + O_KMOD) + e0; const f16_t* R = (const f16_t*)(ws + O_R) + e0;
        const int nvalid = (L - ch * C) < C ? (L - ch * C) : C;
        float W = 1.f;
        CK_LAS unsigned short* tm = (CK_LAS unsigned short*)(lw + L_TM) + lane;
#pragma nounroll
        for (int t8 = 0; t8 < C; t8 += 8) {
            f16_t hw[8], hk[8], hb[8], hm[8], hr[8];
#pragma unroll
            for (int q = 0; q < 8; ++q) { const int o = (t8 + q) * 512; hw[q] = EW[o]; hk[q] = KK[o]; hb[q] = Bv[o]; hm[q] = KM[o]; hr[q] = R[o]; }
#pragma unroll
            for (int q = 0; q < 8; ++q) {
                const int t = t8 + q; const bool ok = t < nvalid;
                const float w = ok ? __expf(-(float)hw[q]) : 1.f, kk = ok ? (float)hk[q] : 0.f, bb = ok ? (float)hb[q] : 0.f, k = ok ? (float)hm[q] : 0.f, r = ok ? (float)hr[q] : 0.f;
                const float Wp = W; W *= w; const float iw = __builtin_amdgcn_rcpf(W);
                tm[t * (TMS / 2)] = (unsigned short)f2bf(-kk * Wp);
                tm[t * (TMS / 2) + TMB / 2] = (unsigned short)f2bf(r * W);
                tm[t * (TMS / 2) + 2 * (TMB / 2)] = (unsigned short)f2bf(bb * iw);
                tm[t * (TMS / 2) + 3 * (TMB / 2)] = (unsigned short)f2bf(k * iw);
            }
        }
        ((CK_LAS float*)(lw + L_WC))[lane] = W;
    }
    f32x16 Lm = zero16(), G2 = zero16(), Gbr = zero16(), Gkr = zero16();
    {
        const CK_LAS unsigned char* fp = lw + L_TM + r32 * TMS + hi * 16;
#pragma unroll
        for (int ks = 0; ks < 4; ++ks) {
            const bf16x8 fa = *(const CK_LAS bf16x8*)(fp + ks * 32), fr = *(const CK_LAS bf16x8*)(fp + TMB + ks * 32), fb = *(const CK_LAS bf16x8*)(fp + 2 * TMB + ks * 32), fk = *(const CK_LAS bf16x8*)(fp + 3 * TMB + ks * 32);
            Lm = MF32(fa, fb, Lm);
            G2 = MF32(fa, fk, G2);
            Gbr = MF32(fb, fr, Gbr);
            Gkr = MF32(fk, fr, Gkr);
        }
#pragma unroll
        for (int i = 0; i < 16; ++i) { const int row = crow(i, hi);
            if (!(r32 < row)) { Lm[i] = 0.f; G2[i] = 0.f; }
            if (row > r32) { Gbr[i] = 0.f; Gkr[i] = 0.f; } }
    }
    {
        CK_LAS float* lf = (CK_LAS float*)(lw + L_LF);
#pragma unroll
        for (int i = 0; i < 16; ++i) lf[crow(i, hi) * 32 + r32] = Lm[i];
        float x[C];
#pragma unroll
        for (int t = 0; t < C; ++t) {
            float acc = (t == r32) ? 1.f : 0.f;
#pragma unroll
            for (int s4 = 0; s4 < (t + 3) / 4; ++s4) { const f32x4 l4 = *(const CK_LAS f32x4*)(lf + t * 32 + 4 * s4);
#pragma unroll
                for (int e = 0; e < 4; ++e) if (4 * s4 + e < t) acc = __builtin_fmaf(l4[e], x[4 * s4 + e], acc); }
            x[t] = acc;
        }
        CK_LAS unsigned short* nt = (CK_LAS unsigned short*)(lw + L_NT) + r32;
        if (hi == 0) {
#pragma unroll
            for (int t = 0; t < C; ++t) nt[t * (NTS / 2)] = (unsigned short)f2bf(x[t]);
        }
    }
    const CK_LAS unsigned char* trb = lw + L_TM + ((lane & 15) >> 2) * TMS + (((lane >> 4) & 1) * 16 + (lane & 3) * 4) * 2;
    f32x16 Ah[2] = {zero16(), zero16()};
    {
        const CK_LAS unsigned char* np_ = lw + L_NT + r32 * NTS + hi * 16;
#pragma unroll
        for (int ks = 0; ks < 2; ++ks) {
            const bf16x8 fn = *(const CK_LAS bf16x8*)(np_ + ks * 32);
#pragma unroll
            for (int cb = 0; cb < 2; ++cb) {
                const s16x4 lo = trd(trb + (16 * ks + 8 * hi) * TMS + 64 * cb), hh = trd(trb + (16 * ks + 8 * hi + 4) * TMS + 64 * cb);
                const bf16x8 fb = (bf16x8){lo[0], lo[1], lo[2], lo[3], hh[0], hh[1], hh[2], hh[3]};
                Ah[cb] = MF32(fn, fb, Ah[cb]);
            }
        }
    }
    f32x16 Gh = zero16();
    {
        const CK_LAS unsigned char* np_ = lw + L_NT + r32 * NTS + hi * 8;
#pragma unroll
        for (int ks = 0; ks < 2; ++ks) {
            const u32x2 lo = *(const CK_LAS u32x2*)(np_ + ks * 32), hh = *(const CK_LAS u32x2*)(np_ + ks * 32 + 16);
            const u32x4 a = (u32x4){lo.x, lo.y, hh.x, hh.y};
            Gh = MF32(__builtin_bit_cast(bf16x8, a), dfrag(G2, ks), Gh);
        }
    }
    bf16_t* Ps = (bf16_t*)((unsigned char*)p.out + OUT_PS) + (size_t)ch_head * 4096; bf16_t* Qs = (bf16_t*)((unsigned char*)p.out + OUT_QS) + (size_t)ch_head * 2048;
    bf16_t* Qy = (bf16_t*)((unsigned char*)p.out + OUT_QY) + (size_t)ch_head * 1024; bf16_t* Py = (bf16_t*)(ws + O_PY) + (size_t)ch_head * 2048;
#pragma unroll
    for (int rb = 0; rb < 2; ++rb) {
        f32x16 acc;
        { const CK_LAS unsigned char* rp = lw + L_TM + TMB + r32 * TMS + (32 * rb + 4 * hi) * 2;
#pragma unroll
          for (int gq = 0; gq < 4; ++gq) { const u32x2 v = *(const CK_LAS u32x2*)(rp + 16 * gq);
              acc[4 * gq] = bf2f(v.x & 0xffffu); acc[4 * gq + 1] = bf2f(v.x >> 16); acc[4 * gq + 2] = bf2f(v.y & 0xffffu); acc[4 * gq + 3] = bf2f(v.y >> 16); } }
#pragma unroll
        for (int ks = 0; ks < 2; ++ks) acc = MF32(dfrag(Ah[rb], ks), dfrag(Gbr, ks), acc);
        bf16_t* o = Py + r32 * 64 + 32 * rb + 4 * hi;
#pragma unroll
        for (int gq = 0; gq < 4; ++gq) *(u32x2*)(o + 8 * gq) = (u32x2){cvtpk(acc[4 * gq], acc[4 * gq + 1]), cvtpk(acc[4 * gq + 2], acc[4 * gq + 3])};
    }
    {
        f32x16 acc = Gkr;
#pragma unroll
        for (int ks = 0; ks < 2; ++ks) acc = MF32(dfrag(Gh, ks), dfrag(Gbr, ks), acc);
        bf16_t* o = Qy + r32 * 32 + 4 * hi;
#pragma unroll
        for (int gq = 0; gq < 4; ++gq) *(u32x2*)(o + 8 * gq) = (u32x2){cvtpk(acc[4 * gq], acc[4 * gq + 1]), cvtpk(acc[4 * gq + 2], acc[4 * gq + 3])};
    }
    {
        const CK_LAS float* wcp = (const CK_LAS float*)(lw + L_WC);
        bf16x8 ident[2];
#pragma unroll
        for (int ks = 0; ks < 2; ++ks) { u32x4 w;
#pragma unroll
            for (int q = 0; q < 4; ++q) { const int k0 = 16 * ks + 8 * hi + 2 * q; w[q] = (k0 == r32 ? 0x3f80u : 0u) | (k0 + 1 == r32 ? 0x3f800000u : 0u); }
            ident[ks] = __builtin_bit_cast(bf16x8, w); }
#pragma unroll
        for (int cb = 0; cb < 2; ++cb) {
            const float wc = wcp[r32 + 32 * cb];
            bf16x8 fbp[2], fkn[2];
#pragma unroll
            for (int ks = 0; ks < 2; ++ks) {
                const s16x4 lo = trd(trb + 2 * TMB + (16 * ks + 4 * hi) * TMS + 64 * cb), hh = trd(trb + 2 * TMB + (16 * ks + 8 + 4 * hi) * TMS + 64 * cb);
                fbp[ks] = (bf16x8){lo[0], lo[1], lo[2], lo[3], hh[0], hh[1], hh[2], hh[3]};
                const s16x4 lo2 = trd(trb + 3 * TMB + (16 * ks + 8 * hi) * TMS + 64 * cb), hh2 = trd(trb + 3 * TMB + (16 * ks + 8 * hi + 4) * TMS + 64 * cb);
                fkn[ks] = (bf16x8){lo2[0], lo2[1], lo2[2], lo2[3], hh2[0], hh2[1], hh2[2], hh2[3]};
            }
#pragma unroll
            for (int rb = 0; rb < 2; ++rb) {
                f32x16 acc = zero16();
#pragma unroll
                for (int ks = 0; ks < 2; ++ks) acc = MF32(dfrag(Ah[rb], ks), fbp[ks], acc);
                bf16_t* o = Ps + (32 * cb + r32) * 64 + 32 * rb + 4 * hi;
#pragma unroll
                for (int gq = 0; gq < 4; ++gq) {
                    float v[4];
#pragma unroll
                    for (int e = 0; e < 4; ++e) { const int r = 32 * rb + crow(4 * gq + e, hi); v[e] = (acc[4 * gq + e] + ((r == 32 * cb + r32) ? 1.f : 0.f)) * wc; }
                    *(u32x2*)(o + 8 * gq) = (u32x2){cvtpk(v[0], v[1]), cvtpk(v[2], v[3])};
                }
            }
            {
                f32x16 acc = zero16();
#pragma unroll
                for (int ks = 0; ks < 2; ++ks) { acc = MF32(dfrag(Gh, ks), fbp[ks], acc); acc = MF32(ident[ks], fkn[ks], acc); }
                bf16_t* o = Qs + (32 * cb + r32) * 32 + 4 * hi;
#pragma unroll
                for (int gq = 0; gq < 4; ++gq) *(u32x2*)(o + 8 * gq) = (u32x2){cvtpk(acc[4 * gq] * wc, acc[4 * gq + 1] * wc), cvtpk(acc[4 * gq + 2] * wc, acc[4 * gq + 3] * wc)};
            }
        }
    }
}
#undef MF32

__device__ __forceinline__ void seq_wave(const Params& p, int item) {
    unsigned char* ws = p.ws;
    const int lane = threadIdx.x & 63, n = lane & 15, g = lane >> 4;
    const int bh = item >> 2, vb = item & 3, b = bh >> 3, h = bh & 7;
    const size_t ebase = ((size_t)b * LP + LPAD) * 512 + h * 64 + 16 * vb + n;
    const f16_t* VV = (const f16_t*)(ws + O_VV);
    float* YR = (float*)(ws + O_YRAW);
    const bf16_t* Ps = (const bf16_t*)((const unsigned char*)p.out + OUT_PS) + (size_t)bh * NCH * 4096; const bf16_t* Qs = (const bf16_t*)((const unsigned char*)p.out + OUT_QS) + (size_t)bh * NCH * 2048;
    const bf16_t* Qy = (const bf16_t*)((const unsigned char*)p.out + OUT_QY) + (size_t)bh * NCH * 1024; const bf16_t* Py = (const bf16_t*)(ws + O_PY) + (size_t)bh * NCH * 2048;
    f32x4 T[4];
#pragma unroll
    for (int rb = 0; rb < 4; ++rb) T[rb] = (f32x4){0.f, 0.f, 0.f, 0.f};
    struct Ops { u32x2 ps[4][2][2]; u32x4 qs[4]; u32x2 py[2][2][2]; u32x4 qy[2]; f16_t v[8]; };
#define SQ_LOAD(O, ch_) do { const int c_ = (ch_) < NCH ? (ch_) : NCH - 1; \
        const bf16_t* ps_ = Ps + (size_t)c_ * 4096 + n * 64 + 4 * g; const bf16_t* py_ = Py + (size_t)c_ * 2048 + n * 64 + 4 * g; \
        const bf16_t* qs_ = Qs + (size_t)c_ * 2048 + n * 32 + 8 * g; const bf16_t* qy_ = Qy + (size_t)c_ * 1024 + n * 32 + 8 * g; \
        _Pragma("unroll") for (int rb = 0; rb < 4; ++rb) { _Pragma("unroll") for (int ks = 0; ks < 2; ++ks) { O.ps[rb][ks][0] = *(const u32x2*)(ps_ + rb * 1024 + 32 * ks); O.ps[rb][ks][1] = *(const u32x2*)(ps_ + rb * 1024 + 32 * ks + 16); } \
            O.qs[rb] = *(const u32x4*)(qs_ + rb * 512); } \
        _Pragma("unroll") for (int tb = 0; tb < 2; ++tb) { _Pragma("unroll") for (int ks = 0; ks < 2; ++ks) { O.py[tb][ks][0] = *(const u32x2*)(py_ + tb * 1024 + 32 * ks); O.py[tb][ks][1] = *(const u32x2*)(py_ + tb * 1024 + 32 * ks + 16); } \
            O.qy[tb] = *(const u32x4*)(qy_ + tb * 512); } \
        _Pragma("unroll") for (int j = 0; j < 8; ++j) { int pos_ = c_ * C + 8 * g + j; if (pos_ > L - 1) pos_ = L - 1; O.v[j] = VV[ebase + (size_t)pos_ * 512]; } } while (0)
#define SQ_STEP(O, ch_) do { \
        bf16x8 bt[2], bv; \
        _Pragma("unroll") for (int ks = 0; ks < 2; ++ks) { const f32x4 x0 = T[2 * ks], x1 = T[2 * ks + 1]; \
            const u32x4 w_ = (u32x4){pk2(x0[0], x0[1]), pk2(x0[2], x0[3]), pk2(x1[0], x1[1]), pk2(x1[2], x1[3])}; bt[ks] = __builtin_bit_cast(bf16x8, w_); } \
        { float vv[8]; _Pragma("unroll") for (int j = 0; j < 8; ++j) vv[j] = ((ch_) * C + 8 * g + j < L) ? (float)O.v[j] : 0.f; \
          const u32x4 w_ = (u32x4){pk2(vv[0], vv[1]), pk2(vv[2], vv[3]), pk2(vv[4], vv[5]), pk2(vv[6], vv[7])}; bv = __builtin_bit_cast(bf16x8, w_); } \
        f32x4 Tn[4]; \
        _Pragma("unroll") for (int rb = 0; rb < 4; ++rb) { f32x4 acc = (f32x4){0.f, 0.f, 0.f, 0.f}; \
            _Pragma("unroll") for (int ks = 0; ks < 2; ++ks) { const u32x4 a_ = (u32x4){O.ps[rb][ks][0].x, O.ps[rb][ks][0].y, O.ps[rb][ks][1].x, O.ps[rb][ks][1].y}; \
                acc = __builtin_amdgcn_mfma_f32_16x16x32_bf16(__builtin_bit_cast(bf16x8, a_), bt[ks], acc, 0, 0, 0); } \
            acc = __builtin_amdgcn_mfma_f32_16x16x32_bf16(__builtin_bit_cast(bf16x8, O.qs[rb]), bv, acc, 0, 0, 0); Tn[rb] = acc; } \
        _Pragma("unroll") for (int tb = 0; tb < 2; ++tb) { f32x4 acc = (f32x4){0.f, 0.f, 0.f, 0.f}; \
            _Pragma("unroll") for (int ks = 0; ks < 2; ++ks) { const u32x4 a_ = (u32x4){O.py[tb][ks][0].x, O.py[tb][ks][0].y, O.py[tb][ks][1].x, O.py[tb][ks][1].y}; \
                acc = __builtin_amdgcn_mfma_f32_16x16x32_bf16(__builtin_bit_cast(bf16x8, a_), bt[ks], acc, 0, 0, 0); } \
            acc = __builtin_amdgcn_mfma_f32_16x16x32_bf16(__builtin_bit_cast(bf16x8, O.qy[tb]), bv, acc, 0, 0, 0); \
            _Pragma("unroll") for (int r = 0; r < 4; ++r) { const int pos_ = (ch_) * C + 16 * tb + 4 * g + r; if (pos_ < L) YR[ebase + (size_t)pos_ * 512] = acc[r]; } } \
        _Pragma("unroll") for (int rb = 0; rb < 4; ++rb) T[rb] = Tn[rb]; } while (0)
    Ops A, B;
    SQ_LOAD(A, 0);
#pragma nounroll
    for (int ch = 0; ch < NCH; ch += 2) {
        SQ_LOAD(B, ch + 1);
        SQ_STEP(A, ch);
        if (ch + 1 < NCH) { SQ_LOAD(A, ch + 2); SQ_STEP(B, ch + 1); }
    }
#undef SQ_LOAD
#undef SQ_STEP
}
constexpr int SQ_PS = 0, SQ_PY = 9216, SQ_QS = 13824, SQ_QY = 18944, SQ_VT = 21504, SQ_SLOT = 26624, SQ_NSLOT = 5;
static_assert(SQ_NSLOT * SQ_SLOT + 256 <= 153600, "seq ring");
__device__ __forceinline__ void seq_block(const Params& p, CK_LAS unsigned char* lds, int bh) {
    unsigned char* ws = p.ws;
    const int tid = threadIdx.x, lane = tid & 63; const int wave = __builtin_amdgcn_readfirstlane(tid >> 6);
    const int b = bh >> 3, h = bh & 7;
    const size_t erow = ((size_t)b * LP + LPAD) * 512 + h * 64;
    const unsigned char* gPs = (const unsigned char*)p.out + OUT_PS + (size_t)bh * NCH * 8192; const unsigned char* gQs = (const unsigned char*)p.out + OUT_QS + (size_t)bh * NCH * 4096;
    const unsigned char* gQy = (const unsigned char*)p.out + OUT_QY + (size_t)bh * NCH * 2048; const unsigned char* gPy = ws + O_PY + (size_t)bh * NCH * 4096;
#define SQ_BAR() do { asm volatile("s_waitcnt lgkmcnt(0)" ::: "memory"); __builtin_amdgcn_s_barrier(); asm volatile("" ::: "memory"); } while (0)
    __syncthreads();
    if (wave >= 4) {
        const int lt = tid - 256;
        const f16_t* VV = (const f16_t*)(ws + O_VV) + erow;
        struct Set { u32x4 ps0, ps1, py, qs, qy, v; };
        Set S0, S1, S2, S3, S4, S5, S6, S7;
#define LD_SET(S, ch_) do { const int c_ = (ch_) < NCH ? (ch_) : NCH - 1; \
            S.ps0 = *(const u32x4*)(gPs + (size_t)c_ * 8192 + lt * 16); S.ps1 = *(const u32x4*)(gPs + (size_t)c_ * 8192 + 4096 + lt * 16); \
            S.py = *(const u32x4*)(gPy + (size_t)c_ * 4096 + lt * 16); S.qs = *(const u32x4*)(gQs + (size_t)c_ * 4096 + lt * 16); \
            S.qy = *(const u32x4*)(gQy + (size_t)c_ * 2048 + (lt & 127) * 16); \
            { int pos_ = c_ * C + (lt >> 3); if (pos_ > L - 1) pos_ = L - 1; S.v = *(const u32x4*)(VV + (size_t)pos_ * 512 + (lt & 7) * 8); } } while (0)
#define WR_SET(S, ch_, slot_) do { CK_LAS unsigned char* d_ = lds + (slot_) * SQ_SLOT; \
            *(CK_LAS u32x4*)(d_ + SQ_PS + (lt >> 3) * 144 + (lt & 7) * 16) = S.ps0; *(CK_LAS u32x4*)(d_ + SQ_PS + (32 + (lt >> 3)) * 144 + (lt & 7) * 16) = S.ps1; \
            *(CK_LAS u32x4*)(d_ + SQ_PY + (lt >> 3) * 144 + (lt & 7) * 16) = S.py; *(CK_LAS u32x4*)(d_ + SQ_QS + (lt >> 2) * 80 + (lt & 3) * 16) = S.qs; \
            if (lt < 128) *(CK_LAS u32x4*)(d_ + SQ_QY + (lt >> 2) * 80 + (lt & 3) * 16) = S.qy; \
            { const bool ok_ = (ch_) * C + (lt >> 3) < L; CK_LAS unsigned short* vt_ = (CK_LAS unsigned short*)(d_ + SQ_VT + ((lt & 7) * 8) * 80) + (lt >> 3); \
              const f16x8 hv_ = __builtin_bit_cast(f16x8, S.v); \
              _Pragma("unroll") for (int e_ = 0; e_ < 8; ++e_) vt_[e_ * 40] = ok_ ? (unsigned short)f2bf((float)hv_[e_]) : (unsigned short)0; } } while (0)
        LD_SET(S0, 0); LD_SET(S1, 1); WR_SET(S0, 0, 0); WR_SET(S1, 1, 1);
        LD_SET(S2, 2); LD_SET(S3, 3); LD_SET(S4, 4); LD_SET(S5, 5); LD_SET(S6, 6); LD_SET(S7, 7); LD_SET(S0, 8); LD_SET(S1, 9);
        SQ_BAR();
        int slot = 2;
#define SQ_IT(S, cc_) do { WR_SET(S, (cc_) + 2, slot); LD_SET(S, (cc_) + 10); slot = slot == SQ_NSLOT - 1 ? 0 : slot + 1; SQ_BAR(); } while (0)
#pragma nounroll
        for (int c = 0; c < NCH + 3; c += 8) {
            SQ_IT(S2, c); SQ_IT(S3, c + 1); SQ_IT(S4, c + 2); SQ_IT(S5, c + 3); SQ_IT(S6, c + 4); SQ_IT(S7, c + 5); SQ_IT(S0, c + 6); SQ_IT(S1, c + 7);
        }
#undef SQ_IT
#undef LD_SET
#undef WR_SET
    } else {
        const int n = lane & 15, g = lane >> 4, vb = wave;
        float* YR = (float*)(ws + O_YRAW) + erow + 16 * vb + n;
        f32x4 T[4];
#pragma unroll
        for (int rb = 0; rb < 4; ++rb) T[rb] = (f32x4){0.f, 0.f, 0.f, 0.f};
        const CK_LAS unsigned char* pA = lds + SQ_PS + n * 144 + 8 * g;
        const CK_LAS unsigned char* pY = lds + SQ_PY + n * 144 + 8 * g;
        const CK_LAS unsigned char* pQ = lds + SQ_QS + n * 80 + 16 * g;
        const CK_LAS unsigned char* pZ = lds + SQ_QY + n * 80 + 16 * g;
        const CK_LAS unsigned char* pV = lds + SQ_VT + (16 * vb + n) * 80 + 16 * g;
        SQ_BAR();
        int slot = 0;
#pragma nounroll
        for (int c = 0; c < 136; ++c) {
            if (c < NCH) {
                const int so = slot * SQ_SLOT;
                bf16x8 bt[2];
#pragma unroll
                for (int ks = 0; ks < 2; ++ks) { const f32x4 x0 = T[2 * ks], x1 = T[2 * ks + 1];
                    const u32x4 w = (u32x4){cvtpk(x0[0], x0[1]), cvtpk(x0[2], x0[3]), cvtpk(x1[0], x1[1]), cvtpk(x1[2], x1[3])}; bt[ks] = __builtin_bit_cast(bf16x8, w); }
                const bf16x8 bv = *(const CK_LAS bf16x8*)(pV + so);
#pragma unroll
                for (int rb = 0; rb < 4; ++rb) {
                    f32x4 acc = (f32x4){0.f, 0.f, 0.f, 0.f};
#pragma unroll
                    for (int ks = 0; ks < 2; ++ks) { const u32x2 lo = *(const CK_LAS u32x2*)(pA + so + rb * 2304 + 64 * ks), hh = *(const CK_LAS u32x2*)(pA + so + rb * 2304 + 64 * ks + 32);
                        const u32x4 a = (u32x4){lo.x, lo.y, hh.x, hh.y}; acc = __builtin_amdgcn_mfma_f32_16x16x32_bf16(__builtin_bit_cast(bf16x8, a), bt[ks], acc, 0, 0, 0); }
                    acc = __builtin_amdgcn_mfma_f32_16x16x32_bf16(*(const CK_LAS bf16x8*)(pQ + so + rb * 1280), bv, acc, 0, 0, 0);
                    T[rb] = acc;
                }
#pragma unroll
                for (int tb = 0; tb < 2; ++tb) {
                    f32x4 acc = (f32x4){0.f, 0.f, 0.f, 0.f};
#pragma unroll
                    for (int ks = 0; ks < 2; ++ks) { const u32x2 lo = *(const CK_LAS u32x2*)(pY + so + tb * 2304 + 64 * ks), hh = *(const CK_LAS u32x2*)(pY + so + tb * 2304 + 64 * ks + 32);
                        const u32x4 a = (u32x4){lo.x, lo.y, hh.x, hh.y}; acc = __builtin_amdgcn_mfma_f32_16x16x32_bf16(__builtin_bit_cast(bf16x8, a), bt[ks], acc, 0, 0, 0); }
                    acc = __builtin_amdgcn_mfma_f32_16x16x32_bf16(*(const CK_LAS bf16x8*)(pZ + so + tb * 1280), bv, acc, 0, 0, 0);
#pragma unroll
                    for (int r = 0; r < 4; ++r) { const int pos = c * C + 16 * tb + 4 * g + r; if (pos < L) YR[(size_t)pos * 512] = acc[r]; }
                }
            }
            slot = slot == SQ_NSLOT - 1 ? 0 : slot + 1;
            SQ_BAR();
        }
    }
#undef SQ_BAR
}
}

namespace att {
#define ATT_LAS __attribute__((address_space(3)))
typedef float f32x16 __attribute__((ext_vector_type(16)));
typedef short bf16x8 __attribute__((ext_vector_type(8)));
typedef short s16x4 __attribute__((ext_vector_type(4)));
typedef float f32x2_t __attribute__((ext_vector_type(2)));
typedef __bf16 bf16x2_t __attribute__((ext_vector_type(2)));
constexpr int KROW = 400, VROW = 320, KBUF = 64 * KROW, VBUF = 64 * VROW;
constexpr int L_K = 0, L_V = 2 * KBUF, L_SCR = 2 * KBUF + 2 * VBUF, ATT_LDS = L_SCR + 8 * 256;
__device__ __forceinline__ int crow(int i, int hi) { return (i & 3) + 8 * (i >> 2) + 4 * hi; }
__device__ __forceinline__ unsigned cvtpk(float lo, float hi) { f32x2_t v = {lo, hi}; bf16x2_t b = __builtin_convertvector(v, bf16x2_t); return __builtin_bit_cast(unsigned, b); }
template <int K> __device__ __forceinline__ float swz_xor(float x) { return __builtin_bit_cast(float, __builtin_amdgcn_ds_swizzle(__builtin_bit_cast(int, x), 0x1F | (K << 10))); }
__device__ __forceinline__ float x32_max(float x) { float a = x, b = x; asm volatile("s_nop 1\n\tv_permlane32_swap_b32 %0, %1" : "+v"(a), "+v"(b)); return fmaxf(a, b); }
__device__ __forceinline__ float x32_sum(float x) { float a = x, b = x; asm volatile("s_nop 1\n\tv_permlane32_swap_b32 %0, %1" : "+v"(a), "+v"(b)); return a + b; }
__device__ __forceinline__ s16x4 vtr(const ATT_LAS unsigned char* p) { return __builtin_bit_cast(s16x4, __builtin_amdgcn_ds_read_tr16_b64_v4i16((ATT_LAS s16x4*)p)); }

__device__ __forceinline__ void attn_unit(const Params& p, ATT_LAS unsigned char* lds, int b, int h, int qblk) {
    const int tid = threadIdx.x, lane = tid & 63, r32 = lane & 31, hi = lane >> 5; const int w = __builtin_amdgcn_readfirstlane(tid >> 6);
    unsigned char* ws = p.ws;
    const bf16_t* Q = (const bf16_t*)(ws + O_Q); const bf16_t* Kg = (const bf16_t*)(ws + O_K); const bf16_t* Vg = (const bf16_t*)(ws + O_V);
    const size_t rowbase = (size_t)b * LP;
    const int qrow = 64 + 256 * qblk + 32 * w + r32;
    const int NT = 4 * qblk + 5, jband = 4 * qblk + 1, jdiag = jband + (w >> 1);
    bf16x8 qf[12];
    { const bf16_t* qp = Q + (rowbase + qrow) * 768 + h * DQK + 8 * hi;
#pragma unroll
      for (int s = 0; s < 12; ++s) qf[s] = *(const bf16x8*)(qp + 16 * s); }
    const unsigned char* kbase = (const unsigned char*)(Kg + rowbase * 768 + h * DQK);
    const unsigned char* vbase = (const unsigned char*)(Vg + rowbase * 512 + h * DV);
    const unsigned sr = (unsigned)tid >> 3, sc8 = ((unsigned)tid & 7u) * 16u;
    const unsigned ko = sr * 1536u + sc8, vo = sr * 1024u + sc8, kl = (unsigned)L_K + sr * KROW + sc8, vl = (unsigned)L_V + sr * VROW + sc8;
    u32x4 sk[3], sv[2];
#define ATT_LOAD(j) do { const unsigned char* kb_ = kbase + (size_t)(j) * (64 * 768 * 2) + ko; const unsigned char* vb_ = vbase + (size_t)(j) * (64 * 512 * 2) + vo; \
                         _Pragma("unroll") for (int i_ = 0; i_ < 3; ++i_) sk[i_] = *(const u32x4*)(kb_ + 128 * i_); \
                         _Pragma("unroll") for (int i_ = 0; i_ < 2; ++i_) sv[i_] = *(const u32x4*)(vb_ + 128 * i_); } while (0)
#define ATT_WRITE(buf) do { _Pragma("unroll") for (int i_ = 0; i_ < 3; ++i_) *(ATT_LAS u32x4*)(lds + kl + (buf) * KBUF + 128 * i_) = sk[i_]; \
                            _Pragma("unroll") for (int i_ = 0; i_ < 2; ++i_) *(ATT_LAS u32x4*)(lds + vl + (buf) * VBUF + 128 * i_) = sv[i_]; } while (0)
    ATT_LAS float* scr = (ATT_LAS float*)(lds + L_SCR + w * 256);
    f32x16 o[4];
#pragma unroll
    for (int d = 0; d < 4; ++d)
#pragma unroll
        for (int i = 0; i < 16; ++i) o[d][i] = 0.f;
    float m = -1e30f, lsum = 0.f;
    const ATT_LAS unsigned char* kp0 = lds + L_K + r32 * KROW + hi * 16;
    const ATT_LAS unsigned char* vp0 = lds + L_V + (4 * hi + ((lane & 15) >> 2)) * VROW + (((lane >> 4) & 1) * 16 + (lane & 3) * 4) * 2;
    ATT_LOAD(0); ATT_WRITE(0);
    __syncthreads();
#pragma nounroll
    for (int j = 0; j < NT; ++j) {
        const int buf = j & 1;
        if (j + 1 < NT) ATT_LOAD(j + 1);
        if (j <= jdiag) {
            const ATT_LAS unsigned char* kp = kp0 + buf * KBUF;
            f32x16 p0, p1;
#pragma unroll
            for (int i = 0; i < 16; ++i) { p0[i] = 0.f; p1[i] = 0.f; }
#pragma unroll
            for (int s = 0; s < 12; ++s) {
                const bf16x8 k0 = *(const ATT_LAS bf16x8*)(kp + s * 32), k1 = *(const ATT_LAS bf16x8*)(kp + 32 * KROW + s * 32);
                p0 = __builtin_amdgcn_mfma_f32_32x32x16_bf16(k0, qf[s], p0, 0, 0, 0);
                p1 = __builtin_amdgcn_mfma_f32_32x32x16_bf16(k1, qf[s], p1, 0, 0, 0);
                if ((s & 3) == 3) __builtin_amdgcn_sched_barrier(0);
            }
            if (j == 0 || j >= jband) {
#pragma unroll
                for (int i = 0; i < 16; ++i) { const int kr = 64 * j + crow(i, hi);
                    if (kr < LPAD || kr > qrow) p0[i] = -1e30f;
                    if (kr + 32 < LPAD || kr + 32 > qrow) p1[i] = -1e30f; }
            }
            float mx = fmaxf(p0[0], p1[0]);
#pragma unroll
            for (int i = 1; i < 16; ++i) mx = fmaxf(mx, fmaxf(p0[i], p1[i]));
            mx = x32_max(mx);
            const float mn = fmaxf(m, mx);
            const bool grew = mn > m;
            const float alpha = __builtin_amdgcn_exp2f(m - mn);
            m = mn;
            float rs = 0.f;
#pragma unroll
            for (int i = 0; i < 16; ++i) { p0[i] = __builtin_amdgcn_exp2f(p0[i] - mn); p1[i] = __builtin_amdgcn_exp2f(p1[i] - mn); rs += p0[i] + p1[i]; }
            lsum = lsum * alpha + rs;
            if (__any(grew)) {
                if (hi == 0) scr[r32] = alpha;
#pragma unroll
                for (int g = 0; g < 4; ++g) { const f32x4 a4 = *(const ATT_LAS f32x4*)(scr + 8 * g + 4 * hi);
#pragma unroll
                    for (int d = 0; d < 4; ++d) { o[d][4 * g + 0] *= a4[0]; o[d][4 * g + 1] *= a4[1]; o[d][4 * g + 2] *= a4[2]; o[d][4 * g + 3] *= a4[3]; } }
            }
            u32x4 pw[4];
#pragma unroll
            for (int s = 0; s < 2; ++s) {
                pw[s] = (u32x4){cvtpk(p0[8 * s], p0[8 * s + 1]), cvtpk(p0[8 * s + 2], p0[8 * s + 3]), cvtpk(p0[8 * s + 4], p0[8 * s + 5]), cvtpk(p0[8 * s + 6], p0[8 * s + 7])};
                pw[2 + s] = (u32x4){cvtpk(p1[8 * s], p1[8 * s + 1]), cvtpk(p1[8 * s + 2], p1[8 * s + 3]), cvtpk(p1[8 * s + 4], p1[8 * s + 5]), cvtpk(p1[8 * s + 6], p1[8 * s + 7])};
            }
            const ATT_LAS unsigned char* vp = vp0 + buf * VBUF;
            __builtin_amdgcn_sched_barrier(0);
#pragma unroll
            for (int ks = 0; ks < 4; ++ks) {
                const bf16x8 pa = __builtin_bit_cast(bf16x8, pw[ks]);
#pragma unroll
                for (int d = 0; d < 4; ++d) {
                    const s16x4 lo = vtr(vp + (16 * ks) * VROW + 64 * d), hh = vtr(vp + (16 * ks + 8) * VROW + 64 * d);
                    const bf16x8 vb = (bf16x8){lo[0], lo[1], lo[2], lo[3], hh[0], hh[1], hh[2], hh[3]};
                    o[d] = __builtin_amdgcn_mfma_f32_32x32x16_bf16(pa, vb, o[d], 0, 0, 0);
                }
                __builtin_amdgcn_sched_barrier(0);
            }
        }
        if (j + 1 < NT) ATT_WRITE(buf ^ 1);
        __syncthreads();
    }
#undef ATT_LOAD
#undef ATT_WRITE
    const float ltot = x32_sum(lsum);
    if (hi == 0) scr[32 + r32] = ltot;
    const float* og = p.in[19] + h * DV;
    float gl[4];
#pragma unroll
    for (int d = 0; d < 4; ++d) gl[d] = og[32 * d + r32];
    bf16_t* Y = (bf16_t*)(ws + O_Y) + ((size_t)b * SEQ + 256 * qblk + 32 * w) * DM + 512 + h * DV + r32;
#pragma unroll
    for (int g = 0; g < 4; ++g) {
        const f32x4 l4 = *(const ATT_LAS f32x4*)(scr + 32 + 8 * g + 4 * hi);
#pragma unroll
        for (int e = 0; e < 4; ++e) {
            const int i = 4 * g + e;
            float ss = o[0][i] * o[0][i] + o[1][i] * o[1][i] + o[2][i] * o[2][i] + o[3][i] * o[3][i];
            ss += swz_xor<1>(ss); ss += swz_xor<2>(ss); ss += swz_xor<4>(ss); ss += swz_xor<8>(ss); ss += swz_xor<16>(ss);
            const float inv = 1.f / l4[e];
            const float sc = inv / sqrtf(ss * inv * inv * (1.f / DV) + RMS_EPS);
            bf16_t* yr = Y + (size_t)crow(i, hi) * DM;
#pragma unroll
            for (int d = 0; d < 4; ++d) yr[32 * d] = (bf16_t)f2bf(o[d][i] * sc * gl[d]);
        }
    }
}
}

template <int CTRL> __device__ __forceinline__ float dpp5(float x) { return __builtin_bit_cast(float, __builtin_amdgcn_update_dpp(0, __builtin_bit_cast(int, x), CTRL, 0xF, 0xF, true)); }
__device__ __forceinline__ float sum8(float x) { x += dpp5<0xB1>(x); x += dpp5<0x4E>(x); x += dpp5<0x141>(x); return x; }
__device__ __forceinline__ void p5_phase(const Params& p, int gw, int ngw, int) {
    const int lane = lane_id_fresh();
    unsigned char* ws = p.ws;
    const float* YRAW = (const float*)(ws + chk::O_YRAW);
    const f16_t* R = (const f16_t*)(ws + O_R); const f16_t* VV = (const f16_t*)(ws + O_VV); const f16_t* KM = (const f16_t*)(ws + O_KMOD); const bf16_t* G = (const bf16_t*)(ws + O_G);
    bf16_t* Y = (bf16_t*)(ws + O_Y);
    float rk[8], lw[8], lb[8];
    { const f32x4* a = (const f32x4*)(p.in[12] + 8 * lane); const f32x4* b = (const f32x4*)(p.in[13] + 8 * lane); const f32x4* c = (const f32x4*)(p.in[14] + 8 * lane);
      const f32x4 a0 = a[0], a1 = a[1], b0 = b[0], b1 = b[1], c0 = c[0], c1 = c[1];
#pragma unroll
      for (int j = 0; j < 4; ++j) { rk[j] = a0[j]; rk[4 + j] = a1[j]; lw[j] = b0[j]; lw[4 + j] = b1[j]; lb[j] = c0[j]; lb[4 + j] = c1[j]; } }
#pragma unroll 2
    for (int rr = gw; rr < TR; rr += ngw) {
        const int b = rr / SEQ, s_ = rr % SEQ;
        const size_t idx = ((size_t)b * LP + 64 + s_) * 512 + 8 * lane;
        const f32x4 y0 = *(const f32x4*)(YRAW + idx), y1 = *(const f32x4*)(YRAW + idx + 4);
        const f16x8 r8 = *(const f16x8*)(R + idx), k8 = *(const f16x8*)(KM + idx), v8 = *(const f16x8*)(VV + idx);
        const u32x4 g8 = *(const u32x4*)(G + idx);
        float y[8] = {y0[0], y0[1], y0[2], y0[3], y1[0], y1[1], y1[2], y1[3]};
        float sm = 0.f, bn = 0.f;
#pragma unroll
        for (int j = 0; j < 8; ++j) { sm += y[j]; bn += (float)r8[j] * (float)k8[j] * rk[j]; }
        const float mean = sum8(sm) * (1.f / 64.f); bn = sum8(bn);
        float sq = 0.f;
#pragma unroll
        for (int j = 0; j < 8; ++j) { y[j] -= mean; sq += y[j] * y[j]; }
        const float rs = 1.0f / sqrtf(sum8(sq) * (1.f / 64.f) + GN_EPS);
        const float gg[8] = {bf2f(g8.x & 0xffffu), bf2f(g8.x >> 16), bf2f(g8.y & 0xffffu), bf2f(g8.y >> 16), bf2f(g8.z & 0xffffu), bf2f(g8.z >> 16), bf2f(g8.w & 0xffffu), bf2f(g8.w >> 16)};
        float o[8];
#pragma unroll
        for (int j = 0; j < 8; ++j) o[j] = (y[j] * rs * lw[j] + lb[j] + bn * (float)v8[j]) * gg[j];
        *(u32x4*)(Y + (size_t)rr * DM + 8 * lane) = (u32x4){pk2(o[0], o[1]), pk2(o[2], o[3]), pk2(o[4], o[5]), pk2(o[6], o[7])};
    }
}
__device__ __forceinline__ void p9_phase(const Params& p, int gw, int ngw, int) {
    const int lane = lane_id_fresh();
    const float* ssq = (const float*)(p.ws + O_SSQ3); const float* g = p.in[25];
    for (int row = gw; row < TR; row += ngw) {
        const float rs = 1.0f / sqrtf(ssq[row] * (1.f / DM) + RMS_EPS);
        f32x4* o = (f32x4*)(p.out + (size_t)row * DM) + lane;
#pragma unroll
        for (int j = 0; j < 4; ++j) { const f32x4 gv = ((const f32x4*)g)[lane + 64 * j]; f32x4 v = o[64 * j]; v = v * rs * gv; o[64 * j] = v; }
    }
}


#define GAS __attribute__((address_space(1)))
#define LAS __attribute__((address_space(3)))
#define XB_TMO      128
#define XB_XCNT(j)  (256  + 64 * (j))
#define XB_XSUB(j)  (1280 + 64 * (j))
#define XB_XGEN(j)  (2304 + 64 * (j))
#define XB_TOP      3328
#define XB_TOPGEN   3392
#define XCD_BAR_WORDS 3456
#define XB_SPIN_CAP (1u << 22)
__device__ __forceinline__ unsigned xb_ld(unsigned* p)              { return __hip_atomic_load(p, __ATOMIC_RELAXED, __HIP_MEMORY_SCOPE_AGENT); }
__device__ __forceinline__ unsigned xb_add(unsigned* p, unsigned v) { return __hip_atomic_fetch_add(p, v, __ATOMIC_RELAXED, __HIP_MEMORY_SCOPE_AGENT); }
__device__ __forceinline__ unsigned xb_xcc_id() { return (unsigned)__builtin_amdgcn_s_getreg((3 << 11) | 20) & 0xFu; }
#define XB_SPIN(cond, bar) do { unsigned _sp = 0; while (cond) { __builtin_amdgcn_s_sleep(1); \
    if ((++_sp & 255u) == 0u) { if (xb_ld(&(bar)[XB_TMO])) break; if (_sp > XB_SPIN_CAP) { atomicAdd(&(bar)[XB_TMO], 1u); break; } } } } while (0)
struct XcdBarrier { unsigned* bar; unsigned x; volatile LAS unsigned* st; };
__device__ __forceinline__ XcdBarrier xcd_barrier_post(unsigned* bar, volatile LAS unsigned* st) {
    XcdBarrier b; b.bar = bar; b.x = xb_xcc_id(); b.st = st;
    if (threadIdx.x == 0) (void)xb_add(&bar[XB_XCNT(b.x)], 1u);
    return b;
}
__device__ __forceinline__ void xcd_barrier_complete(unsigned* bar, unsigned x, unsigned& nloc, unsigned& nx) {
    const unsigned G = gridDim.x * gridDim.y * gridDim.z;
    unsigned sum, cnt, mine, sp = 0u;
    for (;;) {
        sum = 0u; cnt = 0u; mine = 0u;
#pragma unroll
        for (unsigned j = 0; j < 16; ++j) { const unsigned c = xb_ld(&bar[XB_XCNT(j)]); sum += c; cnt += (c > 0u) ? 1u : 0u; mine = (j == x) ? c : mine; }
        if (sum == G) break;
        __builtin_amdgcn_s_sleep(1);
        if ((++sp & 255u) == 0u) { if (xb_ld(&bar[XB_TMO])) break; if (sp > XB_SPIN_CAP) { atomicAdd(&bar[XB_TMO], 1u); break; } }
    }
    nloc = mine > 0u ? mine : 1u; nx = cnt > 0u ? cnt : 1u;
}
__device__ __forceinline__ void xcd_barrier(const XcdBarrier& b) {
    asm volatile("s_waitcnt vmcnt(0)" ::: "memory");
    __syncthreads();
    if (threadIdx.x == 0) {
        unsigned* bar = b.bar;
        __builtin_amdgcn_s_waitcnt(0);
        unsigned nloc = b.st[0], nx = b.st[1];
        if (nloc == 0u) { xcd_barrier_complete(bar, b.x, nloc, nx); b.st[0] = nloc; b.st[1] = nx; }
        const unsigned old = xb_add(&bar[XB_XSUB(b.x)], 1u);
        const unsigned gen = old / nloc;
        if (old + 1u == (gen + 1u) * nloc) {
            __builtin_amdgcn_fence(__ATOMIC_RELEASE, "agent");
            asm volatile("s_waitcnt vmcnt(0)" ::: "memory");
            const unsigned og = xb_add(&bar[XB_TOP], 1u);
            const unsigned tg = og / nx;
            if (og + 1u == (tg + 1u) * nx) xb_add(&bar[XB_TOPGEN], 1u);
            else XB_SPIN(xb_ld(&bar[XB_TOPGEN]) == tg, bar);
            __builtin_amdgcn_fence(__ATOMIC_ACQUIRE, "agent");
            xb_add(&bar[XB_XGEN(b.x)], 1u);
            asm volatile("s_waitcnt vmcnt(0)" ::: "memory");
        } else {
            XB_SPIN(xb_ld(&bar[XB_XGEN(b.x)]) == gen, bar);
            __builtin_amdgcn_fence(__ATOMIC_ACQUIRE, "agent");
            asm volatile("s_waitcnt vmcnt(0)" ::: "memory");
        }
    }
    __syncthreads();
}

#ifndef PH_MASK
#define PH_MASK 0xFFFF
#endif
#define PH(k) ((PH_MASK >> (k)) & 1)
#ifndef PROBE_PHASE
#define PROBE_PHASE -1
#endif
#define PROBE_EXTRA 4
#define NREP(k) ((PH(k) ? 1 : 0) + ((PROBE_PHASE == (k)) ? PROBE_EXTRA : 0))
constexpr int LDS_BYTES = 153600;
constexpr int LDS_MISC = LDS_BYTES - 256;
__global__ void __launch_bounds__(512, 2) mega_fwd(Params p) {
    extern __shared__ __attribute__((aligned(16))) unsigned char lds[];
    const int tid = threadIdx.x, lane = tid & 63; const int wave = __builtin_amdgcn_readfirstlane(tid >> 6);
    const int G = gridDim.x, gw = blockIdx.x * 8 + wave, ngw = G * 8;
    unsigned char* ws = p.ws;
    PG8_LAS unsigned char* ldsg = (PG8_LAS unsigned char*)lds;
    unsigned* ctl = (unsigned*)(ws + O_CTL);
    volatile LAS unsigned* misc = (volatile LAS unsigned*)(lds + LDS_MISC);
    if (tid < 2) misc[tid] = 0u;
    __syncthreads();
    const XcdBarrier xbar = xcd_barrier_post(ctl + 1024, misc);
#define GRID_SYNC() xcd_barrier(xbar)
#ifndef PROBE_SEG
#define PROBE_SEG -1
#endif
#define STAMP(i) do { if (PROBE_SEG >= 0 && blockIdx.x == 0 && tid == 0) misc[16 + (i)] = (unsigned)__builtin_amdgcn_s_memrealtime(); } while (0)
    STAMP(0);
    for (int rep_ = 0; rep_ < NREP(0); ++rep_) p0_phase(p, (float*)lds, gw, ngw, lane, wave);
    if (blockIdx.x == 0 && tid < 64) ctl[tid] = 0u;
    GRID_SYNC();
    STAMP(1);
    for (int rep_ = 0; rep_ < NREP(1); ++rep_) { pg8::Gemm g{(const bf16_t*)(ws + O_U1), (const bf16_t*)(ws + O_WIN), DM, DM, DM}; pg8::StaticOrder S; S.init(TP, NINP, G, blockIdx.x);
      pg8::Epi8<FP> E{FP{(bf16_t*)(ws + O_P)}}; pg8::gemm_phase<pg8::Epi8<FP>, true>(ldsg, g, S, E); }
    GRID_SYNC();
    STAMP(2);
    for (int rep_ = 0; rep_ < NREP(2); ++rep_) p2_phase(p, gw, ngw);
    GRID_SYNC();
    STAMP(3);
    for (int rep_ = 0; rep_ < NREP(3); ++rep_) { pg8::Gemm g{(const bf16_t*)(ws + O_CQKV), (const bf16_t*)(ws + O_WUQ), 640, QL, QL}; pg8::StaticOrder S; S.init(TP, 768, G, blockIdx.x);
      pg8::Epi8<FQ> E{FQ{(bf16_t*)(ws + O_Q), (const float*)(ws + O_RSTDQ), (const float*)(ws + O_ROPE)}}; pg8::gemm_phase<pg8::Epi8<FQ>, true>(ldsg, g, S, E); }
    for (int rep_ = 0; rep_ < NREP(4); ++rep_) { pg8::Gemm g{(const bf16_t*)(ws + O_CQKV) + 384, (const bf16_t*)(ws + O_WUKV), 640, KVL, KVL}; pg8::StaticOrder S; S.init(TP, 1024, G, blockIdx.x);
      pg8::Epi8<FKV> E{FKV{(bf16_t*)(ws + O_K), (bf16_t*)(ws + O_V), (const float*)(ws + O_RSTDKV)}}; pg8::gemm_phase<pg8::Epi8<FKV>, true>(ldsg, g, S, E); }
    if (PH(5)) { pg8::Gemm g{(const bf16_t*)(ws + O_LIN), (const bf16_t*)(ws + O_LWA), 384, 256, 256}; pg8::StaticOrder S; S.init(TP, 1024, G, blockIdx.x);
      pg8::Epi8<FLwa> E{FLwa{(f16_t*)(ws + O_EW), (f16_t*)(ws + O_KMOD), (const f16_t*)(ws + O_KK), (f16_t*)(ws + O_B), p.in[5], p.in[7], p.in[11]}}; pg8::gemm_phase<pg8::Epi8<FLwa>, true>(ldsg, g, S, E); }
    for (int rep_ = 0; rep_ < NREP(6); ++rep_) { pg8::Gemm g{(const bf16_t*)(ws + O_LIN) + 128, (const bf16_t*)(ws + O_LG), 384, 256, 256}; pg8::StaticOrder S; S.init(TP, 512, G, blockIdx.x);
      pg8::Epi8<FG> E{FG{(bf16_t*)(ws + O_G)}}; pg8::gemm_phase<pg8::Epi8<FG>, true>(ldsg, g, S, E); }
    GRID_SYNC();
    STAMP(4);
    if (PH(7)) {
        for (int rep_ = 0; rep_ < 1 + ((PROBE_PHASE == 20) ? PROBE_EXTRA : 0); ++rep_)
            if (wave < chk::PRE_WAVES) for (int u = blockIdx.x * chk::PRE_WAVES + wave; u < chk::NCHH; u += G * chk::PRE_WAVES) chk::pre_mfma(p, (CK_LAS unsigned char*)lds + wave * chk::PRE_LDS, u);
        GRID_SYNC();
        STAMP(5);
        if (blockIdx.x < NB * RH) chk::seq_block(p, (CK_LAS unsigned char*)lds, blockIdx.x);
        if (PROBE_SEG >= 0) { __syncthreads(); STAMP(6); }
    }
    if (PH(8)) {
        volatile LAS unsigned* bc = misc + 8;
        const int xg = (int)(blockIdx.x & 7);
        for (;;) {
            __syncthreads();
            if (tid == 0) bc[0] = atomicAdd(ctl + xg, 1u);
            __syncthreads();
            const unsigned u = bc[0];
            if (u >= 64u) break;
            const int qblk = 15 - (int)(u >> 2), bh = xg + 8 * (int)(u & 3);
            att::attn_unit(p, ldsg, bh >> 2, bh & 3, qblk);
        }
    }
    GRID_SYNC();
    STAMP(7);
    for (int rep_ = 0; rep_ < NREP(9); ++rep_) p5_phase(p, gw, ngw, lane);
    GRID_SYNC();
    STAMP(8);
    if (PH(10)) { pg8::Gemm g{(const bf16_t*)(ws + O_Y), (const bf16_t*)(ws + O_WOUT), DM, DM, DM}; pg8::StaticOrder S; S.init(TR, DM, G, blockIdx.x);
      pg8::Epi8<FOut> E{FOut{p.in[0], p.out, (bf16_t*)(ws + O_H2B), (float*)(ws + O_SSQ2)}}; pg8::gemm_phase<pg8::Epi8<FOut>, true>(ldsg, g, S, E); }
    GRID_SYNC();
    STAMP(9);
    for (int rep_ = 0; rep_ < NREP(11); ++rep_) { pg8::Gemm g{(const bf16_t*)(ws + O_H2B), (const bf16_t*)(ws + O_WGU), DM, DM, DM}; pg8::StaticOrder S; S.init(TR, 2 * DFF, G, blockIdx.x);
      pg8::Epi8<FAct> E{FAct{(bf16_t*)(ws + O_ACT), (const float*)(ws + O_SSQ2)}}; pg8::gemm_phase<pg8::Epi8<FAct>, true>(ldsg, g, S, E); }
    GRID_SYNC();
    STAMP(10);
    if (PH(12)) { pg8::Gemm g{(const bf16_t*)(ws + O_ACT), (const bf16_t*)(ws + O_WDN), DFF, DFF, DFF}; pg8::StaticOrder S; S.init(TR, DM, G, blockIdx.x);
      pg8::Epi8<FDown> E{FDown{p.out, (float*)(ws + O_SSQ3)}}; pg8::gemm_phase<pg8::Epi8<FDown>, true>(ldsg, g, S, E); }
    GRID_SYNC();
    STAMP(11);
    if (PH(13)) p9_phase(p, gw, ngw, lane);
    if (PROBE_SEG >= 0 && blockIdx.x == 0) {
        __syncthreads();
        if (tid == 0) { const unsigned long long t1 = __builtin_amdgcn_s_memrealtime(); misc[16 + 12] = (unsigned)t1;
            const unsigned d = misc[16 + PROBE_SEG + 1] - misc[16 + PROBE_SEG];
            while (__builtin_amdgcn_s_memrealtime() - t1 < 9ull * d) __builtin_amdgcn_s_sleep(8); }
    }
}

extern "C" void kernel_launch(void* const* d_in, const int* in_sizes, int n_in, void* d_out, int out_size, void* d_ws, size_t ws_size, hipStream_t stream) {
    static int grid_blocks = 0;
    if (grid_blocks == 0) {
        if (n_in != 26 || out_size != TR * DM || ws_size < 512 * MiB) { fprintf(stderr, "kernel_launch: unexpected sizes n_in=%d out=%d ws=%zu\n", n_in, out_size, ws_size); grid_blocks = -1; return; }
        int dev = 0, cus = 0, per_cu = 0;
        (void)hipGetDevice(&dev); (void)hipDeviceGetAttribute(&cus, hipDeviceAttributeMultiprocessorCount, dev);
        (void)hipFuncSetAttribute((const void*)mega_fwd, hipFuncAttributeMaxDynamicSharedMemorySize, LDS_BYTES);
        (void)hipOccupancyMaxActiveBlocksPerMultiprocessor(&per_cu, (const void*)mega_fwd, 512, LDS_BYTES);
        if (per_cu < 1) { fprintf(stderr, "kernel_launch: occupancy query says %d blocks per CU\n", per_cu); per_cu = 1; }
        if (per_cu > 1) per_cu = 1;
        grid_blocks = cus * per_cu;
    }
    if (grid_blocks < 0) return;
    Params p{};
    for (int i = 0; i < 26; ++i) p.in[i] = (const float*)d_in[i];
    p.out = (float*)d_out; p.ws = (unsigned char*)d_ws;
    (void)hipMemsetAsync((unsigned char*)d_ws + O_CTL + 4096, 0, XCD_BAR_WORDS * 4, stream);
    hipLaunchKernelGGL(mega_fwd, dim3(grid_blocks), dim3(512), LDS_BYTES, stream, p);
    hipError_t e = hipPeekAtLastError();
    if (e != hipSuccess) fprintf(stderr, "launch failed: %s (grid %d)\n", hipGetErrorString(e), grid_blocks);
}
```
